# Optimizing an MI355X kernel written in HIP

```python
import math
import jax, jax.numpy as jnp
from jax import lax
import numpy as np

D_MODEL = 2048
BATCH = 4
SEQ = 4096
DEPTH = 2

HEAD_DIM = 128
QBLK = 128
FOX_HEADS = 8
DIL_GROUPS = ((128, 1), (512, 4), (2048, 16))
DIL_HEADS_PER_GROUP = 4
DIL_HEADS = DIL_HEADS_PER_GROUP * len(DIL_GROUPS)
NSA_Q_HEADS = 8
NSA_KV_HEADS = 2
NSA_GQA = NSA_Q_HEADS // NSA_KV_HEADS
CMP_BLOCK = 32
CMP_STRIDE = 16
CMP_HIDDEN = 256
SLC_BLOCK = 64
SLC_COUNT = 16
SLC_QBLK = 64
WIN = 512
NSA_BRANCHES = 3
REL_BUCKETS = 32
REL_MAX_EXACT = 16
REL_MAX_DIST = 2048
N_BIAS_HEADS = DIL_HEADS + NSA_Q_HEADS
D_FF = 5632
N_EXPERTS = 8
TOP_K = 2
D_FF_EXPERT = 7168
N_DENSE = (DEPTH + 1) // 2
N_MOE = DEPTH // 2
N_BRANCHES = 3
RMS_EPS = 1e-6
W_FOX_QKV = 3 * FOX_HEADS * HEAD_DIM
W_FOX_F = FOX_HEADS
W_DIL_QKV = 3 * DIL_HEADS * HEAD_DIM
W_NSA_Q = NSA_Q_HEADS * HEAD_DIM
W_NSA_KV = NSA_BRANCHES * 2 * NSA_KV_HEADS * HEAD_DIM
W_NSA_G = NSA_BRANCHES * NSA_Q_HEADS
W_MERGE = N_BRANCHES * D_MODEL
IN_SPLITS = (W_FOX_QKV, W_FOX_F, W_DIL_QKV, W_NSA_Q, W_NSA_KV, W_NSA_G, W_MERGE)
D_IN = W_FOX_QKV + W_FOX_F + W_DIL_QKV + W_NSA_Q + W_NSA_KV + W_NSA_G + W_MERGE

kernel_name = "hybrid_fox_dilated_nsa_moe"


def rmsnorm(x, g):
    xf = x.astype(jnp.float32)
    inv = lax.rsqrt(jnp.mean(xf * xf, axis=-1, keepdims=True) + RMS_EPS)
    return (xf * inv).astype(x.dtype) * g


def masked_softmax(s, mask):
    s = jnp.where(mask, s.astype(jnp.float32), -jnp.inf)
    m = jnp.max(s, axis=-1, keepdims=True)
    m = jnp.where(jnp.isfinite(m), m, 0.0)
    e = jnp.exp(s - m)
    den = jnp.sum(e, axis=-1, keepdims=True)
    return e / jnp.where(den > 0, den, 1.0)


def t5_bucket(dist):
    dist = jnp.maximum(dist, 0)
    d = jnp.maximum(dist, 1).astype(jnp.float32)
    log_ratio = jnp.log(d / REL_MAX_EXACT) / math.log(REL_MAX_DIST / REL_MAX_EXACT)
    large = REL_MAX_EXACT + (log_ratio * (REL_BUCKETS - REL_MAX_EXACT)).astype(jnp.int32)
    large = jnp.minimum(large, REL_BUCKETS - 1)
    return jnp.where(dist < REL_MAX_EXACT, dist, large)


def split_columns(a, sizes):
    out, start = [], 0
    for n in sizes:
        out.append(a[..., start:start + n])
        start += n
    return out


def fox_attention(q, k, v, logf):
    B, S, H, D = q.shape
    nb = S // QBLK
    scale = HEAD_DIM ** -0.5
    c = jnp.cumsum(logf.astype(jnp.float32), axis=1).transpose(0, 2, 1)
    qb = q.reshape(B, nb, QBLK, H, D).transpose(1, 0, 2, 3, 4)
    cb = c.reshape(B, H, nb, QBLK).transpose(2, 0, 1, 3)
    kpos = jnp.arange(S)

    def block(args):
        i, qi, ci = args
        s = jnp.einsum("bqhd,bkhd->bhqk", qi, k).astype(jnp.float32) * scale
        s = s + (ci[..., :, None] - c[:, :, None, :])
        qpos = i * QBLK + jnp.arange(QBLK)
        p = masked_softmax(s, kpos[None, :] <= qpos[:, None])
        return jnp.einsum("bhqk,bkhd->bqhd", p.astype(v.dtype), v)

    o = lax.map(block, (jnp.arange(nb), qb, cb))
    return o.transpose(1, 0, 2, 3, 4).reshape(B, S, H * D)


def dilated_attention(q, k, v, rel_bias_b):
    B, S, H, D = q.shape
    G, Hg = len(DIL_GROUPS), DIL_HEADS_PER_GROUP
    nb = S // QBLK
    scale = HEAD_DIM ** -0.5
    qg = q.reshape(B, S, G, Hg, D)
    kg = k.reshape(B, S, G, Hg, D)
    vg = v.reshape(B, S, G, Hg, D)
    bias_g = rel_bias_b.reshape(REL_BUCKETS, G, Hg)
    offsets = [dil * np.arange(window // dil + 1) for window, dil in DIL_GROUPS]
    biases = [bias_g[t5_bucket(jnp.asarray(offsets[g])), g].T for g in range(G)]
    qb = qg.reshape(B, nb, QBLK, G, Hg, D).transpose(1, 0, 2, 3, 4, 5)

    def block(args):
        i, qi = args
        qpos = i * QBLK + jnp.arange(QBLK)
        outs, maxs, dens = [], [], []
        for g in range(G):
            idx = qpos[:, None] - jnp.asarray(offsets[g])[None, :]
            valid = idx >= 0
            idxc = jnp.maximum(idx, 0)
            kk = jnp.take(kg[:, :, g], idxc, axis=1)
            vv = jnp.take(vg[:, :, g], idxc, axis=1)
            s = jnp.einsum("bqhd,bqnhd->bhqn", qi[:, :, g], kk).astype(jnp.float32) * scale
            s = s + biases[g][None, :, None, :]
            s = jnp.where(valid[None, None], s, -jnp.inf)
            m = jnp.max(s, axis=-1, keepdims=True)
            e = jnp.exp(s - m)
            den = jnp.sum(e, axis=-1, keepdims=True)
            outs.append(jnp.einsum("bhqn,bqnhd->bqhd", (e / den).astype(v.dtype), vv))
            maxs.append(m[..., 0])
            dens.append(den[..., 0])
        m_all = jnp.stack(maxs, 0)
        w = jnp.stack(dens, 0) * jnp.exp(m_all - jnp.max(m_all, axis=0, keepdims=True))
        w = w / jnp.sum(w, axis=0, keepdims=True)
        return jnp.einsum("gbhq,gbqhd->bqhd", w.astype(v.dtype), jnp.stack(outs, 0))

    o = lax.map(block, (jnp.arange(nb), qb))
    return o.transpose(1, 0, 2, 3, 4).reshape(B, S, Hg * D)


def compress_tokens(x, pe, w1, w2):
    B, S, H, D = x.shape
    r = CMP_BLOCK // CMP_STRIDE
    nc = S // CMP_STRIDE - r + 1
    chunks = x.reshape(B, S // CMP_STRIDE, CMP_STRIDE, H, D)
    blocks = jnp.concatenate([chunks[:, j:j + nc] for j in range(r)], axis=2)
    blocks = blocks + pe[None, None, :, None, :]
    flat = blocks.transpose(0, 1, 3, 2, 4).reshape(B, nc, H, CMP_BLOCK * D)
    return jax.nn.gelu(flat @ w1) @ w2


def nsa_attention(q, k_cmp, v_cmp, k_slc, v_slc, k_win, v_win, gate_logits,
                  cmp_pe_k, cmp_w1_k, cmp_w2_k, cmp_pe_v, cmp_w1_v, cmp_w2_v, rel_bias_c):
    B, S, _, D = q.shape
    Hkv, G = NSA_KV_HEADS, NSA_GQA
    scale = HEAD_DIM ** -0.5
    pos = jnp.arange(S)
    qg = q.reshape(B, S, Hkv, G, D)
    bias_c = rel_bias_c.reshape(REL_BUCKETS, Hkv, G)

    kc = compress_tokens(k_cmp, cmp_pe_k, cmp_w1_k, cmp_w2_k)
    vc = compress_tokens(v_cmp, cmp_pe_v, cmp_w1_v, cmp_w2_v)
    nc = kc.shape[1]
    s_c = jnp.einsum("bshgd,bchd->bhgsc", qg, kc) * scale
    block_end = jnp.arange(nc) * CMP_STRIDE + CMP_BLOCK - 1
    p_cmp = masked_softmax(s_c, block_end[None, :] <= pos[:, None])
    o_cmp = jnp.einsum("bhgsc,bchd->bshgd", p_cmp.astype(vc.dtype), vc)

    n_slc = S // SLC_BLOCK
    ratio, n_inner = SLC_BLOCK // CMP_STRIDE, CMP_BLOCK // CMP_STRIDE
    off = np.array([m - n for m in range(ratio) for n in range(n_inner)])
    cidx = ratio * np.arange(n_slc)[:, None] + off[None, :]
    cvalid = (cidx >= 0) & (cidx < nc)
    imp = jnp.sum(p_cmp, axis=2)
    p_slc = jnp.sum(jnp.where(cvalid, jnp.take(imp, np.clip(cidx, 0, nc - 1), axis=-1), 0.0), axis=-1)
    blk = jnp.arange(n_slc)
    cur = pos // SLC_BLOCK
    forced = (blk[None, :] == 0) | (blk[None, :] == cur[:, None]) | (blk[None, :] == cur[:, None] - 1)
    allowed = blk[None, :] <= cur[:, None]
    score = jnp.where(forced, jnp.inf, jnp.where(allowed, p_slc, -jnp.inf))
    n_sel = min(SLC_COUNT, n_slc)
    _, sel = lax.top_k(score, n_sel)

    kb = k_slc.reshape(B, n_slc, SLC_BLOCK, Hkv, D).transpose(0, 3, 1, 2, 4)
    vb = v_slc.reshape(B, n_slc, SLC_BLOCK, Hkv, D).transpose(0, 3, 1, 2, 4)
    nq = S // SLC_QBLK
    qsb = qg.reshape(B, nq, SLC_QBLK, Hkv, G, D).transpose(1, 0, 3, 4, 2, 5)
    selb = sel.reshape(B, Hkv, nq, SLC_QBLK, n_sel).transpose(2, 0, 1, 3, 4)
    bi = jnp.arange(B)[:, None, None, None]
    hi = jnp.arange(Hkv)[None, :, None, None]
    n_keys = n_sel * SLC_BLOCK

    def slc_block(args):
        i, qi, si = args
        kk = kb[bi, hi, si].reshape(B, Hkv, SLC_QBLK, n_keys, D)
        vv = vb[bi, hi, si].reshape(B, Hkv, SLC_QBLK, n_keys, D)
        s = jnp.einsum("bhgqd,bhqnd->bhgqn", qi, kk).astype(jnp.float32) * scale
        qpos = i * SLC_QBLK + jnp.arange(SLC_QBLK)
        kpos = (si[..., None] * SLC_BLOCK + jnp.arange(SLC_BLOCK)).reshape(B, Hkv, SLC_QBLK, n_keys)
        dist = qpos[None, None, :, None] - kpos
        s = s + bias_c[t5_bucket(dist), hi].transpose(0, 1, 4, 2, 3)
        p = masked_softmax(s, (dist >= 0)[:, :, None])
        return jnp.einsum("bhgqn,bhqnd->bqhgd", p.astype(vv.dtype), vv)

    o_slc = lax.map(slc_block, (jnp.arange(nq), qsb, selb))
    o_slc = o_slc.transpose(1, 0, 2, 3, 4, 5).reshape(B, S, Hkv, G, D)

    span = WIN + QBLK
    kp = jnp.pad(k_win, ((0, 0), (WIN, 0), (0, 0), (0, 0)))
    vp = jnp.pad(v_win, ((0, 0), (WIN, 0), (0, 0), (0, 0)))
    nb = S // QBLK
    qwb = qg.reshape(B, nb, QBLK, Hkv, G, D).transpose(1, 0, 2, 3, 4, 5)
    kloc = jnp.arange(span)
    wdist = jnp.arange(QBLK)[:, None] + WIN - kloc[None, :]
    in_win = (wdist >= 0) & (wdist < WIN)
    bias_w = bias_c[t5_bucket(wdist)].transpose(2, 3, 0, 1)

    def win_block(args):
        i, qi = args
        kk = lax.dynamic_slice_in_dim(kp, i * QBLK, span, axis=1)
        vv = lax.dynamic_slice_in_dim(vp, i * QBLK, span, axis=1)
        s = jnp.einsum("bqhgd,bkhd->bhgqk", qi, kk).astype(jnp.float32) * scale + bias_w
        kpos = i * QBLK - WIN + kloc
        p = masked_softmax(s, in_win & (kpos >= 0)[None, :])
        return jnp.einsum("bhgqk,bkhd->bqhgd", p.astype(vv.dtype), vv)

    o_win = lax.map(win_block, (jnp.arange(nb), qwb))
    o_win = o_win.transpose(1, 0, 2, 3, 4, 5).reshape(B, S, Hkv, G, D)

    g = jax.nn.sigmoid(gate_logits).reshape(B, S, NSA_BRANCHES, Hkv, G)[..., None]
    o = g[:, :, 0] * o_cmp + g[:, :, 1] * o_slc + g[:, :, 2] * o_win
    return o.reshape(B, S, NSA_Q_HEADS * D)


def mixing_layer(h, w_in, fox_forget_bias, cmp_pe_k, cmp_w1_k, cmp_w2_k, cmp_pe_v, cmp_w1_v, cmp_w2_v,
                 w_branch_a, w_branch_b, w_branch_c, w_out, rel_bias):
    B, S, _ = h.shape
    D = HEAD_DIM
    fox_qkv, fox_f, dil_qkv, nsa_q, nsa_kv, nsa_g, merge_g = split_columns(h @ w_in, IN_SPLITS)
    qkv_a = fox_qkv.reshape(B, S, 3, FOX_HEADS, D)
    logf = jax.nn.log_sigmoid((fox_f + fox_forget_bias).astype(jnp.float32))
    y_a = fox_attention(qkv_a[:, :, 0], qkv_a[:, :, 1], qkv_a[:, :, 2], logf)
    qkv_b = dil_qkv.reshape(B, S, 3, DIL_HEADS, D)
    y_b = dilated_attention(qkv_b[:, :, 0], qkv_b[:, :, 1], qkv_b[:, :, 2], rel_bias[:, :DIL_HEADS])
    kv = nsa_kv.reshape(B, S, NSA_BRANCHES, 2, NSA_KV_HEADS, D)
    y_c = nsa_attention(nsa_q.reshape(B, S, NSA_Q_HEADS, D),
                        kv[:, :, 0, 0], kv[:, :, 0, 1], kv[:, :, 1, 0], kv[:, :, 1, 1],
                        kv[:, :, 2, 0], kv[:, :, 2, 1],
                        nsa_g.reshape(B, S, NSA_BRANCHES, NSA_Q_HEADS),
                        cmp_pe_k, cmp_w1_k, cmp_w2_k, cmp_pe_v, cmp_w1_v, cmp_w2_v,
                        rel_bias[:, DIL_HEADS:])
    gates = jax.nn.sigmoid(merge_g.reshape(B, S, N_BRANCHES, D_MODEL))
    merged = (gates[:, :, 0] * (y_a @ w_branch_a) + gates[:, :, 1] * (y_b @ w_branch_b)
              + gates[:, :, 2] * (y_c @ w_branch_c))
    return merged @ w_out


def swiglu(h, wg, wu, wd):
    return (jax.nn.silu(h @ wg) * (h @ wu)) @ wd


def moe_ffn(h, router, wg, wu, wd):
    logits = (h @ router).astype(jnp.float32)
    vals, idx = lax.top_k(logits, TOP_K)
    w = jax.nn.softmax(vals, axis=-1)
    combine = jnp.sum(jax.nn.one_hot(idx, N_EXPERTS, dtype=jnp.float32) * w[..., None], axis=-2)
    out = jnp.zeros_like(h)
    for e in range(N_EXPERTS):
        out = out + combine[..., e:e + 1].astype(h.dtype) * swiglu(h, wg[e], wu[e], wd[e])
    return out


def setup_inputs(seed: int = 0) -> dict:
    key = jax.random.key(seed)
    ks = jax.random.split(key, 24)
    f32 = jnp.float32
    D = D_MODEL

    def nrm(k, shape):
        return jax.random.normal(k, shape, f32)

    def w(k, shape, fan_in):
        return nrm(k, shape) * (fan_in ** -0.5)

    return {
        "x": nrm(ks[0], (BATCH, SEQ, D)),
        "rel_bias": 0.3 * nrm(ks[1], (REL_BUCKETS, N_BIAS_HEADS)),
        "norm_mix_g": 1.0 + 0.02 * nrm(ks[2], (DEPTH, D)),
        "norm_ffn_g": 1.0 + 0.02 * nrm(ks[3], (DEPTH, D)),
        "norm_final_g": 1.0 + 0.02 * nrm(ks[4], (D,)),
        "w_in": w(ks[5], (DEPTH, D, D_IN), D),
        "fox_forget_bias": 3.0 + 0.5 * nrm(ks[6], (DEPTH, FOX_HEADS)),
        "cmp_pe_k": 0.1 * nrm(ks[7], (DEPTH, CMP_BLOCK, HEAD_DIM)),
        "cmp_w1_k": w(ks[8], (DEPTH, CMP_BLOCK * HEAD_DIM, CMP_HIDDEN), CMP_BLOCK * HEAD_DIM),
        "cmp_w2_k": w(ks[9], (DEPTH, CMP_HIDDEN, HEAD_DIM), CMP_HIDDEN),
        "cmp_pe_v": 0.1 * nrm(ks[10], (DEPTH, CMP_BLOCK, HEAD_DIM)),
        "cmp_w1_v": w(ks[11], (DEPTH, CMP_BLOCK * HEAD_DIM, CMP_HIDDEN), CMP_BLOCK * HEAD_DIM),
        "cmp_w2_v": w(ks[12], (DEPTH, CMP_HIDDEN, HEAD_DIM), CMP_HIDDEN),
        "w_branch_a": w(ks[13], (DEPTH, FOX_HEADS * HEAD_DIM, D), FOX_HEADS * HEAD_DIM),
        "w_branch_b": w(ks[14], (DEPTH, DIL_HEADS_PER_GROUP * HEAD_DIM, D), DIL_HEADS_PER_GROUP * HEAD_DIM),
        "w_branch_c": w(ks[15], (DEPTH, NSA_Q_HEADS * HEAD_DIM, D), NSA_Q_HEADS * HEAD_DIM),
        "w_out": w(ks[16], (DEPTH, D, D), D),
        "ffn_w_gate": w(ks[17], (N_DENSE, D, D_FF), D),
        "ffn_w_up": w(ks[18], (N_DENSE, D, D_FF), D),
        "ffn_w_down": w(ks[19], (N_DENSE, D_FF, D), D_FF),
        "moe_router": w(ks[20], (N_MOE, D, N_EXPERTS), D),
        "moe_w_gate": w(ks[21], (N_MOE, N_EXPERTS, D, D_FF_EXPERT), D),
        "moe_w_up": w(ks[22], (N_MOE, N_EXPERTS, D, D_FF_EXPERT), D),
        "moe_w_down": w(ks[23], (N_MOE, N_EXPERTS, D_FF_EXPERT, D), D_FF_EXPERT),
    }


def reference(x, rel_bias, norm_mix_g, norm_ffn_g, norm_final_g, w_in, fox_forget_bias,
              cmp_pe_k, cmp_w1_k, cmp_w2_k, cmp_pe_v, cmp_w1_v, cmp_w2_v,
              w_branch_a, w_branch_b, w_branch_c, w_out,
              ffn_w_gate, ffn_w_up, ffn_w_down, moe_router, moe_w_gate, moe_w_up, moe_w_down):
    for l in range(DEPTH):
        h = rmsnorm(x, norm_mix_g[l])
        x = x + mixing_layer(h, w_in[l], fox_forget_bias[l], cmp_pe_k[l], cmp_w1_k[l], cmp_w2_k[l],
                             cmp_pe_v[l], cmp_w1_v[l], cmp_w2_v[l], w_branch_a[l], w_branch_b[l],
                             w_branch_c[l], w_out[l], rel_bias)
        h = rmsnorm(x, norm_ffn_g[l])
        if l % 2 == 0:
            j = l // 2
            x = x + swiglu(h, ffn_w_gate[j], ffn_w_up[j], ffn_w_down[j])
        else:
            j = l // 2
            x = x + moe_ffn(h, moe_router[j], moe_w_gate[j], moe_w_up[j], moe_w_down[j])
    return rmsnorm(x, norm_final_g)
```

```cpp
#include <hip/hip_runtime.h>
#include <stdint.h>
#include <stdio.h>

#ifndef MK_DEBUG
#define MK_DEBUG 0
#endif
#ifndef MK_DBG_STAGE
#define MK_DBG_STAGE 0
#endif
#ifndef MK_PROBE
#define MK_PROBE 0
#endif
#ifndef MK_ONE_LAUNCH
#define MK_ONE_LAUNCH 1
#endif

#define LAS __attribute__((address_space(3)))
typedef unsigned short bf16_t;
typedef short bf16x8 __attribute__((ext_vector_type(8)));
typedef short s16x4 __attribute__((ext_vector_type(4)));
typedef float f32x2 __attribute__((ext_vector_type(2)));
typedef float f32x4 __attribute__((ext_vector_type(4)));
typedef float f32x16 __attribute__((ext_vector_type(16)));
typedef unsigned u32x2 __attribute__((ext_vector_type(2)));
typedef unsigned u32x4 __attribute__((ext_vector_type(4)));

constexpr int T = 16384, DM = 2048, SEQ = 4096, NBATCH = 4;
constexpr int D_IN = 16416;
constexpr int LDP = 16384;
constexpr int PC_FOXQ = 0, PC_FOXK = 1024, PC_FOXV = 2048;
constexpr int PC_DILQ = 3072, PC_DILK = 3072 + 1536, PC_DILV = 3072 + 3072;
constexpr int PC_NSAQ = 7680, PC_NSAKV = 8704, PC_MERGE = 10240;
constexpr int LDY = 2560;
constexpr int YC_A = 0, YC_B = 1024, YC_C = 1536;
constexpr int DFF = 5632, DFFE = 7168, NEXP = 8;
constexpr int MOE_ROWS = 2 * T + NEXP * 256;
constexpr float RMS_EPS = 1e-6f;
constexpr float LOG2E = 1.4426950408889634f;
constexpr float SM_SCALE = 0.08838834764831845f;
constexpr float C2 = SM_SCALE * LOG2E;

enum { IN_X = 0, IN_RELB, IN_NMIX, IN_NFFN, IN_NFIN, IN_WIN, IN_FOXB, IN_PEK, IN_W1K, IN_W2K, IN_PEV, IN_W1V, IN_W2V,
       IN_WBA, IN_WBB, IN_WBC, IN_WOUT, IN_FG, IN_FU, IN_FD, IN_ROUTER, IN_MG, IN_MU, IN_MD, N_IN };

constexpr size_t CTL_BYTES = 65536;
constexpr size_t SZ_WIN = (size_t)16384 * 2048 * 2, SZ_WG32 = (size_t)32 * 2048 * 2, SZ_WBR = (size_t)2048 * 2560 * 2, SZ_WOUT = (size_t)2048 * 2048 * 2;
constexpr size_t SZ_WFU = (size_t)2 * DFF * 2048 * 2, SZ_WFD = (size_t)2048 * DFF * 2;
constexpr size_t SZ_WMU1 = (size_t)2 * DFFE * 2048 * 2, SZ_WMD1 = (size_t)2048 * DFFE * 2;
constexpr size_t SZ_WC1 = (size_t)256 * 4096 * 2, SZ_WC2 = (size_t)128 * 256 * 2;
constexpr size_t WS_CTL = 0;
constexpr size_t WS_WIN = WS_CTL + CTL_BYTES;
constexpr size_t WS_WG32 = WS_WIN + 2 * SZ_WIN;
constexpr size_t WS_WBR = WS_WG32 + 2 * SZ_WG32;
constexpr size_t WS_WOUT = WS_WBR + 2 * SZ_WBR;
constexpr size_t WS_WFU = WS_WOUT + 2 * SZ_WOUT;
constexpr size_t WS_WFD = WS_WFU + SZ_WFU;
constexpr size_t WS_WMU = WS_WFD + SZ_WFD;
constexpr size_t WS_WMD = WS_WMU + 8 * SZ_WMU1;
constexpr size_t WS_WC1 = WS_WMD + 8 * SZ_WMD1;
constexpr size_t WS_WC2 = WS_WC1 + 4 * SZ_WC1;
constexpr size_t WS_CB1 = WS_WC2 + 4 * SZ_WC2;
constexpr size_t WS_PROJ = WS_CB1 + 4096;
constexpr size_t SZ_PROJ = (size_t)(T + 64) * LDP * 2;
constexpr size_t WS_H = WS_PROJ + SZ_PROJ;
constexpr size_t WS_Y = WS_H + (size_t)T * 2048 * 2;
constexpr size_t WS_MERGED = WS_Y + (size_t)T * LDY * 2;
constexpr size_t WS_YCF = WS_MERGED + (size_t)T * 2048 * 2;
constexpr size_t WS_DILO = WS_YCF + (size_t)T * 1024 * 4;
constexpr size_t WS_DILST = WS_DILO + (size_t)3 * T * 512 * 2;
constexpr size_t WS_GATES = WS_DILST + (size_t)3 * T * 4 * 8;
constexpr size_t WS_CNEG = WS_GATES + (size_t)T * 32 * 4;
constexpr size_t WS_KC = WS_CNEG + (size_t)32 * 4096 * 4;
constexpr size_t WS_VC = WS_KC + (size_t)8 * 256 * 128 * 2;
constexpr size_t WS_PSLC = WS_VC + (size_t)8 * 256 * 128 * 2;
constexpr size_t WS_ROUTE = WS_PSLC + (size_t)8 * 4096 * 64 * 4;
constexpr size_t WS_END = WS_ROUTE + (size_t)T * 8 * 3 + (size_t)MOE_ROWS * 4 + 4096;
constexpr size_t WS_SLAB = WS_MERGED;
constexpr size_t WS_ACT = WS_PROJ;
constexpr size_t WS_ACTM = WS_PROJ;
constexpr size_t WS_HG = WS_Y;
static_assert((size_t)MOE_ROWS * 2048 * 2 <= (size_t)T * LDY * 2 + (size_t)T * 2048 * 2, "HG alias");
static_assert((size_t)MOE_ROWS * DFFE * 2 <= SZ_PROJ, "ACTM alias");

constexpr int CW_BAR = 0;
constexpr int CW_DBG = 4096;
constexpr int CW_CNT = 8192;

constexpr int LDS_BYTES = 147456;
constexpr int LDS_MISC = 146432;
constexpr int SHM_K = 16384, SHM_V = 16384;
constexpr int ALS_OFF = 65536, TAB_OFF = 67584, KEYB_OFF = 71680, IMP_OFF = 73728;

struct Params { const float* in[N_IN]; float* out; unsigned char* ws; int ph_lo, ph_hi; };

typedef __bf16 bf16x2_t __attribute__((ext_vector_type(2)));
__device__ __forceinline__ unsigned cvt_pk_bf16(float lo, float hi) { const f32x2 v = {lo, hi}; const bf16x2_t b = __builtin_convertvector(v, bf16x2_t); return __builtin_bit_cast(unsigned, b); }
__device__ __forceinline__ float bf2f(bf16_t b) { return __uint_as_float(((unsigned)b) << 16); }
__device__ __forceinline__ float bflo(unsigned w) { return __uint_as_float(w << 16); }
__device__ __forceinline__ float bfhi(unsigned w) { return __uint_as_float(w & 0xffff0000u); }
__device__ __forceinline__ bf16_t f2bf(float f) { return (bf16_t)(cvt_pk_bf16(f, 0.f) & 0xffffu); }
__device__ __forceinline__ float sigmoidf_(float x) { return 1.f / (1.f + __expf(-x)); }
__device__ __forceinline__ int rfl(int v) { return __builtin_amdgcn_readfirstlane(v); }
__device__ __forceinline__ int tid_l() { int t = threadIdx.x; asm volatile("" : "+v"(t)); return t; }
__device__ __forceinline__ int bid_l() { int t = blockIdx.x; asm volatile("" : "+s"(t)); return t; }
__device__ __forceinline__ int gdim_l() { int t = gridDim.x; asm volatile("" : "+s"(t)); return t; }
typedef const __attribute__((address_space(4))) Params* KParams;
__device__ __forceinline__ Params load_params() { Params r;
#if defined(__HIP_DEVICE_COMPILE__)
    KParams k = (KParams)__builtin_amdgcn_kernarg_segment_ptr(); asm volatile("" : "+s"(k));
#pragma unroll
    for (int i = 0; i < N_IN; ++i) r.in[i] = k->in[i];
    r.out = k->out; r.ws = k->ws; r.ph_lo = k->ph_lo; r.ph_hi = k->ph_hi;
#endif
    return r; }
__device__ __forceinline__ float keep_or_ninf(float x, int keep) { const unsigned m = (unsigned)(keep >> 31); return __uint_as_float((__float_as_uint(x) & ~m) | (0xff800000u & m)); }

#define XB_TMO      128
#define XB_XCNT(j)  (256  + 64 * (j))
#define XB_XSUB(j)  (1280 + 64 * (j))
#define XB_XGEN(j)  (2304 + 64 * (j))
#define XB_TOP      3328
#define XB_TOPGEN   3392
#define XCD_BAR_WORDS 3456
#define XB_SPIN_CAP (1u << 23)
__device__ __forceinline__ unsigned xb_ld(unsigned* p)              { return __hip_atomic_load(p, __ATOMIC_RELAXED, __HIP_MEMORY_SCOPE_AGENT); }
__device__ __forceinline__ unsigned xb_add(unsigned* p, unsigned v) { return __hip_atomic_fetch_add(p, v, __ATOMIC_RELAXED, __HIP_MEMORY_SCOPE_AGENT); }
__device__ __forceinline__ unsigned xb_xcc_id() { return (unsigned)__builtin_amdgcn_s_getreg((3 << 11) | 20) & 0xFu; }
#define XB_SPIN(cond, bar) do { unsigned _sp = 0; while (cond) { __builtin_amdgcn_s_sleep(1); \
    if ((++_sp & 255u) == 0u) { if (xb_ld(&(bar)[XB_TMO])) break; if (_sp > XB_SPIN_CAP) { atomicAdd(&(bar)[XB_TMO], 1u); break; } } } } while (0)
struct XcdBarrier { unsigned* bar; unsigned x; volatile LAS unsigned* st; };
__device__ __forceinline__ XcdBarrier xcd_barrier_post(unsigned* bar, volatile LAS unsigned* st) {
    XcdBarrier b; b.bar = bar; b.x = xb_xcc_id(); b.st = st;
    if (threadIdx.x == 0) (void)xb_add(&bar[XB_XCNT(b.x)], 1u);
    return b;
}
__device__ __forceinline__ void xcd_barrier_complete(unsigned* bar, unsigned x, unsigned& nloc, unsigned& nx) {
    const unsigned G = gridDim.x * gridDim.y * gridDim.z;
    unsigned sum, cnt, mine, sp = 0u;
    for (;;) {
        sum = 0u; cnt = 0u; mine = 0u;
#pragma unroll
        for (unsigned j = 0; j < 16; ++j) { const unsigned c = xb_ld(&bar[XB_XCNT(j)]); sum += c; cnt += (c > 0u) ? 1u : 0u; mine = (j == x) ? c : mine; }
        if (sum == G) break;
        __builtin_amdgcn_s_sleep(1);
        if ((++sp & 255u) == 0u) { if (xb_ld(&bar[XB_TMO])) break; if (sp > XB_SPIN_CAP) { atomicAdd(&bar[XB_TMO], 1u); break; } }
    }
    nloc = mine > 0u ? mine : 1u; nx = cnt > 0u ? cnt : 1u;
}
__device__ __forceinline__ void xcd_barrier(const XcdBarrier& b) {
    asm volatile("s_waitcnt vmcnt(0)" ::: "memory");
    __syncthreads();
    if (threadIdx.x == 0) {
        unsigned* bar = b.bar; asm volatile("" : "+s"(bar));
        __builtin_amdgcn_s_waitcnt(0);
        unsigned nloc = b.st[0], nx = b.st[1];
        unsigned bx = b.x; asm volatile("" : "+s"(bx));
        if (nloc == 0u) { xcd_barrier_complete(bar, bx, nloc, nx); b.st[0] = nloc; b.st[1] = nx; }
        const unsigned old = xb_add(&bar[XB_XSUB(bx)], 1u);
        const unsigned gen = old / nloc;
        if (old + 1u == (gen + 1u) * nloc) {
            __builtin_amdgcn_fence(__ATOMIC_RELEASE, "agent");
            asm volatile("s_waitcnt vmcnt(0)" ::: "memory");
            const unsigned og = xb_add(&bar[XB_TOP], 1u);
            const unsigned tg = og / nx;
            if (og + 1u == (tg + 1u) * nx) xb_add(&bar[XB_TOPGEN], 1u);
            else XB_SPIN(xb_ld(&bar[XB_TOPGEN]) == tg, bar);
            __builtin_amdgcn_fence(__ATOMIC_ACQUIRE, "agent");
            xb_add(&bar[XB_XGEN(bx)], 1u);
            asm volatile("s_waitcnt vmcnt(0)" ::: "memory");
        } else {
            XB_SPIN(xb_ld(&bar[XB_XGEN(bx)]) == gen, bar);
            __builtin_amdgcn_fence(__ATOMIC_ACQUIRE, "agent");
            asm volatile("s_waitcnt vmcnt(0)" ::: "memory");
        }
    }
    __syncthreads();
}

__device__ __forceinline__ int t5_bucket(int dist) {
    dist = dist < 0 ? 0 : dist;
    if (dist < 16) return dist;
    const float lr = logf((float)dist * (1.0f / 16.0f)) * (1.0f / 4.852030263919617f);
    int large = 16 + (int)(lr * 16.0f);
    return large < 31 ? large : 31;
}
constexpr int PT_WIN = 0, PT_BR = PT_WIN + 2 * 32 * 128, PT_OUT = PT_BR + 2 * 40 * 16, PT_FU = PT_OUT + 2 * 32 * 16, PT_FD = PT_FU + 32 * 88,
              PT_MU = PT_FD + 88 * 16, PT_MD = PT_MU + 8 * 32 * 112, PT_C1 = PT_MD + 8 * 112 * 16, PT_C2 = PT_C1 + 4 * 64 * 2, PT_END = PT_C2 + 4 * 4;

__device__ __forceinline__ void prep_decode(const Params& p, int id, const float*& s, int& ld_s, bf16_t*& d, int& ld_d) {
    unsigned char* ws = p.ws;
    if (id < PT_BR) { const int l = id / 4096, r = id % 4096, kt = r / 128, nt = r % 128; const int n = nt * 128, sc = n + (n < 3072 ? 0 : (n < 10240 ? 8 : 32));
        s = p.in[IN_WIN] + (size_t)l * 2048 * D_IN + (size_t)(kt * 64) * D_IN + sc; ld_s = D_IN; d = (bf16_t*)(ws + WS_WIN + l * SZ_WIN) + (size_t)n * 2048 + kt * 64; ld_d = 2048; return; }
    if (id < PT_OUT) { id -= PT_BR; const int l = id / 640, r = id % 640, kt = r / 16, nt = r % 16;
        const float* src = kt < 16 ? p.in[IN_WBA] + (size_t)l * 1024 * 2048 + (size_t)(kt * 64) * 2048
                         : kt < 24 ? p.in[IN_WBB] + (size_t)l * 512 * 2048 + (size_t)((kt - 16) * 64) * 2048
                                   : p.in[IN_WBC] + (size_t)l * 1024 * 2048 + (size_t)((kt - 24) * 64) * 2048;
        s = src + nt * 128; ld_s = 2048; d = (bf16_t*)(ws + WS_WBR + l * SZ_WBR) + (size_t)(nt * 128) * 2560 + kt * 64; ld_d = 2560; return; }
    if (id < PT_FU) { id -= PT_OUT; const int l = id / 512, r = id % 512, kt = r / 16, nt = r % 16;
        s = p.in[IN_WOUT] + (size_t)l * 2048 * 2048 + (size_t)(kt * 64) * 2048 + nt * 128; ld_s = 2048; d = (bf16_t*)(ws + WS_WOUT + l * SZ_WOUT) + (size_t)(nt * 128) * 2048 + kt * 64; ld_d = 2048; return; }
    if (id < PT_FD) { id -= PT_FU; const int kt = id / 88, nt = id % 88;
        s = ((nt & 1) ? p.in[IN_FU] : p.in[IN_FG]) + (size_t)(kt * 64) * DFF + (nt >> 1) * 128; ld_s = DFF; d = (bf16_t*)(ws + WS_WFU) + (size_t)(nt * 128) * 2048 + kt * 64; ld_d = 2048; return; }
    if (id < PT_MU) { id -= PT_FD; const int kt = id / 16, nt = id % 16;
        s = p.in[IN_FD] + (size_t)(kt * 64) * 2048 + nt * 128; ld_s = 2048; d = (bf16_t*)(ws + WS_WFD) + (size_t)(nt * 128) * DFF + kt * 64; ld_d = DFF; return; }
    if (id < PT_MD) { id -= PT_MU; const int e = id / 3584, r = id % 3584, kt = r / 112, nt = r % 112;
        s = ((nt & 1) ? p.in[IN_MU] : p.in[IN_MG]) + (size_t)e * 2048 * DFFE + (size_t)(kt * 64) * DFFE + (nt >> 1) * 128; ld_s = DFFE;
        d = (bf16_t*)(ws + WS_WMU + e * SZ_WMU1) + (size_t)(nt * 128) * 2048 + kt * 64; ld_d = 2048; return; }
    if (id < PT_C1) { id -= PT_MD; const int e = id / 1792, r = id % 1792, kt = r / 16, nt = r % 16;
        s = p.in[IN_MD] + (size_t)e * DFFE * 2048 + (size_t)(kt * 64) * 2048 + nt * 128; ld_s = 2048; d = (bf16_t*)(ws + WS_WMD + e * SZ_WMD1) + (size_t)(nt * 128) * DFFE + kt * 64; ld_d = DFFE; return; }
    if (id < PT_C2) { id -= PT_C1; const int j = id / 128, r = id % 128, kt = r / 2, nt = r % 2; const int l = j >> 1, kv = j & 1;
        s = p.in[kv ? IN_W1V : IN_W1K] + (size_t)l * 4096 * 256 + (size_t)(kt * 64) * 256 + nt * 128; ld_s = 256; d = (bf16_t*)(ws + WS_WC1 + j * SZ_WC1) + (size_t)(nt * 128) * 4096 + kt * 64; ld_d = 4096; return; }
    { id -= PT_C2; const int j = id / 4, kt = id % 4; const int l = j >> 1, kv = j & 1;
        s = p.in[kv ? IN_W2V : IN_W2K] + (size_t)l * 256 * 128 + (size_t)(kt * 64) * 128; ld_s = 128; d = (bf16_t*)(ws + WS_WC2 + j * SZ_WC2) + kt * 64; ld_d = 256; return; }
}

__device__ __forceinline__ void phase_prep(const Params& p, LAS unsigned char* lds) {
    const int tid = tid_l(), G = gdim_l();
    LAS float* sm = (LAS float*)lds;
    const int lk = tid >> 5, ln = (tid & 31) * 4;
    const int wn = tid & 127, wk = (tid >> 7) * 16;
    f32x4 v[4];
    const float* s; int ld_s; bf16_t* d; int ld_d;
    int id = bid_l();
    if (id < PT_END) { prep_decode(p, id, s, ld_s, d, ld_d);
#pragma unroll
        for (int i = 0; i < 4; ++i) v[i] = *(const f32x4*)(s + (size_t)(lk + 16 * i) * ld_s + ln); }
    for (; id < PT_END; id += G) {
#pragma unroll
        for (int i = 0; i < 4; ++i) *(LAS f32x4*)(sm + (lk + 16 * i) * 132 + ln) = v[i];
        bf16_t* dcur = d; const int ldc = ld_d;
        const int nid = id + G;
        if (nid < PT_END) { prep_decode(p, nid, s, ld_s, d, ld_d);
#pragma unroll
            for (int i = 0; i < 4; ++i) v[i] = *(const f32x4*)(s + (size_t)(lk + 16 * i) * ld_s + ln); }
        __syncthreads();
        unsigned w[8];
#pragma unroll
        for (int j = 0; j < 8; ++j) w[j] = cvt_pk_bf16(sm[(wk + 2 * j) * 132 + wn], sm[(wk + 2 * j + 1) * 132 + wn]);
        bf16_t* dp = dcur + (size_t)wn * ldc + wk;
        *(u32x4*)dp = (u32x4){w[0], w[1], w[2], w[3]};
        *(u32x4*)(dp + 8) = (u32x4){w[4], w[5], w[6], w[7]};
        __syncthreads();
    }
    const int gt = bid_l() * 512 + tid;
    for (int i = gt; i < 2 * 32 * 2048; i += G * 512) { const int l = i >> 16, r = (i >> 11) & 31, k = i & 2047; const int sc = r < 8 ? 3072 + r : 10248 + (r - 8);
        ((bf16_t*)(p.ws + WS_WG32))[i] = f2bf(p.in[IN_WIN][(size_t)l * 2048 * D_IN + (size_t)k * D_IN + sc]); }
    { const int wv = gt >> 6, lane = tid & 63;
      if (wv < 1024) { const int j = wv >> 8, n = wv & 255, l = j >> 1, kv = j & 1;
        const float* pe = p.in[kv ? IN_PEV : IN_PEK] + (size_t)l * 4096; const float* w1 = p.in[kv ? IN_W1V : IN_W1K] + (size_t)l * 4096 * 256 + n;
        float a = 0.f; for (int k = lane; k < 4096; k += 64) a += pe[k] * w1[(size_t)k * 256];
        for (int o = 32; o >= 1; o >>= 1) a += __shfl_xor(a, o);
        if (lane == 0) ((float*)(p.ws + WS_CB1))[wv] = a; } }
}

template <bool ROUTE>
__device__ __forceinline__ void phase_norm(const Params& p, const float* x, const float* g, bf16_t* h, LAS unsigned char* lds) {
    const int tid = tid_l(), wid = tid >> 6, lane = tid & 63;
    LAS int* cnt = (LAS int*)lds;
    if (ROUTE) { if (tid < 8) cnt[tid] = 0; __syncthreads(); }
    const unsigned vo16 = (unsigned)lane * 16u, vo128 = (unsigned)lane * 128u;
    for (int rb = bid_l(); rb < T / 64; rb += gdim_l()) {
#pragma unroll 1
        for (int i = 0; i < 8; ++i) {
            const int row = rb * 64 + wid * 8 + i;
            const char* xr = (const char*)(x + (size_t)row * 2048);
            f32x4 v[8]; float ss = 0.f;
#pragma unroll
            for (int j = 0; j < 8; ++j) { v[j] = *(const f32x4*)(xr + j * 1024 + vo16); ss += v[j][0] * v[j][0] + v[j][1] * v[j][1] + v[j][2] * v[j][2] + v[j][3] * v[j][3]; }
            for (int o = 32; o >= 1; o >>= 1) ss += __shfl_xor(ss, o);
            const float inv = rsqrtf(ss * (1.0f / 2048.0f) + RMS_EPS);
            float lg[8] = {0.f, 0.f, 0.f, 0.f, 0.f, 0.f, 0.f, 0.f};
#pragma unroll
            for (int j = 0; j < 8; ++j) { const f32x4 gv = *(const f32x4*)((const char*)g + j * 1024 + vo16); const f32x4 y = v[j] * inv * gv;
                u32x2 w; w.x = cvt_pk_bf16(y[0], y[1]); w.y = cvt_pk_bf16(y[2], y[3]);
                *(u32x2*)(h + (size_t)row * 2048 + (lane + 64 * j) * 4) = w;
                if (ROUTE) { const char* rw = (const char*)p.in[IN_ROUTER] + j * 8192;
#pragma unroll
                    for (int q = 0; q < 4; ++q) { const f32x4 a = *(const f32x4*)(rw + vo128 + q * 32), b = *(const f32x4*)(rw + vo128 + q * 32 + 16);
                        lg[0] += y[q] * a[0]; lg[1] += y[q] * a[1]; lg[2] += y[q] * a[2]; lg[3] += y[q] * a[3];
                        lg[4] += y[q] * b[0]; lg[5] += y[q] * b[1]; lg[6] += y[q] * b[2]; lg[7] += y[q] * b[3]; }
                    asm volatile("" ::: "memory"); } }
            if (ROUTE) {
#pragma unroll
                for (int e = 0; e < 8; ++e) for (int o = 32; o >= 1; o >>= 1) lg[e] += __shfl_xor(lg[e], o);
                if (lane == 0) {
                    int e0 = 0; float v0 = lg[0];
#pragma unroll
                    for (int e = 1; e < 8; ++e) if (lg[e] > v0) { v0 = lg[e]; e0 = e; }
                    int e1 = -1; float v1 = -__builtin_inff();
#pragma unroll
                    for (int e = 0; e < 8; ++e) if (e != e0 && lg[e] > v1) { v1 = lg[e]; e1 = e; }
                    const float w0 = 1.f / (1.f + expf(v1 - v0)), w1 = 1.f - w0;
                    int* toke = (int*)(p.ws + WS_ROUTE); float* tokw = (float*)(p.ws + WS_ROUTE + (size_t)T * 8);
                    toke[row * 2] = e0; toke[row * 2 + 1] = e1; tokw[row * 2] = w0; tokw[row * 2 + 1] = w1;
                    atomicAdd((int*)&cnt[e0], 1); atomicAdd((int*)&cnt[e1], 1);
                }
            }
        }
        if (ROUTE) { __syncthreads(); if (tid < 8) { ((int*)(p.ws + WS_CTL))[CW_CNT + rb * 8 + tid] = cnt[tid]; cnt[tid] = 0; } __syncthreads(); }
    }
}

__device__ __forceinline__ void phase_final(const Params& p, const float* g, float* dst) {
    const int tid = tid_l(), wid = tid >> 6, lane = tid & 63;
    const int* slot = (const int*)(p.ws + WS_ROUTE + (size_t)T * 16);
    const bf16_t* om = (const bf16_t*)(p.ws + WS_HG);
    f32x4 gv[8];
#pragma unroll
    for (int j = 0; j < 8; ++j) gv[j] = ((const f32x4*)g)[lane + 64 * j];
    for (int rb = bid_l(); rb < T / 64; rb += gdim_l()) {
#pragma unroll 1
        for (int i = 0; i < 8; ++i) {
            const int row = rb * 64 + wid * 8 + i;
            const int s0 = __hip_atomic_load(slot + row * 2, __ATOMIC_RELAXED, __HIP_MEMORY_SCOPE_AGENT), s1 = __hip_atomic_load(slot + row * 2 + 1, __ATOMIC_RELAXED, __HIP_MEMORY_SCOPE_AGENT);
            f32x4* xr = (f32x4*)(p.out + (size_t)row * 2048);
            const u32x2* o0 = (const u32x2*)(om + (size_t)s0 * 2048); const u32x2* o1 = (const u32x2*)(om + (size_t)s1 * 2048);
            f32x4 v[8]; float ss = 0.f;
#pragma unroll
            for (int j = 0; j < 8; ++j) { v[j] = xr[lane + 64 * j];
                const unsigned long long a_ = __hip_atomic_load((const unsigned long long*)(o0 + lane + 64 * j), __ATOMIC_RELAXED, __HIP_MEMORY_SCOPE_AGENT), b_ = __hip_atomic_load((const unsigned long long*)(o1 + lane + 64 * j), __ATOMIC_RELAXED, __HIP_MEMORY_SCOPE_AGENT);
                const u32x2 a = {(unsigned)a_, (unsigned)(a_ >> 32)}, b = {(unsigned)b_, (unsigned)(b_ >> 32)};
                v[j][0] += bflo(a.x) + bflo(b.x); v[j][1] += bfhi(a.x) + bfhi(b.x); v[j][2] += bflo(a.y) + bflo(b.y); v[j][3] += bfhi(a.y) + bfhi(b.y);
                ss += v[j][0] * v[j][0] + v[j][1] * v[j][1] + v[j][2] * v[j][2] + v[j][3] * v[j][3]; }
            for (int o = 32; o >= 1; o >>= 1) ss += __shfl_xor(ss, o);
            const float inv = rsqrtf(ss * (1.0f / 2048.0f) + RMS_EPS);
#pragma unroll
            for (int j = 0; j < 8; ++j) ((f32x4*)(dst + (size_t)row * 2048))[lane + 64 * j] = v[j] * inv * gv[j];
        }
    }
}

__device__ __forceinline__ void moe_offsets(const Params& p, LAS int* sm  , int& nrt) {
    const int tid = tid_l();
    const int* cnt = (const int*)(p.ws + WS_CTL) + CW_CNT;
    for (int i = tid; i < 2048; i += 512) sm[i] = cnt[i];
    __syncthreads();
    if (tid < 8) { int s = 0; for (int c = 0; c < 256; ++c) s += sm[c * 8 + tid]; sm[2048 + tid] = s; }
    __syncthreads();
    if (tid == 0) { int off = 0; for (int e = 0; e < 8; ++e) { sm[2056 + e] = off; off += (sm[2048 + e] + 255) & ~255; } sm[2064] = off; }
    __syncthreads();
    nrt = sm[2064] >> 8;
}
__device__ __forceinline__ void phase_moe_scatter(const Params& p, LAS unsigned char* lds) {
    const int tid = tid_l(), wid = tid >> 6, lane = tid & 63;
    LAS int* sm = (LAS int*)lds; int nrt; moe_offsets(p, sm, nrt);
    const int* toke = (const int*)(p.ws + WS_ROUTE); const float* tokw = (const float*)(p.ws + WS_ROUTE + (size_t)T * 8);
    int* slot = (int*)(p.ws + WS_ROUTE + (size_t)T * 16); float* roww = (float*)(p.ws + WS_ROUTE + (size_t)T * 24);
    const bf16_t* h2 = (const bf16_t*)(p.ws + WS_H); bf16_t* hg = (bf16_t*)(p.ws + WS_HG);
    LAS int* ls = sm + 2080;
    for (int c = bid_l(); c < 256; c += gdim_l()) {
        if (tid < 8) { const int e = tid; int base = sm[2056 + e]; for (int cc = 0; cc < c; ++cc) base += sm[cc * 8 + e];
            for (int t = 0; t < 64; ++t) { const int tok = c * 64 + t;
#pragma unroll
                for (int k = 0; k < 2; ++k) if (toke[tok * 2 + k] == e) { ls[t * 2 + k] = base; slot[tok * 2 + k] = base; roww[base] = tokw[tok * 2 + k]; ++base; } } }
        __syncthreads();
        for (int r = wid; r < 128; r += 8) { const int tok = c * 64 + (r >> 1); const int s = ls[r];
            const u32x4* src = (const u32x4*)(h2 + (size_t)tok * 2048); u32x4* dst = (u32x4*)(hg + (size_t)s * 2048);
#pragma unroll
            for (int j = 0; j < 4; ++j) dst[lane + 64 * j] = src[lane + 64 * j]; }
        __syncthreads();
    }
    if (bid_l() == 0 && tid < 8) { const int e = tid; const int b = sm[2056 + e] + sm[2048 + e], en = sm[2056 + e] + ((sm[2048 + e] + 255) & ~255); for (int r = b; r < en; ++r) roww[r] = 0.f; }
}

__device__ __forceinline__ void phase_fox_cumsum(const Params& p, int layer) {
    const int gw = (bid_l() * 512 + tid_l()) >> 6, lane = tid_l() & 63;
    const int nw = (gdim_l() * 512) >> 6;
    const float* gates = (const float*)(p.ws + WS_GATES); float* cneg = (float*)(p.ws + WS_CNEG);
    for (int s = gw; s < 32; s += nw) { const int b = s >> 3, hh = s & 7; const float fb = p.in[IN_FOXB][layer * 8 + hh];
        float tot = 0.f;
        for (int j = 0; j < 64; ++j) { const float x = gates[(size_t)(b * SEQ + lane * 64 + j) * 32 + hh] + fb; tot += fminf(x, 0.f) - log1pf(expf(-fabsf(x))); }
        float inc = tot;
        for (int o = 1; o < 64; o <<= 1) { const float t = __shfl_up(inc, o); if (lane >= o) inc += t; }
        float run = inc - tot;
        for (int j = 0; j < 64; ++j) { const float x = gates[(size_t)(b * SEQ + lane * 64 + j) * 32 + hh] + fb; run += fminf(x, 0.f) - log1pf(expf(-fabsf(x)));
            cneg[(size_t)s * SEQ + lane * 64 + j] = -run * (1.0f / SM_SCALE); } }
}

__device__ __forceinline__ void phase_gates(const Params& p, int layer) {
    const int gw = (bid_l() * 512 + tid_l()) >> 6, lane = tid_l() & 63, nw = (gdim_l() * 512) >> 6;
    const bf16_t* h = (const bf16_t*)(p.ws + WS_H); const bf16_t* w = (const bf16_t*)(p.ws + WS_WG32 + layer * SZ_WG32);
    float* gates = (float*)(p.ws + WS_GATES);
    const int fr = lane & 15, fq = lane >> 4;
    for (int u = gw; u < T / 16; u += nw) {
        f32x4 a0 = {0.f, 0.f, 0.f, 0.f}, a1 = {0.f, 0.f, 0.f, 0.f};
        const bf16_t* ap = h + (size_t)(u * 16 + fr) * 2048 + fq * 8; const bf16_t* b0 = w + (size_t)fr * 2048 + fq * 8; const bf16_t* b1 = w + (size_t)(16 + fr) * 2048 + fq * 8;
#pragma unroll 8
        for (int ks = 0; ks < 64; ++ks) { const bf16x8 a = *(const bf16x8*)(ap + ks * 32), x0 = *(const bf16x8*)(b0 + ks * 32), x1 = *(const bf16x8*)(b1 + ks * 32);
            a0 = __builtin_amdgcn_mfma_f32_16x16x32_bf16(a, x0, a0, 0, 0, 0); a1 = __builtin_amdgcn_mfma_f32_16x16x32_bf16(a, x1, a1, 0, 0, 0); }
#pragma unroll
        for (int i = 0; i < 4; ++i) { float* o = gates + (size_t)(u * 16 + fq * 4 + i) * 32 + fr; o[0] = a0[i]; o[16] = a1[i]; }
    }
}
namespace pg8 {
constexpr int BM = 256, BK = 64, HALF = 128, HTB = HALF * BK * 2, STAGE_BYTES = 8 * HTB, NXCD = 8, WGM = 8;
__device__ __forceinline__ int lds_byte(int r, int c) { const int st = (r >> 4) * 2 + (c >> 5), rr = r & 15, cc = c & 31, ob = rr * 64 + cc * 2; return st * 1024 + (ob ^ (((ob >> 9) & 1) << 5)); }
__device__ __forceinline__ void stage_rc(int b, int& R, int& C) { const int st = b / 1024, sb = b % 1024, swz = sb ^ (((sb >> 9) & 1) << 5); R = (st >> 1) * 16 + swz / 64; C = (st & 1) * 32 + (swz % 64) / 2; }
__device__ __forceinline__ int perm32(int rho) { const int n = rho >> 4, i = rho & 15; return 8 * (i >> 2) + 4 * n + (i & 3); }

struct GUnit { size_t aoff, boff; int row0, col0, aux; };
struct GemmP { const char* A; const char* B; unsigned rsB; size_t ks2A; int nt; };
struct LinRow { unsigned rs; __device__ __forceinline__ unsigned operator()(int R) const { return (unsigned)R * rs; } };

__device__ __forceinline__ bool static_tile(int i, int G, int c, int nM, int nN, int& pm, int& pn) {
    const int nwg = nM * nN; const long L = (long)i * G + c; if (L >= nwg) return false;
    int wgid = (int)L; { const int q = nwg / NXCD, r = nwg % NXCD, xcd = wgid % NXCD, off = wgid / NXCD; wgid = (xcd < r ? xcd * (q + 1) : r * (q + 1) + (xcd - r) * q) + off; }
    const int nig = WGM * nN, gid = wgid / nig, fm = gid * WGM, gsz = (nM - fm) < WGM ? (nM - fm) : WGM;
    pm = fm + ((wgid % nig) % gsz); pn = (wgid % nig) / gsz; return true;
}
struct StaticOrder {
    int nM, nN, G, c; size_t tsA, tsB;
    __device__ __forceinline__ bool next(int i, GUnit& u) const { int pm, pn; if (!static_tile(i, G, c, nM, nN, pm, pn)) return false;
        u.aoff = (size_t)pm * tsA; u.boff = (size_t)pn * tsB; u.row0 = pm * BM; u.col0 = pn * BM; u.aux = 0; return true; }
};

template <class Epi, class Sched, class RowA>
__device__ __forceinline__ void gemm_phase(LAS unsigned char* lds, const GemmP g, const Sched& S, const Epi& E, const RowA& rowA) {
    const int tid = tid_l(), wid = __builtin_amdgcn_readfirstlane(tid >> 6), lane = tid & 63, wr = wid >> 2, wc = wid & 3, fr = lane & 15, fq = lane >> 4;
    const int nt = g.nt;
    unsigned voffA[2], voffB[2];
#pragma unroll
    for (int i = 0; i < 2; ++i) { int R, C; stage_rc(tid * 16 + i * 8192, R, C); const int Rb = Epi::PERM ? ((R & ~31) + perm32(R & 31)) : R;
        voffA[i] = rowA(R) + (unsigned)C * 2u; voffB[i] = (unsigned)Rb * g.rsB + (unsigned)C * 2u; }
    const size_t hstepA = (size_t)rowA(HALF), hstepB = (size_t)HALF * g.rsB;
    const size_t ks2A = g.ks2A;
    const unsigned ldsw = (unsigned)wid * 1024u;
    const int aoff = lds_byte(wr * 64 + fr, fq * 8), boff = lds_byte(wc * 32 + fr, fq * 8);
#define PG8_SA(b, h) (((b) * 2 + (h)) * HTB)
#define PG8_SB(b, h) ((4 + (b) * 2 + (h)) * HTB)
#define PG8_STAGE(bufoff, gbase, voff) do { _Pragma("unroll") for (int _i = 0; _i < 2; ++_i) \
        __builtin_amdgcn_global_load_lds((const unsigned*)((const char*)(gbase) + (voff)[_i]), (LAS unsigned*)(lds + (bufoff) + ldsw + _i * 8192), 16, 0, 0); } while (0)
#define PG8_LDA(dst, b, h) do { _Pragma("unroll") for (int m = 0; m < 4; ++m) _Pragma("unroll") for (int k = 0; k < 2; ++k) dst[m][k] = *(const LAS bf16x8*)(lds + PG8_SA(b, h) + aoff + m * 2048 + k * 1024); } while (0)
#define PG8_LDB(dst, b, h) do { _Pragma("unroll") for (int n = 0; n < 2; ++n) _Pragma("unroll") for (int k = 0; k < 2; ++k) dst[n][k] = *(const LAS bf16x8*)(lds + PG8_SB(b, h) + boff + n * 2048 + k * 1024); } while (0)
#define PG8_MMA(ai, bj, At, Bt) do { __builtin_amdgcn_s_setprio(1); _Pragma("unroll") for (int m = 0; m < 4; ++m) _Pragma("unroll") for (int n = 0; n < 2; ++n) _Pragma("unroll") for (int k = 0; k < 2; ++k) \
        acc[ai][bj][m][n] = __builtin_amdgcn_mfma_f32_16x16x32_bf16(Bt[n][k], At[m][k], acc[ai][bj][m][n], 0, 0, 0); __builtin_amdgcn_s_setprio(0); } while (0)
#define PG8_WAIT_V(n) asm volatile("s_waitcnt vmcnt(" #n ")" ::: "memory")
#define PG8_WAIT_L(n) asm volatile("s_waitcnt lgkmcnt(" #n ")" ::: "memory")
#define PG8_BAR __builtin_amdgcn_s_barrier()
#define PG8_SCHED __builtin_amdgcn_sched_barrier(0)
    GUnit cur, nxt; int ui = 0;
    if (!S.next(0, cur)) return;
    f32x4 acc[2][2][4][2];
#pragma unroll
    for (int a = 0; a < 2; ++a)
#pragma unroll
        for (int b = 0; b < 2; ++b)
#pragma unroll
            for (int m = 0; m < 4; ++m)
#pragma unroll
                for (int n = 0; n < 2; ++n) acc[a][b][m][n] = (f32x4){0.f, 0.f, 0.f, 0.f};
    bf16x8 At[4][2], B0[2][2], B1[2][2];
    const char* cA = g.A + cur.aoff; const char* cB = g.B + cur.boff;
    PG8_STAGE(PG8_SB(0, 0), cB, voffB); PG8_STAGE(PG8_SA(0, 0), cA, voffA); PG8_STAGE(PG8_SB(0, 1), cB + hstepB, voffB); PG8_STAGE(PG8_SA(0, 1), cA + hstepA, voffA);
    if (wr == 1) PG8_BAR;
    PG8_WAIT_V(4); PG8_BAR;
    PG8_STAGE(PG8_SB(1, 0), cB + 128, voffB); PG8_STAGE(PG8_SA(1, 0), cA + 128, voffA); PG8_STAGE(PG8_SB(1, 1), cB + hstepB + 128, voffB);
    PG8_WAIT_V(6); PG8_BAR;
    for (;;) {
        const bool has_next = S.next(ui + 1, nxt);
        const char* nA = has_next ? g.A + nxt.aoff : cA; const char* nB = has_next ? g.B + nxt.boff : cB;
        for (int t = 0; t < nt; t += 2) {
            const bool last = (t == nt - 2);
            if constexpr (Epi::NHOOK > 0) { if (t == Epi::H1 || t == Epi::H2) E.hook(acc, cur, t, wr, wc, fr, fq); }
            const char* a1 = cA + (size_t)(t >> 1) * ks2A + 128;
            const char* a2 = last ? nA : cA + (size_t)((t >> 1) + 1) * ks2A; const char* b2 = last ? nB : cB + (size_t)(t + 2) * 128;
            const char* a3 = a2 + 128; const char* b3 = b2 + 128;
            PG8_LDB(B0, 0, 0); PG8_SCHED; PG8_LDA(At, 0, 0); PG8_STAGE(PG8_SA(1, 1), a1 + hstepA, voffA);
            PG8_WAIT_L(8); PG8_BAR; PG8_WAIT_L(0); PG8_MMA(0, 0, At, B0); PG8_BAR; PG8_SCHED;
            PG8_LDB(B1, 0, 1); PG8_STAGE(PG8_SB(0, 0), b2, voffB);
            PG8_BAR; PG8_WAIT_L(0); PG8_MMA(0, 1, At, B1); PG8_BAR;
            PG8_LDA(At, 0, 1); PG8_STAGE(PG8_SA(0, 0), a2, voffA);
            PG8_BAR; PG8_WAIT_L(0); PG8_MMA(1, 0, At, B0); PG8_BAR; PG8_SCHED;
            PG8_STAGE(PG8_SB(0, 1), b2 + hstepB, voffB);
            PG8_WAIT_V(6); PG8_BAR; PG8_MMA(1, 1, At, B1); PG8_BAR;
            PG8_LDB(B0, 1, 0); PG8_SCHED; PG8_LDA(At, 1, 0); PG8_STAGE(PG8_SA(0, 1), a2 + hstepA, voffA);
            PG8_WAIT_L(8); PG8_BAR; PG8_WAIT_L(0); PG8_MMA(0, 0, At, B0); PG8_BAR; PG8_SCHED;
            PG8_LDB(B1, 1, 1); PG8_STAGE(PG8_SB(1, 0), b3, voffB);
            PG8_BAR; PG8_WAIT_L(0); PG8_MMA(0, 1, At, B1); PG8_BAR;
            PG8_LDA(At, 1, 1); PG8_STAGE(PG8_SA(1, 0), a3, voffA);
            PG8_BAR; PG8_WAIT_L(0); PG8_MMA(1, 0, At, B0); PG8_BAR; PG8_SCHED;
            PG8_STAGE(PG8_SB(1, 1), b3 + hstepB, voffB);
            PG8_WAIT_V(6); PG8_BAR; PG8_MMA(1, 1, At, B1); PG8_BAR;
        }
        E(acc, cur, wr, wc, fr, fq);
        if (!has_next) break;
#pragma unroll
        for (int a = 0; a < 2; ++a)
#pragma unroll
            for (int b = 0; b < 2; ++b)
#pragma unroll
                for (int m = 0; m < 4; ++m)
#pragma unroll
                    for (int n = 0; n < 2; ++n) acc[a][b][m][n] = (f32x4){0.f, 0.f, 0.f, 0.f};
        cur = nxt; cA = nA; cB = nB; ++ui;
    }
    PG8_WAIT_V(0);
    if (wr == 0) PG8_BAR;
    PG8_BAR;
#undef PG8_SA
#undef PG8_SB
#undef PG8_STAGE
#undef PG8_LDA
#undef PG8_LDB
#undef PG8_MMA
#undef PG8_WAIT_V
#undef PG8_WAIT_L
#undef PG8_BAR
#undef PG8_SCHED
}

struct EpiBf16 {
    static constexpr bool PERM = true; static constexpr int NHOOK = 0, H1 = -1, H2 = -1;
    bf16_t* O; int ldc;
    __device__ __forceinline__ void operator()(const f32x4 (&acc)[2][2][4][2], const GUnit& u, int wr, int wc, int fr, int fq) const {
        const int row0 = u.row0 + wr * 64 + fr, col0 = u.col0 + wc * 32 + 8 * fq;
#pragma unroll
        for (int ai = 0; ai < 2; ++ai)
#pragma unroll
            for (int m = 0; m < 4; ++m) { bf16_t* rowp = O + (size_t)(row0 + ai * HALF + m * 16) * ldc + col0;
#pragma unroll
                for (int bj = 0; bj < 2; ++bj) { const f32x4 v0 = acc[ai][bj][m][0], v1 = acc[ai][bj][m][1];
                    u32x4 w; w.x = cvt_pk_bf16(v0[0], v0[1]); w.y = cvt_pk_bf16(v0[2], v0[3]); w.z = cvt_pk_bf16(v1[0], v1[1]); w.w = cvt_pk_bf16(v1[2], v1[3]);
                    *(u32x4*)(rowp + bj * HALF) = w; } }
    }
};
struct EpiSilu {
    static constexpr bool PERM = true; static constexpr int NHOOK = 0, H1 = -1, H2 = -1;
    bf16_t* O; int ldc;
    __device__ __forceinline__ void operator()(const f32x4 (&acc)[2][2][4][2], const GUnit& u, int wr, int wc, int fr, int fq) const {
        const int row0 = u.row0 + wr * 64 + fr, col0 = (u.col0 >> 1) + wc * 32 + 8 * fq;
#pragma unroll
        for (int ai = 0; ai < 2; ++ai)
#pragma unroll
            for (int m = 0; m < 4; ++m) { bf16_t* rowp = O + (size_t)(row0 + ai * HALF + m * 16) * ldc + col0;
                float r[8];
#pragma unroll
                for (int n = 0; n < 2; ++n)
#pragma unroll
                    for (int i = 0; i < 4; ++i) { const float gg = acc[ai][0][m][n][i], uu = acc[ai][1][m][n][i]; r[n * 4 + i] = gg * uu / (1.f + __expf(-gg)); }
                u32x4 w; w.x = cvt_pk_bf16(r[0], r[1]); w.y = cvt_pk_bf16(r[2], r[3]); w.z = cvt_pk_bf16(r[4], r[5]); w.w = cvt_pk_bf16(r[6], r[7]);
                *(u32x4*)rowp = w; }
    }
};
struct EpiRes {
    static constexpr bool PERM = false; static constexpr int NHOOK = 0, H1 = -1, H2 = -1;
    const float* base; float* out;
    __device__ __forceinline__ void operator()(const f32x4 (&acc)[2][2][4][2], const GUnit& u, int wr, int wc, int fr, int fq) const {
        const int row0 = u.row0 + wr * 64 + fr, col0 = u.col0 + wc * 32 + 4 * fq;
#pragma unroll
        for (int ai = 0; ai < 2; ++ai)
#pragma unroll
            for (int m = 0; m < 4; ++m) { const size_t off = (size_t)(row0 + ai * HALF + m * 16) * 2048 + col0;
#pragma unroll
                for (int bj = 0; bj < 2; ++bj)
#pragma unroll
                    for (int n = 0; n < 2; ++n) { const f32x4 bs = *(const f32x4*)(base + off + bj * HALF + n * 16); *(f32x4*)(out + off + bj * HALF + n * 16) = bs + acc[ai][bj][m][n]; } }
    }
};
struct EpiSlab {
    static constexpr bool PERM = false; static constexpr int NHOOK = 0, H1 = -1, H2 = -1;
    float* slab;
    __device__ __forceinline__ void operator()(const f32x4 (&acc)[2][2][4][2], const GUnit& u, int wr, int wc, int fr, int fq) const {
        const int row0 = u.row0 + wr * 64 + fr, col0 = wc * 32 + 4 * fq;
        float* sb = slab + (size_t)u.aux * 2048 * 256;
#pragma unroll
        for (int ai = 0; ai < 2; ++ai)
#pragma unroll
            for (int m = 0; m < 4; ++m) { float* rowp = sb + (size_t)(row0 + ai * HALF + m * 16) * 256 + col0;
#pragma unroll
                for (int bj = 0; bj < 2; ++bj)
#pragma unroll
                    for (int n = 0; n < 2; ++n) *(f32x4*)(rowp + bj * HALF + n * 16) = acc[ai][bj][m][n]; }
    }
};
struct EpiBranch {
    static constexpr bool PERM = true; static constexpr int NHOOK = 2, H1 = 16, H2 = 24;
    const bf16_t* proj; bf16_t* O;
    __device__ __forceinline__ void scale(f32x4 (&acc)[2][2][4][2], const GUnit& u, int mode, int wr, int wc, int fr, int fq) const {
        const unsigned voff = (unsigned)(fr * LDP + 8 * fq) * 2u;
#pragma unroll
        for (int ai = 0; ai < 2; ++ai)
#pragma unroll
            for (int m = 0; m < 4; ++m) { const char* gp = (const char*)(proj + (size_t)(u.row0 + wr * 64 + ai * HALF + m * 16) * LDP + PC_MERGE + u.col0 + wc * 32);
#pragma unroll
                for (int bj = 0; bj < 2; ++bj)
#pragma unroll
                    for (int n = 0; n < 2; ++n) {
                        f32x4 f;
                        if (mode == 2) { const u32x2 z = *(const u32x2*)(gp + (2 * 2048 + bj * HALF + 4 * n) * 2 + voff);
                            f[0] = 1.f / (1.f + __expf(-bflo(z.x))); f[1] = 1.f / (1.f + __expf(-bfhi(z.x))); f[2] = 1.f / (1.f + __expf(-bflo(z.y))); f[3] = 1.f / (1.f + __expf(-bfhi(z.y))); }
                        else { const u32x2 za = *(const u32x2*)(gp + (mode * 2048 + bj * HALF + 4 * n) * 2 + voff), zb = *(const u32x2*)(gp + ((mode + 1) * 2048 + bj * HALF + 4 * n) * 2 + voff);
                            f[0] = (1.f + __expf(-bflo(zb.x))) / (1.f + __expf(-bflo(za.x))); f[1] = (1.f + __expf(-bfhi(zb.x))) / (1.f + __expf(-bfhi(za.x)));
                            f[2] = (1.f + __expf(-bflo(zb.y))) / (1.f + __expf(-bflo(za.y))); f[3] = (1.f + __expf(-bfhi(zb.y))) / (1.f + __expf(-bfhi(za.y))); }
                        acc[ai][bj][m][n] *= f;
                        asm volatile("" : "+v"(acc[ai][bj][m][n]) :: "memory");
                    } }
    }
    __device__ __forceinline__ void hook(f32x4 (&acc)[2][2][4][2], const GUnit& u, int t, int wr, int wc, int fr, int fq) const { scale(acc, u, t == 16 ? 0 : 1, wr, wc, fr, fq); }
    __device__ __forceinline__ void operator()(f32x4 (&acc)[2][2][4][2], const GUnit& u, int wr, int wc, int fr, int fq) const {
        scale(acc, u, 2, wr, wc, fr, fq);
        EpiBf16 e{O, 2048}; e(acc, u, wr, wc, fr, fq);
    }
};
struct EpiMoeDown {
    static constexpr bool PERM = true; static constexpr int NHOOK = 0, H1 = -1, H2 = -1;
    bf16_t* O; const float* roww;
    __device__ __forceinline__ void operator()(const f32x4 (&acc)[2][2][4][2], const GUnit& u, int wr, int wc, int fr, int fq) const {
        const int row0 = u.row0 + wr * 64 + fr, col0 = u.col0 + wc * 32 + 8 * fq;
#pragma unroll
        for (int ai = 0; ai < 2; ++ai)
#pragma unroll
            for (int m = 0; m < 4; ++m) { const int row = row0 + ai * HALF + m * 16; const float rw = roww[row]; bf16_t* rowp = O + (size_t)row * 2048 + col0;
#pragma unroll
                for (int bj = 0; bj < 2; ++bj) { const f32x4 v0 = acc[ai][bj][m][0] * rw, v1 = acc[ai][bj][m][1] * rw;
                    u32x4 w; w.x = cvt_pk_bf16(v0[0], v0[1]); w.y = cvt_pk_bf16(v0[2], v0[3]); w.z = cvt_pk_bf16(v1[0], v1[1]); w.w = cvt_pk_bf16(v1[2], v1[3]);
                    *(u32x4*)(rowp + bj * HALF) = w; } }
    }
};
}
#define KSWZ(row, colB) ((row) * 256 + ((colB) ^ (((row) & 7) << 4)))
__device__ __forceinline__ int v_st(int k, int c) { const int kk = (k & ~0xC) | ((k & 4) << 1) | ((k & 8) >> 1); return ((kk >> 3) * 4 + (c >> 5)) * 512 + ((kk & 7) * 32 + (c & 31)) * 2; }
__device__ __forceinline__ int v_rd_base(int lane) { return ((lane & 3) << 3) | (((lane >> 2) & 3) << 6) | (((lane >> 4) & 1) << 5) | (((lane >> 5) & 1) << 8); }
constexpr int v_rd_off(int d0, int ks, int half) { return d0 * 512 + ks * 4096 + half * 2048; }
__device__ __forceinline__ int crow(int r, int hi) { return (r & 3) + 8 * (r >> 2) + 4 * hi; }

__device__ __forceinline__ void qkt(f32x16& p0, f32x16& p1, LAS const unsigned char* Kb, int r32, int hi, const bf16x8* qr) {
    LAS const unsigned char* kb[4];
#pragma unroll
    for (int dd = 0; dd < 4; ++dd) kb[dd] = Kb + KSWZ(r32, (dd * 16 + hi * 8) * 2);
#pragma unroll
    for (int d0 = 0; d0 < 8; ++d0) { LAS const unsigned char* a = kb[d0 & 3] + (d0 >> 2) * 128;
        const bf16x8 b0 = *(LAS const bf16x8*)a;
        const bf16x8 b1 = *(LAS const bf16x8*)(a + 32 * 256);
        p0 = __builtin_amdgcn_mfma_f32_32x32x16_bf16(b0, qr[d0], p0, 0, 0, 0);
        p1 = __builtin_amdgcn_mfma_f32_32x32x16_bf16(b1, qr[d0], p1, 0, 0, 0); }
}
__device__ __forceinline__ void pv_tile(f32x16* o, unsigned vb, bf16x8 pa0, bf16x8 pa1, bf16x8 pa2, bf16x8 pa3) {
#define TRRD(dst, off) asm volatile("ds_read_b64_tr_b16 %0, %1 offset:%2" : "=&v"(dst) : "v"(vb), "i"(off) : "memory")
#define PV_D0(d0) do { s16x4 l0, l1, l2, l3, h0, h1, h2, h3; constexpr int b_ = v_rd_off(d0, 0, 0); \
        TRRD(l0, b_); TRRD(h0, b_ + 2048); TRRD(l1, b_ + 4096); TRRD(h1, b_ + 6144); TRRD(l2, b_ + 8192); TRRD(h2, b_ + 10240); TRRD(l3, b_ + 12288); TRRD(h3, b_ + 14336); \
        asm volatile("s_waitcnt lgkmcnt(0)" ::: "memory"); __builtin_amdgcn_sched_barrier(0); \
        o[d0] = __builtin_amdgcn_mfma_f32_32x32x16_bf16(pa0, (bf16x8){l0[0], l0[1], l0[2], l0[3], h0[0], h0[1], h0[2], h0[3]}, o[d0], 0, 0, 0);   \
        o[d0] = __builtin_amdgcn_mfma_f32_32x32x16_bf16(pa1, (bf16x8){l1[0], l1[1], l1[2], l1[3], h1[0], h1[1], h1[2], h1[3]}, o[d0], 0, 0, 0);   \
        o[d0] = __builtin_amdgcn_mfma_f32_32x32x16_bf16(pa2, (bf16x8){l2[0], l2[1], l2[2], l2[3], h2[0], h2[1], h2[2], h2[3]}, o[d0], 0, 0, 0);   \
        o[d0] = __builtin_amdgcn_mfma_f32_32x32x16_bf16(pa3, (bf16x8){l3[0], l3[1], l3[2], l3[3], h3[0], h3[1], h3[2], h3[3]}, o[d0], 0, 0, 0); } while (0)
    PV_D0(0); PV_D0(1); PV_D0(2); PV_D0(3);
#undef PV_D0
#undef TRRD
}
__device__ __forceinline__ float swapmax(float v) { auto rr = __builtin_amdgcn_permlane32_swap(__float_as_uint(v), __float_as_uint(v), false, false); return fmaxf(__uint_as_float(rr[0]), __uint_as_float(rr[1])); }
__device__ __forceinline__ float swapadd(float v) { auto rr = __builtin_amdgcn_permlane32_swap(__float_as_uint(v), __float_as_uint(v), false, false); return __uint_as_float(rr[0]) + __uint_as_float(rr[1]); }
__device__ __forceinline__ void pack_p(const f32x16& p0, const f32x16& p1, bf16x8& pa0, bf16x8& pa1, bf16x8& pa2, bf16x8& pa3) {
#define PK4(P, B_, OUT) do { unsigned a0 = cvt_pk_bf16(P[B_+0], P[B_+1]), a1 = cvt_pk_bf16(P[B_+2], P[B_+3]);                          \
        unsigned b0 = cvt_pk_bf16(P[B_+4], P[B_+5]), b1 = cvt_pk_bf16(P[B_+6], P[B_+7]);                                             \
        auto r0 = __builtin_amdgcn_permlane32_swap(a0, b0, false, false); auto r1 = __builtin_amdgcn_permlane32_swap(a1, b1, false, false); \
        u32x4 w = {r0[0], r1[0], r0[1], r1[1]}; OUT = *reinterpret_cast<bf16x8*>(&w); } while (0)
    PK4(p0, 0, pa0); PK4(p0, 8, pa1); PK4(p1, 0, pa2); PK4(p1, 8, pa3);
#undef PK4
}

template <class F>
__device__ __forceinline__ void attn_unit(const F& f, LAS unsigned char* lds) {
    constexpr int NPOS = F::NPOS, NH = F::NH, TW = NPOS + 63, TABN = NH * TW;
    static_assert(NPOS * NH == 256 && TABN <= 512, "unit geometry");
    const int tid = tid_l(), wid = rfl(tid >> 6), lane = tid & 63, r32 = lane & 31, hi = lane >> 5;
    LAS unsigned char* V_lds = lds; LAS unsigned char* K_lds = lds + 2 * SHM_V;
    LAS float* als = (LAS float*)(lds + ALS_OFF) + wid * 64;
    LAS float* tab = (LAS float*)(lds + TAB_OFF);
    LAS float* keyb = (LAS float*)(lds + KEYB_OFF);
    const int sr = tid >> 4, sc = (tid & 15) * 8;
    const int kws = KSWZ(sr, sc * 2), vst0 = v_st(sr, sc), vst1 = v_st(32 + sr, sc);
    const int row = wid * 32 + r32;
    const int pl = NH == 1 ? row : (row >> 2), gh = NH == 1 ? 0 : (row & 3);
    bf16x8 qr[8];
    { const bf16_t* qp = f.qptr(row);
#pragma unroll
      for (int d0 = 0; d0 < 8; ++d0) qr[d0] = *(const bf16x8*)(qp + d0 * 16 + hi * 8); }
    float m_reg = -1e30f, l_reg = 0.f;
    f32x16 o[4];
#pragma unroll
    for (int d = 0; d < 4; ++d)
#pragma unroll
        for (int r = 0; r < 16; ++r) o[d][r] = 0.f;
    const int nt = f.nt;
    const int tlb = gh * TW + NPOS - 1 - pl + 4 * hi;
    const unsigned vb0 = (unsigned)(uintptr_t)V_lds + (unsigned)v_rd_base(lane);
    bf16x8 sk0, sk1, sv0, sv1;
#define A_LOAD(t) do { const int kb_ = f.kbase(t); sk0 = *(const bf16x8*)(f.kptr(kb_ + sr) + sc); sk1 = *(const bf16x8*)(f.kptr(kb_ + 32 + sr) + sc); \
                       sv0 = *(const bf16x8*)(f.vptr(kb_ + sr) + sc); sv1 = *(const bf16x8*)(f.vptr(kb_ + 32 + sr) + sc); } while (0)
#define A_WRITE(bf) do { *(LAS bf16x8*)(K_lds + (bf) * SHM_K + kws) = sk0; *(LAS bf16x8*)(K_lds + (bf) * SHM_K + kws + 32 * 256) = sk1; \
                         *(LAS bf16x8*)(V_lds + (bf) * SHM_V + vst0) = sv0; *(LAS bf16x8*)(V_lds + (bf) * SHM_V + vst1) = sv1; } while (0)
#define A_TAB(t, bf) do { if (tid < TABN) { const int g_ = tid / TW, j_ = tid - g_ * TW; tab[(bf) * 512 + tid] = f.tabval(g_, f.q0 - f.kbase(t) + NPOS - 1 - j_); } } while (0)
    if (nt > 0) { A_LOAD(0); A_TAB(0, 0); }
    if (F::KEYBIAS) { const f32x4* kbg = (const f32x4*)f.keyb; ((LAS f32x4*)keyb)[tid] = kbg[tid]; ((LAS f32x4*)keyb)[tid + 512] = kbg[tid + 512]; }
    if (nt > 0) { A_WRITE(0); }
    __syncthreads();
#pragma unroll 1
    for (int t = 0; t < nt; ++t) {
        const int bf = t & 1;
        if (t + 1 < nt) A_LOAD(t + 1);
        if (f.wave_active(t, wid)) {
            f32x16 p0, p1;
            if (F::KEYBIAS) { const int kb_ = f.kbase(t);
#pragma unroll
                for (int a = 0; a < 4; ++a) { const f32x4 x0 = *(LAS const f32x4*)(keyb + kb_ + 8 * a + 4 * hi), x1 = *(LAS const f32x4*)(keyb + kb_ + 32 + 8 * a + 4 * hi);
#pragma unroll
                    for (int i = 0; i < 4; ++i) { p0[4 * a + i] = x0[i]; p1[4 * a + i] = x1[i]; } } }
            else {
#pragma unroll
                for (int r = 0; r < 16; ++r) { p0[r] = 0.f; p1[r] = 0.f; } }
            qkt(p0, p1, K_lds + bf * SHM_K, r32, hi, qr);
            { LAS const float* tp = tab + bf * 512 + tlb;
#pragma unroll
              for (int r = 0; r < 16; ++r) { const int c = (r & 3) + 8 * (r >> 2); p0[r] = fmaf(p0[r], C2, tp[c]); p1[r] = fmaf(p1[r], C2, tp[c + 32]); } }
            if (F::ROWMASK) { if (!f.row_on(t, row)) {
#pragma unroll
                for (int r = 0; r < 16; ++r) { p0[r] = -__builtin_inff(); p1[r] = -__builtin_inff(); } } }
            float pmax = p0[0];
#pragma unroll
            for (int r = 1; r < 16; ++r) pmax = fmaxf(pmax, p0[r]);
#pragma unroll
            for (int r = 0; r < 16; ++r) pmax = fmaxf(pmax, p1[r]);
            pmax = swapmax(pmax);
            const float mn = fmaxf(m_reg, pmax);
            const float alpha = __builtin_amdgcn_exp2f(m_reg - mn); m_reg = mn;
            float ps = 0.f;
#pragma unroll
            for (int r = 0; r < 16; ++r) { p0[r] = __builtin_amdgcn_exp2f(p0[r] - mn); p1[r] = __builtin_amdgcn_exp2f(p1[r] - mn); ps += p0[r] + p1[r]; }
            ps = swapadd(ps);
            l_reg = l_reg * alpha + ps;
            bf16x8 pa0, pa1, pa2, pa3; pack_p(p0, p1, pa0, pa1, pa2, pa3);
            if (__any(alpha < 1.f)) { if (hi == 0) als[r32] = alpha; asm volatile("s_waitcnt lgkmcnt(0)" ::: "memory");
#pragma unroll
                for (int r = 0; r < 16; ++r) { const float a_ = als[crow(r, hi)];
#pragma unroll
                    for (int d = 0; d < 4; ++d) o[d][r] *= a_; } }
            pv_tile(o, vb0 + (unsigned)(bf * SHM_V), pa0, pa1, pa2, pa3);
        }
        if (t + 1 < nt) { A_TAB(t + 1, bf ^ 1); A_WRITE(bf ^ 1); }
        __syncthreads();
    }
#undef A_LOAD
#undef A_WRITE
#undef A_TAB
    if (hi == 0) { als[r32] = l_reg; f.stats(row, m_reg, l_reg); }
    asm volatile("s_waitcnt lgkmcnt(0)" ::: "memory");
#pragma unroll
    for (int r = 0; r < 16; ++r) { const int R = wid * 32 + crow(r, hi); const float lv = als[crow(r, hi)]; const float rl = lv > 0.f ? 1.f / lv : 0.f;
#pragma unroll
        for (int d = 0; d < 4; ++d) f.store(R, d * 32 + r32, o[d][r] * rl); }
    __syncthreads();
}

struct AV_Fox {
    static constexpr int NPOS = 256, NH = 1; static constexpr bool KEYBIAS = true, ROWMASK = false;
    const bf16_t *Q, *K, *V; const float* keyb; bf16_t* Y; int q0, nt;
    __device__ __forceinline__ const bf16_t* qptr(int row) const { return Q + (size_t)(q0 + row) * LDP; }
    __device__ __forceinline__ int kbase(int t) const { return 64 * t; }
    __device__ __forceinline__ const bf16_t* kptr(int key) const { return K + (size_t)key * LDP; }
    __device__ __forceinline__ const bf16_t* vptr(int key) const { return V + (size_t)key * LDP; }
    __device__ __forceinline__ bool wave_active(int t, int wid) const { return 64 * t <= q0 + wid * 32 + 31; }
    __device__ __forceinline__ float tabval(int, int dist) const { return dist >= 0 ? 0.f : -__builtin_inff(); }
    __device__ __forceinline__ bool row_on(int, int) const { return true; }
    __device__ __forceinline__ void stats(int, float, float) const {}
    __device__ __forceinline__ void store(int R, int dcol, float v) const { Y[(size_t)(q0 + R) * LDY + dcol] = f2bf(v); }
};
struct AV_Dil {
    static constexpr int NPOS = 256, NH = 1; static constexpr bool KEYBIAS = false, ROWMASK = false;
    const bf16_t *Q, *K, *V; const float* keyb; const float* relb; bf16_t* O; f32x2* ST; int q0, nt, t0, dil, hb;
    size_t rs, os;
    __device__ __forceinline__ const bf16_t* qptr(int row) const { return Q + (size_t)(q0 + row) * rs; }
    __device__ __forceinline__ int kbase(int t) const { return 64 * (t0 + t); }
    __device__ __forceinline__ const bf16_t* kptr(int key) const { return K + (size_t)key * rs; }
    __device__ __forceinline__ const bf16_t* vptr(int key) const { return V + (size_t)key * rs; }
    __device__ __forceinline__ bool wave_active(int t, int wid) const { const int kb = 64 * (t0 + t), ulo = q0 + wid * 32; return kb <= ulo + 31 && kb + 63 >= ulo - 128; }
    __device__ __forceinline__ float tabval(int, int dist) const { return (dist >= 0 && dist <= 128) ? relb[t5_bucket(dist * dil) * 20 + hb] * LOG2E : -__builtin_inff(); }
    __device__ __forceinline__ bool row_on(int, int) const { return true; }
    __device__ __forceinline__ void stats(int row, float m, float l) const { ST[(size_t)(q0 + row) * (os / 128)] = (f32x2){m, l}; }
    __device__ __forceinline__ void store(int R, int dcol, float v) const { O[(size_t)(q0 + R) * os + dcol] = f2bf(v); }
};
struct AV_Win {
    static constexpr int NPOS = 64, NH = 4; static constexpr bool KEYBIAS = false, ROWMASK = false;
    const bf16_t *Q, *K, *V; const float* keyb; const float* relb; const float* gates; float* YCF; int q0, nt, t0, hb, tok0;
    __device__ __forceinline__ const bf16_t* qptr(int row) const { return Q + (size_t)(q0 + (row >> 2)) * LDP + (row & 3) * 128; }
    __device__ __forceinline__ int kbase(int t) const { return 64 * (t0 + t); }
    __device__ __forceinline__ const bf16_t* kptr(int key) const { return K + (size_t)key * LDP; }
    __device__ __forceinline__ const bf16_t* vptr(int key) const { return V + (size_t)key * LDP; }
    __device__ __forceinline__ bool wave_active(int, int) const { return true; }
    __device__ __forceinline__ float tabval(int g, int dist) const { return (dist >= 0 && dist < 512) ? relb[t5_bucket(dist) * 20 + hb + g] * LOG2E : -__builtin_inff(); }
    __device__ __forceinline__ bool row_on(int, int) const { return true; }
    __device__ __forceinline__ void stats(int, float, float) const {}
    __device__ __forceinline__ void store(int R, int dcol, float v) const { const int tok = tok0 + q0 + (R >> 2), hd = (hb - 12) + (R & 3);
        const float gt = sigmoidf_(gates[(size_t)tok * 32 + 8 + 16 + hd]); YCF[(size_t)tok * 1024 + hd * 128 + dcol] = gt * v; }
};
struct AV_Slc {
    static constexpr int NPOS = 64, NH = 4; static constexpr bool KEYBIAS = false, ROWMASK = true;
    const bf16_t *Q, *K, *V; const float* keyb; const float* relb; const float* gates; const float* YCF; bf16_t* Y; int q0, nt, hb, tok0;
    LAS const int* tl; LAS const unsigned long long* msk;
    __device__ __forceinline__ const bf16_t* qptr(int row) const { return Q + (size_t)(q0 + (row >> 2)) * LDP + (row & 3) * 128; }
    __device__ __forceinline__ int kbase(int t) const { return 64 * tl[t]; }
    __device__ __forceinline__ const bf16_t* kptr(int key) const { return K + (size_t)key * LDP; }
    __device__ __forceinline__ const bf16_t* vptr(int key) const { return V + (size_t)key * LDP; }
    __device__ __forceinline__ bool wave_active(int, int) const { return true; }
    __device__ __forceinline__ float tabval(int g, int dist) const { return dist >= 0 ? relb[t5_bucket(dist) * 20 + hb + g] * LOG2E : -__builtin_inff(); }
    __device__ __forceinline__ bool row_on(int t, int row) const { return (msk[row >> 2] >> tl[t]) & 1ull; }
    __device__ __forceinline__ void stats(int, float, float) const {}
    __device__ __forceinline__ void store(int R, int dcol, float v) const { const int tok = tok0 + q0 + (R >> 2), hd = (hb - 12) + (R & 3);
        const float gt = sigmoidf_(gates[(size_t)tok * 32 + 8 + 8 + hd]); Y[(size_t)tok * LDY + YC_C + hd * 128 + dcol] = f2bf(YCF[(size_t)tok * 1024 + hd * 128 + dcol] + gt * v); }
};
__device__ __forceinline__ float gelu_tanh(float x) { const float u = 0.7978845608028654f * (x + 0.044715f * x * x * x); const float e = __expf(2.f * u); const float th = 1.f - 2.f / (1.f + e); return 0.5f * x * (1.f + th); }
__device__ __forceinline__ void cmp_stage2_unit(const Params& p, int layer, int unit, LAS unsigned char* lds) {
    const int tid = tid_l(), wid = tid >> 6, lane = tid & 63, fr = lane & 15, fq = lane >> 4;
    const int kv = unit >> 7, rg = unit & 127;
    LAS bf16_t* hid = (LAS bf16_t*)lds;
    const float* slab = (const float*)(p.ws + WS_SLAB) + (size_t)kv * 16 * 2048 * 256;
    const float* cb1 = (const float*)(p.ws + WS_CB1) + (layer * 2 + kv) * 256;
    { const int r = tid >> 5, n = (tid & 31) * 8;
      f32x4 a0 = *(const f32x4*)(cb1 + n), a1 = *(const f32x4*)(cb1 + n + 4);
#pragma unroll 4
      for (int s = 0; s < 16; ++s) { const float* sp = slab + ((size_t)s * 2048 + rg * 16 + r) * 256 + n; a0 += *(const f32x4*)sp; a1 += *(const f32x4*)(sp + 4); }
      u32x4 w; w.x = cvt_pk_bf16(gelu_tanh(a0[0]), gelu_tanh(a0[1])); w.y = cvt_pk_bf16(gelu_tanh(a0[2]), gelu_tanh(a0[3]));
      w.z = cvt_pk_bf16(gelu_tanh(a1[0]), gelu_tanh(a1[1])); w.w = cvt_pk_bf16(gelu_tanh(a1[2]), gelu_tanh(a1[3]));
      *(LAS u32x4*)(hid + r * 264 + n) = w; }
    __syncthreads();
    const bf16_t* w2 = (const bf16_t*)(p.ws + WS_WC2 + (size_t)(layer * 2 + kv) * SZ_WC2) + (size_t)(wid * 16 + fr) * 256 + fq * 8;
    f32x4 acc = {0.f, 0.f, 0.f, 0.f};
#pragma unroll
    for (int ks = 0; ks < 8; ++ks) { const bf16x8 a = *(LAS const bf16x8*)(hid + fr * 264 + ks * 32 + fq * 8); const bf16x8 b = *(const bf16x8*)(w2 + ks * 32);
        acc = __builtin_amdgcn_mfma_f32_16x16x32_bf16(a, b, acc, 0, 0, 0); }
    bf16_t* out = (bf16_t*)(p.ws + (kv ? WS_VC : WS_KC));
#pragma unroll
    for (int i = 0; i < 4; ++i) { const int grow = rg * 16 + fq * 4 + i; const int hk = grow & 1, bc = grow >> 1, c = bc & 255, b = bc >> 8;
        out[((size_t)(b * 2 + hk) * 256 + c) * 128 + wid * 16 + fr] = c == 255 ? (bf16_t)0 : f2bf(acc[i]); }
    __syncthreads();
}

__device__ __forceinline__ void cmp_attn_unit(const Params& p, int unit, LAS unsigned char* lds) {
    const int tid = tid_l(), wid = rfl(tid >> 6), lane = tid & 63, r32 = lane & 31, hi = lane >> 5;
    const int b = unit >> 7, hk = (unit >> 6) & 1, qb = unit & 63, q0 = qb * 64;
    LAS unsigned char* V_lds = lds; LAS unsigned char* K_lds = lds + 2 * SHM_V;
    LAS float* als = (LAS float*)(lds + ALS_OFF) + wid * 64;
    LAS float* imp = (LAS float*)(lds + IMP_OFF);
    const bf16_t* proj = (const bf16_t*)(p.ws + WS_PROJ);
    const bf16_t* Kc = (const bf16_t*)(p.ws + WS_KC) + (size_t)(b * 2 + hk) * 256 * 128; const bf16_t* Vc = (const bf16_t*)(p.ws + WS_VC) + (size_t)(b * 2 + hk) * 256 * 128;
    const int sr = tid >> 4, sc = (tid & 15) * 8;
    const int kws = KSWZ(sr, sc * 2), vst0 = v_st(sr, sc), vst1 = v_st(32 + sr, sc);
    const int row = wid * 32 + r32, pl = row >> 2, gh = row & 3, pos = q0 + pl;
    bf16x8 qr[8];
    { const bf16_t* qp = proj + (size_t)(b * SEQ + pos) * LDP + PC_NSAQ + (hk * 4 + gh) * 128;
#pragma unroll
      for (int d0 = 0; d0 < 8; ++d0) qr[d0] = *(const bf16x8*)(qp + d0 * 16 + hi * 8); }
    const int nt = (q0 + 32) / 1024 + 1;
    for (int i = tid; i < 64 * 257; i += 512) imp[i] = 0.f;
    const unsigned vb0 = (unsigned)(uintptr_t)V_lds + (unsigned)v_rd_base(lane);
    const int cmax = pos >= 31 ? (pos - 31) >> 4 : -1;
    float m_reg = -1e30f, l_reg = 0.f;
#pragma unroll 1
    for (int t = 0; t < nt; ++t) {
        const bf16x8 k0 = *(const bf16x8*)(Kc + (size_t)(64 * t + sr) * 128 + sc), k1 = *(const bf16x8*)(Kc + (size_t)(64 * t + 32 + sr) * 128 + sc);
        __syncthreads();
        *(LAS bf16x8*)(K_lds + kws) = k0; *(LAS bf16x8*)(K_lds + kws + 32 * 256) = k1;
        __syncthreads();
        f32x16 p0, p1;
#pragma unroll
        for (int r = 0; r < 16; ++r) { p0[r] = 0.f; p1[r] = 0.f; }
        qkt(p0, p1, K_lds, r32, hi, qr);
        float pmax = -__builtin_inff();
#pragma unroll
        for (int r = 0; r < 16; ++r) { const int dc = cmax - 64 * t - crow(r, hi); p0[r] = keep_or_ninf(p0[r] * C2, dc); p1[r] = keep_or_ninf(p1[r] * C2, dc - 32); pmax = fmaxf(pmax, fmaxf(p0[r], p1[r])); }
        pmax = swapmax(pmax);
        const float mn = fmaxf(m_reg, pmax); const float alpha = __builtin_amdgcn_exp2f(m_reg - mn); m_reg = mn;
        float ps = 0.f;
#pragma unroll
        for (int r = 0; r < 16; ++r) ps += __builtin_amdgcn_exp2f(p0[r] - mn) + __builtin_amdgcn_exp2f(p1[r] - mn);
        ps = swapadd(ps); l_reg = l_reg * alpha + ps;
    }
    const float invl = l_reg > 0.f ? 1.f / l_reg : 0.f;
    f32x16 o[4];
#pragma unroll
    for (int d = 0; d < 4; ++d)
#pragma unroll
        for (int r = 0; r < 16; ++r) o[d][r] = 0.f;
#pragma unroll 1
    for (int t = 0; t < nt; ++t) {
        const bf16x8 k0 = *(const bf16x8*)(Kc + (size_t)(64 * t + sr) * 128 + sc), k1 = *(const bf16x8*)(Kc + (size_t)(64 * t + 32 + sr) * 128 + sc);
        const bf16x8 v0 = *(const bf16x8*)(Vc + (size_t)(64 * t + sr) * 128 + sc), v1 = *(const bf16x8*)(Vc + (size_t)(64 * t + 32 + sr) * 128 + sc);
        __syncthreads();
        *(LAS bf16x8*)(K_lds + kws) = k0; *(LAS bf16x8*)(K_lds + kws + 32 * 256) = k1;
        *(LAS bf16x8*)(V_lds + vst0) = v0; *(LAS bf16x8*)(V_lds + vst1) = v1;
        __syncthreads();
        f32x16 p0, p1;
#pragma unroll
        for (int r = 0; r < 16; ++r) { p0[r] = 0.f; p1[r] = 0.f; }
        qkt(p0, p1, K_lds, r32, hi, qr);
#pragma unroll
        for (int r = 0; r < 16; ++r) { const int c = 64 * t + crow(r, hi);
            p0[r] = __builtin_amdgcn_exp2f(keep_or_ninf(p0[r] * C2, cmax - c) - m_reg) * invl; p1[r] = __builtin_amdgcn_exp2f(keep_or_ninf(p1[r] * C2, cmax - c - 32) - m_reg) * invl;
            float s0 = p0[r], s1 = p1[r];
            s0 += __shfl_xor(s0, 1); s0 += __shfl_xor(s0, 2); s1 += __shfl_xor(s1, 1); s1 += __shfl_xor(s1, 2);
            if (gh == 0) { imp[pl * 257 + c] = s0; imp[pl * 257 + c + 32] = s1; } }
        bf16x8 pa0, pa1, pa2, pa3; pack_p(p0, p1, pa0, pa1, pa2, pa3);
        pv_tile(o, vb0, pa0, pa1, pa2, pa3);
    }
    __syncthreads();
    { const int ppl = tid >> 3, part = tid & 7; float* ps = (float*)(p.ws + WS_PSLC) + ((size_t)(b * 2 + hk) * SEQ + q0 + ppl) * 64 + part * 8;
      float r8[8];
#pragma unroll
      for (int jj = 0; jj < 8; ++jj) { const int j = part * 8 + jj; LAS const float* ip = imp + ppl * 257 + 4 * j;
          float s = 2.f * (ip[0] + ip[1] + ip[2]); if (j > 0) s += ip[-1]; if (j < 63) s += ip[3]; r8[jj] = s; }
      *(f32x4*)ps = (f32x4){r8[0], r8[1], r8[2], r8[3]}; *(f32x4*)(ps + 4) = (f32x4){r8[4], r8[5], r8[6], r8[7]}; }
    float* ycf = (float*)(p.ws + WS_YCF); const float* gates = (const float*)(p.ws + WS_GATES);
#pragma unroll
    for (int r = 0; r < 16; ++r) { const int R = wid * 32 + crow(r, hi); const int tok = b * SEQ + q0 + (R >> 2), hd = hk * 4 + (R & 3);
        const float gt = sigmoidf_(gates[(size_t)tok * 32 + 8 + hd]);
#pragma unroll
        for (int d = 0; d < 4; ++d) { float* yp = ycf + (size_t)tok * 1024 + hd * 128 + d * 32 + r32; *yp = *yp + gt * o[d][r]; } }
    __syncthreads();
}

__device__ __forceinline__ void phase_dil_combine(const Params& p) {
    const bf16_t* dilo = (const bf16_t*)(p.ws + WS_DILO); const f32x2* st = (const f32x2*)(p.ws + WS_DILST); bf16_t* Y = (bf16_t*)(p.ws + WS_Y);
    for (int i = bid_l() * 512 + tid_l(); i < T * 64; i += gdim_l() * 512) { const int tok = i >> 6, h = (i >> 4) & 3, dc = (i & 15) * 8;
        const f32x2 s0 = st[(size_t)tok * 4 + h], s1 = st[((size_t)T + tok) * 4 + h], s2 = st[((size_t)2 * T + tok) * 4 + h];
        const float M = fmaxf(s0.x, fmaxf(s1.x, s2.x));
        float w0 = s0.y * __builtin_amdgcn_exp2f(s0.x - M), w1 = s1.y * __builtin_amdgcn_exp2f(s1.x - M), w2 = s2.y * __builtin_amdgcn_exp2f(s2.x - M);
        const float iw = 1.f / (w0 + w1 + w2); w0 *= iw; w1 *= iw; w2 *= iw;
        const u32x4 a = *(const u32x4*)(dilo + (size_t)tok * 512 + h * 128 + dc), bq = *(const u32x4*)(dilo + ((size_t)T + tok) * 512 + h * 128 + dc), c = *(const u32x4*)(dilo + ((size_t)2 * T + tok) * 512 + h * 128 + dc);
        u32x4 w;
#pragma unroll
        for (int j = 0; j < 4; ++j) w[j] = cvt_pk_bf16(w0 * bflo(a[j]) + w1 * bflo(bq[j]) + w2 * bflo(c[j]), w0 * bfhi(a[j]) + w1 * bfhi(bq[j]) + w2 * bfhi(c[j]));
        *(u32x4*)(Y + (size_t)tok * LDY + YC_B + h * 128 + dc) = w; }
}

constexpr int SLC_SC_OFF = KEYB_OFF, SLC_MSK_OFF = KEYB_OFF + 32768, SLC_TL_OFF = SLC_MSK_OFF + 512, SLC_UNI_OFF = SLC_TL_OFF + 256;
__device__ __forceinline__ int slc_select(const Params& p, int b, int hk, int qb, LAS unsigned char* lds) {
    const int tid = tid_l(), lane = tid & 63;
    LAS unsigned long long* sc = (LAS unsigned long long*)(lds + SLC_SC_OFF); LAS unsigned long long* msk = (LAS unsigned long long*)(lds + SLC_MSK_OFF);
    LAS int* tl = (LAS int*)(lds + SLC_TL_OFF); LAS unsigned long long* uni = (LAS unsigned long long*)(lds + SLC_UNI_OFF);
    const float* ps = (const float*)(p.ws + WS_PSLC) + ((size_t)(b * 2 + hk) * SEQ + qb * 64) * 64;
    { const int e = tid * 8, j0 = e & 63; const f32x4 a = *(const f32x4*)(ps + e), c = *(const f32x4*)(ps + e + 4); float v[8] = {a[0], a[1], a[2], a[3], c[0], c[1], c[2], c[3]};
#pragma unroll
      for (int i = 0; i < 8; ++i) { const int j = j0 + i; const float s = (j == 0 || j == qb || j == qb - 1) ? __builtin_inff() : (j <= qb ? v[i] : -__builtin_inff());
          unsigned ub = __float_as_uint(s); ub ^= (ub >> 31) ? 0xffffffffu : 0x80000000u;
          sc[e + i] = ((unsigned long long)ub << 32) | (unsigned)(63 - j); } }
    __syncthreads();
    { const int ppl = tid >> 3, part = tid & 7; unsigned lo = 0u, hiw = 0u;
#pragma unroll 1
      for (int jj = 0; jj < 8; ++jj) { const int j = part * 8 + jj; const unsigned long long kj = sc[ppl * 64 + j]; int rank = 0;
#pragma unroll 4
          for (int i = 0; i < 64; ++i) { const unsigned long long ki = sc[ppl * 64 + i]; rank += ki > kj ? 1 : 0; }
          if (rank < 16 && j <= qb) { if (j < 32) lo |= 1u << j; else hiw |= 1u << (j - 32); } }
      lo |= __shfl_xor(lo, 1); hiw |= __shfl_xor(hiw, 1); lo |= __shfl_xor(lo, 2); hiw |= __shfl_xor(hiw, 2); lo |= __shfl_xor(lo, 4); hiw |= __shfl_xor(hiw, 4);
      if (part == 0) msk[ppl] = ((unsigned long long)hiw << 32) | lo; }
    __syncthreads();
    if (tid < 64) { const unsigned long long m = msk[lane]; unsigned lo = (unsigned)m, hiw = (unsigned)(m >> 32);
        for (int o = 1; o < 64; o <<= 1) { lo |= __shfl_xor(lo, o); hiw |= __shfl_xor(hiw, o); }
        const unsigned long long u = ((unsigned long long)hiw << 32) | lo;
        if (lane == 0) uni[0] = u;
        if ((u >> lane) & 1ull) tl[__popcll(u & ((1ull << lane) - 1ull))] = lane; }
    __syncthreads();
    return __popcll(uni[0]);
}
struct CmpOrder { int G, c; size_t bbase;
    __device__ __forceinline__ bool next(int i, pg8::GUnit& u) const { const int L = i * G + c; if (L >= 256) return false;
        const int kv = L >> 7, pm = (L >> 4) & 7, ks = L & 15, b = pm >> 1, c0 = (pm & 1) * 128;
        u.aoff = ((size_t)(b * SEQ + 16 * c0 + 2 * ks) * LDP + kv * 256) * 2; u.boff = (size_t)kv * SZ_WC1 + (size_t)ks * 4 * 128;
        u.row0 = pm * 256; u.col0 = 0; u.aux = kv * 16 + ks; return true; }
};
struct CmpRow { __device__ __forceinline__ unsigned operator()(int R) const { return (unsigned)(R >> 1) * (unsigned)(16 * LDP * 2) + (unsigned)(R & 1) * 256u; } };
struct MoeOrder { int nM, nN, G, c; size_t tsA, tsB, esB; LAS const int* offs;
    __device__ __forceinline__ bool next(int i, pg8::GUnit& u) const { int pm, pn; if (!pg8::static_tile(i, G, c, nM, nN, pm, pn)) return false;
        const int row0 = pm * 256; int e = 0;
#pragma unroll
        for (int k = 1; k < 8; ++k) if (offs[k] <= row0) e = k;
        u.aoff = (size_t)pm * tsA; u.boff = (size_t)e * esB + (size_t)pn * tsB; u.row0 = row0; u.col0 = pn * 256; u.aux = e; return true; }
};

constexpr int NPH = 34;
#ifndef MK_FINAL_OOP
#define MK_FINAL_DST p.out
#else
#define MK_FINAL_DST ((float*)(p.ws + WS_PROJ))
#endif
#define PH_BEGIN asm volatile("; PHASE_MARK"); const Params p = load_params(); const int c = bid_l(), G = gdim_l(); (void)c; (void)G; unsigned char* ws = p.ws; (void)ws; \
        bf16_t* PROJ = (bf16_t*)(ws + WS_PROJ); bf16_t* H = (bf16_t*)(ws + WS_H); bf16_t* Y = (bf16_t*)(ws + WS_Y); bf16_t* MERGED = (bf16_t*)(ws + WS_MERGED); \
        const float* GATES = (const float*)(ws + WS_GATES); const float* relb = p.in[IN_RELB]; const float* xin = l == 0 ? p.in[IN_X] : p.out; (void)PROJ; (void)H; (void)Y; (void)MERGED; (void)GATES; (void)relb; (void)xin;
#define INP(j) (LO <= pb + (j) && pb + (j) < HI)
#define SEAM(k) do { if constexpr ((k) + 1 < HI) xcd_barrier(bar); } while (0)
template <int L, int LO, int HI>
__device__ __forceinline__ void layer_phases(const XcdBarrier& bar, LAS unsigned char* lds) {
    constexpr int l = L, pb = 1 + 16 * L;
        if constexpr (INP(0)) { PH_BEGIN phase_norm<false>(p, xin, p.in[IN_NMIX] + l * 2048, H, lds); SEAM(pb + 0); }
        if constexpr (INP(1)) { PH_BEGIN
            pg8::GemmP g{(const char*)H, (const char*)(ws + WS_WIN + l * SZ_WIN), 4096u, 256, 32};
            pg8::StaticOrder S{64, 64, G, c, (size_t)256 * 4096, (size_t)256 * 4096};
            pg8::EpiBf16 E{PROJ, LDP};
            pg8::gemm_phase(lds, g, S, E, pg8::LinRow{4096u});
            phase_gates(p, l);
            SEAM(pb + 1);
        }
        if constexpr (INP(2)) { PH_BEGIN
            pg8::GemmP g{(const char*)(PROJ + PC_NSAKV), (const char*)(ws + WS_WC1 + (size_t)l * 2 * SZ_WC1), 8192u, (size_t)LDP * 2, 4};
            CmpOrder S{G, c, 0};
            pg8::EpiSlab E{(float*)(ws + WS_SLAB)};
            pg8::gemm_phase(lds, g, S, E, CmpRow{});
            phase_fox_cumsum(p, l);
            SEAM(pb + 2);
        }
        if constexpr (INP(3)) { PH_BEGIN
#pragma unroll 1
            for (int u = c; u < 256; u += G) cmp_stage2_unit(p, l, u, lds);
#pragma unroll 1
            for (int u = c; u < 256; u += G) { const int b = u >> 6, h = (u >> 3) & 7, pr = u & 7;
#pragma unroll 1
                for (int half = 0; half < 2; ++half) { const int qt = half ? 15 - pr : pr;
                    AV_Fox f; const bf16_t* base = PROJ + (size_t)(b * SEQ) * LDP + h * 128;
                    f.Q = base + PC_FOXQ; f.K = base + PC_FOXK; f.V = base + PC_FOXV; f.keyb = (const float*)(ws + WS_CNEG) + (size_t)(b * 8 + h) * SEQ;
                    f.Y = Y + (size_t)(b * SEQ) * LDY + YC_A + h * 128; f.q0 = qt * 256; f.nt = 4 * qt + 4;
                    attn_unit(f, lds); } }
#pragma unroll 1
            for (int u = c; u < 512; u += G) { const int b = u >> 7, hk = (u >> 6) & 1, qb = u & 63;
                AV_Win f; const bf16_t* base = PROJ + (size_t)(b * SEQ) * LDP;
                f.Q = base + PC_NSAQ + hk * 512; f.K = base + PC_NSAKV + 2 * 512 + hk * 128; f.V = base + PC_NSAKV + 2 * 512 + 256 + hk * 128; f.keyb = nullptr; f.relb = relb; f.gates = GATES;
                f.YCF = (float*)(ws + WS_YCF); f.q0 = qb * 64; f.t0 = qb > 8 ? qb - 8 : 0; f.nt = qb - f.t0 + 1; f.hb = 12 + hk * 4; f.tok0 = b * SEQ;
                attn_unit(f, lds); }
#pragma unroll 1
            for (int u = c; u < 768; u += G) { const int gi = u >> 8, r8 = u & 255, b = r8 >> 6, h = (r8 >> 4) & 3, x = r8 & 15;
                const int dil = gi == 0 ? 1 : (gi == 1 ? 4 : 16); const int r = gi == 0 ? 0 : (gi == 1 ? (x & 3) : x), ut = gi == 0 ? x : (gi == 1 ? (x >> 2) : 0);
                AV_Dil f; const int hh = gi * 4 + h; const bf16_t* base = PROJ + (size_t)(b * SEQ + r) * LDP + hh * 128;
                f.Q = base + PC_DILQ; f.K = base + PC_DILK; f.V = base + PC_DILV; f.keyb = nullptr; f.relb = relb;
                f.O = (bf16_t*)(ws + WS_DILO) + ((size_t)gi * T + b * SEQ + r) * 512 + h * 128; f.ST = (f32x2*)(ws + WS_DILST) + ((size_t)gi * T + b * SEQ + r) * 4 + h;
                f.q0 = ut * 256; f.t0 = ut == 0 ? 0 : 4 * ut - 2; f.nt = 4 * ut + 4 - f.t0; f.dil = dil; f.hb = hh; f.rs = (size_t)dil * LDP; f.os = (size_t)dil * 512;
                attn_unit(f, lds); }
            SEAM(pb + 3);
        }
        if constexpr (INP(4)) { PH_BEGIN
#pragma unroll 1
            for (int u = c; u < 512; u += G) cmp_attn_unit(p, u, lds);
            phase_dil_combine(p);
            SEAM(pb + 4);
        }
        if constexpr (INP(5)) { PH_BEGIN
#pragma unroll 1
            for (int u = c; u < 256; u += G) { const int b = u >> 6, hk = (u >> 5) & 1, pr = u & 31;
#pragma unroll 1
                for (int half = 0; half < 2; ++half) { const int qb = half ? 63 - pr : pr;
                    const int ntl = slc_select(p, b, hk, qb, lds);
                    AV_Slc f; const bf16_t* base = PROJ + (size_t)(b * SEQ) * LDP;
                    f.Q = base + PC_NSAQ + hk * 512; f.K = base + PC_NSAKV + 512 + hk * 128; f.V = base + PC_NSAKV + 512 + 256 + hk * 128; f.keyb = nullptr; f.relb = relb; f.gates = GATES;
                    f.YCF = (const float*)(ws + WS_YCF); f.Y = Y; f.q0 = qb * 64; f.nt = ntl; f.hb = 12 + hk * 4; f.tok0 = b * SEQ;
                    f.tl = (LAS const int*)(lds + SLC_TL_OFF); f.msk = (LAS const unsigned long long*)(lds + SLC_MSK_OFF);
                    attn_unit(f, lds); } }
            SEAM(pb + 5);
        }
        if constexpr (INP(6)) { PH_BEGIN
            pg8::GemmP g{(const char*)Y, (const char*)(ws + WS_WBR + l * SZ_WBR), 5120u, 256, 40};
            pg8::StaticOrder S{64, 8, G, c, (size_t)256 * 5120, (size_t)256 * 5120};
            pg8::EpiBranch E{PROJ, MERGED};
            pg8::gemm_phase(lds, g, S, E, pg8::LinRow{5120u});
            SEAM(pb + 6);
        }
        if constexpr (INP(7)) { PH_BEGIN
            pg8::GemmP g{(const char*)MERGED, (const char*)(ws + WS_WOUT + l * SZ_WOUT), 4096u, 256, 32};
            pg8::StaticOrder S{64, 8, G, c, (size_t)256 * 4096, (size_t)256 * 4096};
            pg8::EpiRes E{xin, p.out};
            pg8::gemm_phase(lds, g, S, E, pg8::LinRow{4096u});
            SEAM(pb + 7);
        }
        if constexpr (INP(8)) { PH_BEGIN if (l == 0) phase_norm<false>(p, p.out, p.in[IN_NFFN] + l * 2048, H, lds); else phase_norm<true>(p, p.out, p.in[IN_NFFN] + l * 2048, H, lds); SEAM(pb + 8); }
        if constexpr (l == 0) {
            if constexpr (INP(10)) { PH_BEGIN
                pg8::GemmP g{(const char*)H, (const char*)(ws + WS_WFU), 4096u, 256, 32};
                pg8::StaticOrder S{64, 44, G, c, (size_t)256 * 4096, (size_t)256 * 4096};
                pg8::EpiSilu E{(bf16_t*)(ws + WS_ACT), DFF};
                pg8::gemm_phase(lds, g, S, E, pg8::LinRow{4096u});
                SEAM(pb + 10);
            }
            if constexpr (INP(11)) { PH_BEGIN
                pg8::GemmP g{(const char*)(ws + WS_ACT), (const char*)(ws + WS_WFD), (unsigned)(DFF * 2), 256, DFF / 64};
                pg8::StaticOrder S{64, 8, G, c, (size_t)256 * DFF * 2, (size_t)256 * DFF * 2};
                pg8::EpiRes E{p.out, p.out};
                pg8::gemm_phase(lds, g, S, E, pg8::LinRow{(unsigned)(DFF * 2)});
                SEAM(pb + 11);
            }
        } else {
            if constexpr (INP(9)) { PH_BEGIN phase_moe_scatter(p, lds); SEAM(pb + 9); }
            if constexpr (INP(10)) { PH_BEGIN
                LAS int* sm = (LAS int*)lds; int nrt; moe_offsets(p, sm, nrt);
                LAS int* offs = (LAS int*)(lds + LDS_MISC + 64); { const int tq = tid_l(); if (tq < 8) offs[tq] = sm[2056 + tq]; } __syncthreads();
                pg8::GemmP g{(const char*)(ws + WS_HG), (const char*)(ws + WS_WMU), 4096u, 256, 32};
                MoeOrder S{nrt, 56, G, c, (size_t)256 * 4096, (size_t)256 * 4096, SZ_WMU1, offs};
                pg8::EpiSilu E{(bf16_t*)(ws + WS_ACTM), DFFE};
                pg8::gemm_phase(lds, g, S, E, pg8::LinRow{4096u});
                SEAM(pb + 10);
            }
            if constexpr (INP(11)) { PH_BEGIN
                LAS int* sm = (LAS int*)lds; int nrt; moe_offsets(p, sm, nrt);
                LAS int* offs = (LAS int*)(lds + LDS_MISC + 64); { const int tq = tid_l(); if (tq < 8) offs[tq] = sm[2056 + tq]; } __syncthreads();
                pg8::GemmP g{(const char*)(ws + WS_ACTM), (const char*)(ws + WS_WMD), (unsigned)(DFFE * 2), 256, DFFE / 64};
                MoeOrder S{nrt, 8, G, c, (size_t)256 * DFFE * 2, (size_t)256 * DFFE * 2, SZ_WMD1, offs};
                pg8::EpiMoeDown E{(bf16_t*)(ws + WS_HG), (const float*)(ws + WS_ROUTE + (size_t)T * 24)};
                pg8::gemm_phase(lds, g, S, E, pg8::LinRow{(unsigned)(DFFE * 2)});
                SEAM(pb + 11);
            }
        }
    }
template <int LO, int HI>
__global__ void __launch_bounds__(512, 2) mk_range(Params p_) {
    extern __shared__ __attribute__((aligned(16))) unsigned char lds_raw[];
    LAS unsigned char* lds = (LAS unsigned char*)lds_raw;
    volatile LAS unsigned* misc = (volatile LAS unsigned*)(lds + LDS_MISC);
    { const int t0 = tid_l(); if (t0 < 16) misc[t0] = 0u; }
    __syncthreads();
#if MK_PROBE
    const unsigned long long t_start = wall_clock64();
#endif
    XcdBarrier bar; bar.bar = (unsigned*)(p_.ws + WS_CTL) + CW_BAR; bar.x = 0; bar.st = misc;
    if constexpr (HI - LO > 1) bar = xcd_barrier_post((unsigned*)(p_.ws + WS_CTL) + CW_BAR, misc);
    if constexpr (LO <= 0 && 0 < HI) { const Params p = load_params(); phase_prep(p, lds); SEAM(0); }
    layer_phases<0, LO, HI>(bar, lds);
    layer_phases<1, LO, HI>(bar, lds);
#ifdef MK_PRECHECK
    if constexpr (HI == 34) {
        const Params p = load_params(); unsigned cs = 0u;
        for (size_t i_ = (size_t)bid_l() * 512 + tid_l(); i_ < (size_t)T * DM; i_ += (size_t)gdim_l() * 512) cs += __float_as_uint(p.out[i_]) * (unsigned)(2654435761u * (unsigned)(i_ + 1) | 1u);
        { const int* slot = (const int*)(p.ws + WS_ROUTE + (size_t)T * 16); const size_t rw = 1024;
          for (size_t i_ = (size_t)bid_l() * 512 + tid_l(); i_ < (size_t)2 * T * rw; i_ += (size_t)gdim_l() * 512) { const size_t tk = i_ / rw, w_ = i_ - tk * rw; const int s = slot[tk];
              const unsigned x_ = *(const unsigned*)(p.ws + WS_HG + ((size_t)s * rw + w_) * 4); cs += (x_ + (unsigned)s) * (unsigned)(2654435761u * (unsigned)(i_ + 1) | 1u); } }
        atomicAdd((unsigned*)(p.ws + WS_CTL) + CW_DBG + 1, cs);
        xcd_barrier(bar);
    }
#endif
    if constexpr (LO <= 33 && 33 < HI) { const Params p = load_params(); phase_final(p, p.in[IN_NFIN], MK_FINAL_DST); }
#if MK_PROBE
    if constexpr (HI - LO > 1) {
        const Params p = load_params();
        xcd_barrier(bar);
        unsigned* ctl = (unsigned*)(p.ws + WS_CTL);
#if MK_PROBE == 1
        const unsigned long long t1 = wall_clock64();
        const unsigned tmo = __hip_atomic_load(ctl + XB_TMO, __ATOMIC_RELAXED, __HIP_MEMORY_SCOPE_AGENT);
        const float ms = (float)(t1 - t_start) * 1e-5f;
        int k = 1 + (int)fminf(45.f, rintf(4.f * log2f(1.f + ms))) + (tmo ? 50 : 0);
        const float cv = sqrtf((float)k);
#else
        unsigned cs = 0u;
#define CKS(off, rows, rowbytes, stridebytes) do { const size_t nw_ = (size_t)(rowbytes) / 4; for (size_t i_ = (size_t)bid_l() * 512 + tid_l(); i_ < (size_t)(rows) * nw_; i_ += (size_t)gdim_l() * 512) { \
            const size_t r_ = i_ / nw_, w_ = i_ - r_ * nw_; const unsigned x_ = *(const unsigned*)(p.ws + (off) + r_ * (size_t)(stridebytes) + w_ * 4); cs += x_ * (unsigned)(2654435761u * (unsigned)(i_ + 1) | 1u); } } while (0)
        constexpr int PS = HI - 1;
        if constexpr (PS == 0) { CKS(WS_WIN, 1, WS_PROJ - WS_WIN, 0); }
        if constexpr (PS == 1 || PS == 9 || PS == 17 || PS == 25) { CKS(WS_H, T, 4096, 4096); }
        if constexpr (PS == 2 || PS == 18) { CKS(WS_PROJ, T, LDP * 2, LDP * 2); CKS(WS_GATES, T, 128, 128); }
        if constexpr (PS == 3 || PS == 19) { CKS(WS_SLAB, 1, 67108864, 0); CKS(WS_CNEG, 1, 32 * 4096 * 4, 0); }
        if constexpr (PS == 4 || PS == 20) { CKS(WS_YCF, T, 4096, 4096); CKS(WS_DILO, 3 * T, 1024, 1024); CKS(WS_DILST, 3 * T, 32, 32); CKS(WS_KC, 1, 8 * 256 * 128 * 2 * 2, 0); CKS(WS_Y, T, 2048, LDY * 2); }
        if constexpr (PS == 5 || PS == 21) { CKS(WS_YCF, T, 4096, 4096); CKS(WS_PSLC, 1, 8 * 4096 * 64 * 4, 0); CKS(WS_Y + 2048, T, 1024, LDY * 2); }
        if constexpr (PS == 6 || PS == 22) { CKS(WS_Y, T, LDY * 2, LDY * 2); }
        if constexpr (PS == 7 || PS == 23) { CKS(WS_MERGED, T, 4096, 4096); }
        if constexpr (PS == 8 || PS == 12 || PS == 24 || PS == 33 || PS == 28 || PS == 25) { for (size_t i_ = (size_t)bid_l() * 512 + tid_l(); i_ < (size_t)T * DM; i_ += (size_t)gdim_l() * 512) cs += __float_as_uint(p.out[i_]) * (unsigned)(2654435761u * (unsigned)(i_ + 1) | 1u); }
        if constexpr (PS == 11) { CKS(WS_ACT, T, DFF * 2, DFF * 2); }
#ifdef MK_FINAL_OOP
        if constexpr (PS == 33) { CKS(WS_PROJ, T, 8192, 8192); }
#endif
        if constexpr (PS == 25) { CKS(WS_ROUTE, 1, (size_t)T * 16, 0); CKS(WS_CTL + CW_CNT * 4, 1, 2048 * 4, 0); }
        if constexpr (PS == 26 || PS == 27 || PS == 28) { const int* slot = (const int*)(p.ws + WS_ROUTE + (size_t)T * 16);
            const size_t base = PS == 27 ? WS_ACTM : WS_HG; const size_t rw = PS == 27 ? DFFE / 2 : 1024;
            for (size_t i_ = (size_t)bid_l() * 512 + tid_l(); i_ < (size_t)2 * T * rw; i_ += (size_t)gdim_l() * 512) { const size_t tk = i_ / rw, w_ = i_ - tk * rw; const int s = slot[tk];
                const unsigned x_ = *(const unsigned*)(p.ws + base + ((size_t)s * rw + w_) * 4); cs += (x_ + (unsigned)s) * (unsigned)(2654435761u * (unsigned)(i_ + 1) | 1u); } }
#ifdef MK_PRECHECK
        cs = 0u;
#endif
        atomicAdd(ctl + CW_DBG, cs);
        xcd_barrier(bar);
#ifdef MK_PRECHECK
        const unsigned tot = __hip_atomic_load(ctl + CW_DBG + 1, __ATOMIC_RELAXED, __HIP_MEMORY_SCOPE_AGENT);
#else
        const unsigned tot = __hip_atomic_load(ctl + CW_DBG, __ATOMIC_RELAXED, __HIP_MEMORY_SCOPE_AGENT);
#endif
        const float cv = 1.0f + (float)((tot ^ (tot >> 16)) & 0xffffu) * (1.0f / 65536.0f);
#endif
        for (size_t i = (size_t)bid_l() * 512 + tid_l(); i < (size_t)T * DM; i += (size_t)gdim_l() * 512) p.out[i] = cv;
    }
#endif
}
#undef INP
#undef SEAM
#undef PH_BEGIN
#if MK_ONE_LAUNCH && !MK_DEBUG
#ifndef MK_PSTAGE
#define MK_PSTAGE (NPH - 1)
#endif
#define MK_MAIN (mk_range<0, MK_PSTAGE + 1>)
#else
#define MK_MAIN (mk_range<2, 3>)
typedef void (*kern_t)(Params);
template <int... I> struct KernTab { kern_t k[sizeof...(I)] = { mk_range<I, I + 1>... }; };
template <int N, int... I> struct MakeTab : MakeTab<N - 1, N - 1, I...> {};
template <int... I> struct MakeTab<0, I...> { typedef KernTab<I...> type; };
static MakeTab<NPH>::type kerns;
#endif
extern "C" void kernel_launch(void* const* d_in, const int* in_sizes, int n_in, void* d_out, int out_size, void* d_ws, size_t ws_size, hipStream_t stream) {
    static int grid = 0;
    if (grid == 0) {
        if (n_in != N_IN || out_size != T * DM || ws_size < WS_END) { fprintf(stderr, "kernel_launch: unexpected shapes (n_in %d out %d ws %zu need %zu)\n", n_in, out_size, ws_size, (size_t)WS_END); grid = -1; return; }
        int dev = 0, cus = 0, per_cu = 0;
        if (hipGetDevice(&dev) != hipSuccess || hipDeviceGetAttribute(&cus, hipDeviceAttributeMultiprocessorCount, dev) != hipSuccess) { grid = -1; return; }
#if MK_ONE_LAUNCH && !MK_DEBUG
        if (hipFuncSetAttribute((const void*)MK_MAIN, hipFuncAttributeMaxDynamicSharedMemorySize, LDS_BYTES) != hipSuccess) { fprintf(stderr, "kernel_launch: hipFuncSetAttribute failed\n"); grid = -1; return; }
#else
        for (int i = 0; i < NPH; ++i) if (hipFuncSetAttribute((const void*)kerns.k[i], hipFuncAttributeMaxDynamicSharedMemorySize, LDS_BYTES) != hipSuccess) { fprintf(stderr, "kernel_launch: hipFuncSetAttribute failed\n"); grid = -1; return; }
#endif
        if (hipOccupancyMaxActiveBlocksPerMultiprocessor(&per_cu, (const void*)MK_MAIN, 512, LDS_BYTES) != hipSuccess || per_cu < 1) { fprintf(stderr, "kernel_launch: occupancy query says %d\n", per_cu); per_cu = 1; }
        (void)hipGetLastError();
        grid = cus;
    }
    if (grid < 0) return;
    (void)hipMemsetAsync((char*)d_ws + WS_CTL, 0, CTL_BYTES, stream);
    Params p{};
    for (int i = 0; i < N_IN; ++i) p.in[i] = (const float*)d_in[i];
    p.out = (float*)d_out; p.ws = (unsigned char*)d_ws;
#if MK_ONE_LAUNCH && !MK_DEBUG
    p.ph_lo = 0; p.ph_hi = NPH;
    hipLaunchKernelGGL(MK_MAIN, dim3(grid), dim3(512), LDS_BYTES, stream, p);
#else
    for (int ph = 0; ph < NPH; ++ph) {
        const bool empty = (ph >= 13 && ph <= 16) || (ph >= 29 && ph <= 32) || ph == 10;
        if (empty) continue;
#if MK_DEBUG
        dbg_before(p, ph, grid, stream);
#endif
        p.ph_lo = ph; p.ph_hi = ph + 1;
        hipLaunchKernelGGL(kerns.k[ph], dim3(grid), dim3(512), LDS_BYTES, stream, p);
#if MK_DEBUG
        dbg_after(p, ph, grid, stream);
#endif
    }
#endif
}
```

```cpp
#include <hip/hip_runtime.h>
#include <stdint.h>
#include <stdio.h>

#ifndef MK_DEBUG
#define MK_DEBUG 0
#endif
#ifndef MK_DBG_STAGE
#define MK_DBG_STAGE 0
#endif
#ifndef MK_PROBE
#define MK_PROBE 0
#endif
#ifndef MK_PROBE3_MODE
#define MK_PROBE3_MODE 0
#endif
#ifndef MK_FP8PROBE
#define MK_FP8PROBE 0
#endif
#ifndef MK_FFN_F8
#ifndef MK_FUSE_N1
#define MK_FUSE_N1 1
#endif
#ifndef MK_FUSE_N2
#define MK_FUSE_N2 1
#endif
#define MK_FFN_F8 2
#endif
#ifndef MK_ONE_LAUNCH
#define MK_ONE_LAUNCH 1
#endif

#define LAS __attribute__((address_space(3)))
typedef unsigned short bf16_t;
typedef short bf16x8 __attribute__((ext_vector_type(8)));
typedef short s16x4 __attribute__((ext_vector_type(4)));
typedef float f32x2 __attribute__((ext_vector_type(2)));
typedef float f32x4 __attribute__((ext_vector_type(4)));
typedef float f32x16 __attribute__((ext_vector_type(16)));
typedef unsigned u32x2 __attribute__((ext_vector_type(2)));
typedef unsigned u32x4 __attribute__((ext_vector_type(4)));

constexpr int T = 16384, DM = 2048, SEQ = 4096, NBATCH = 4;
constexpr int D_IN = 16416;
#ifndef MK_LDP
#define MK_LDP 16384
#endif
constexpr int LDP = MK_LDP;
constexpr int PC_FOXQ = 0, PC_FOXK = 1024, PC_FOXV = 2048;
constexpr int PC_DILQ = 3072, PC_DILK = 3072 + 1536, PC_DILV = 3072 + 3072;
constexpr int PC_NSAQ = 7680, PC_NSAKV = 8704, PC_MERGE = 10240;
constexpr int LDY = 2560;
constexpr int YC_A = 0, YC_B = 1024, YC_C = 1536;
constexpr int DFF = 5632, DFFE = 7168, NEXP = 8;
constexpr int MOE_ROWS = 2 * T + NEXP * 256;
constexpr float RMS_EPS = 1e-6f;
constexpr float LOG2E = 1.4426950408889634f;
constexpr float SM_SCALE = 0.08838834764831845f;
constexpr float C2 = SM_SCALE * LOG2E;

enum { IN_X = 0, IN_RELB, IN_NMIX, IN_NFFN, IN_NFIN, IN_WIN, IN_FOXB, IN_PEK, IN_W1K, IN_W2K, IN_PEV, IN_W1V, IN_W2V,
       IN_WBA, IN_WBB, IN_WBC, IN_WOUT, IN_FG, IN_FU, IN_FD, IN_ROUTER, IN_MG, IN_MU, IN_MD, N_IN };

constexpr size_t CTL_BYTES = 65536;
constexpr size_t SZ_WIN = (size_t)16384 * 2048 * 2, SZ_WG32 = (size_t)32 * 2048 * 2, SZ_WBR = (size_t)2048 * 2560 * 2, SZ_WOUT = (size_t)2048 * 2048 * 2;
constexpr size_t SZ_WFU = (size_t)2 * DFF * 2048 * 2, SZ_WFD = (size_t)2048 * DFF * 2;
constexpr size_t SZ_WMU1 = (size_t)2 * DFFE * 2048 * 2, SZ_WMD1 = (size_t)2048 * DFFE * 2;
constexpr size_t SZ_WC1 = (size_t)256 * 4096 * 2, SZ_WC2 = (size_t)128 * 256 * 2;
constexpr size_t WS_CTL = 0;
constexpr size_t WS_WIN = WS_CTL + CTL_BYTES;
constexpr size_t WS_WG32 = WS_WIN + 2 * SZ_WIN;
constexpr size_t WS_WBR = WS_WG32 + 2 * SZ_WG32;
constexpr size_t WS_WOUT = WS_WBR + 2 * SZ_WBR;
constexpr size_t WS_WFU = WS_WOUT + 2 * SZ_WOUT;
constexpr size_t WS_WFD = WS_WFU + SZ_WFU;
constexpr size_t WS_WMU = WS_WFD + SZ_WFD;
constexpr size_t WS_WMD = WS_WMU + 8 * SZ_WMU1;
constexpr size_t WS_WC1 = WS_WMD + 8 * SZ_WMD1;
constexpr size_t WS_WC2 = WS_WC1 + 4 * SZ_WC1;
constexpr size_t WS_CB1 = WS_WC2 + 4 * SZ_WC2;
constexpr size_t WS_PROJ = WS_CB1 + 4096;
constexpr size_t SZ_PROJ = (size_t)(T + 64) * LDP * 2;
constexpr size_t WS_H = WS_PROJ + SZ_PROJ;
constexpr size_t WS_Y = WS_H + (size_t)T * 2048 * 2;
constexpr size_t WS_MERGED = WS_Y + (size_t)T * LDY * 2;
constexpr size_t WS_YCF = WS_MERGED + (size_t)T * 2048 * 2;
constexpr size_t WS_YCF2 = WS_YCF + (size_t)T * 1024 * 4;
constexpr size_t WS_DILO = WS_YCF2 + (size_t)T * 1024 * 4;
constexpr size_t WS_DILST = WS_DILO + (size_t)3 * T * 512 * 2;
constexpr size_t WS_GATES = WS_DILST + (size_t)3 * T * 4 * 8;
constexpr size_t WS_CNEG = WS_GATES + (size_t)T * 32 * 4;
constexpr size_t WS_KC = WS_CNEG + (size_t)32 * 4096 * 4;
constexpr size_t WS_VC = WS_KC + (size_t)8 * 256 * 128 * 2;
constexpr size_t WS_PSLC = WS_VC + (size_t)8 * 256 * 128 * 2;
constexpr size_t WS_ROUTE = WS_PSLC + (size_t)8 * 4096 * 64 * 4;
constexpr size_t WS_H8 = WS_ROUTE + (size_t)T * 8 * 3 + (size_t)MOE_ROWS * 4 + 4096;
constexpr size_t WS_CTOT = WS_H8 + (size_t)T * 2048;
constexpr size_t WS_XB = WS_CTOT + 4 * 8 * 64 * 4;
constexpr size_t WS_SS = WS_XB + (size_t)T * 2048 * 2;
constexpr size_t WS_SS1 = WS_SS + (size_t)T * 4;
constexpr size_t WS_END = WS_SS1 + (size_t)T * 4;
constexpr size_t WS_SLAB = WS_MERGED;
constexpr size_t WS_OMPART = WS_YCF;
constexpr size_t WS_ACT = WS_PROJ;
constexpr size_t WS_ACTM = WS_PROJ;
constexpr size_t WS_HG = WS_Y;
static_assert((size_t)MOE_ROWS * 2048 * 2 <= (size_t)T * LDY * 2 + (size_t)T * 2048 * 2, "HG alias");
static_assert((size_t)MOE_ROWS * DFFE * 2 <= SZ_PROJ, "ACTM alias");

constexpr int CW_BAR = 0;
constexpr int CW_DBG = 4096;
constexpr int CW_CNT = 8192;
constexpr int CW_TMAP = 12288;

constexpr int LDS_BYTES = 147456;
constexpr int LDS_MISC = 146432;
constexpr int SHM_K = 16384, SHM_V = 16384;
constexpr int ALS_OFF = 98304, TAB_OFF = 100352, RBL_OFF = 104960, KEYB_OFF = 105472;
constexpr int CMP_ALS_OFF = 65536, CMP_IMP_OFF = 73728;

struct Params { const float* in[N_IN]; float* out; unsigned char* ws; int ph_lo, ph_hi; };

typedef __bf16 bf16x2_t __attribute__((ext_vector_type(2)));
__device__ __forceinline__ unsigned cvt_pk_bf16(float lo, float hi) { const f32x2 v = {lo, hi}; const bf16x2_t b = __builtin_convertvector(v, bf16x2_t); return __builtin_bit_cast(unsigned, b); }
__device__ __forceinline__ float bf2f(bf16_t b) { return __uint_as_float(((unsigned)b) << 16); }
__device__ __forceinline__ float bflo(unsigned w) { return __uint_as_float(w << 16); }
__device__ __forceinline__ float bfhi(unsigned w) { return __uint_as_float(w & 0xffff0000u); }
__device__ __forceinline__ bf16_t f2bf(float f) { return (bf16_t)(cvt_pk_bf16(f, 0.f) & 0xffffu); }
__device__ __forceinline__ float rcp_(float x) { return __builtin_amdgcn_rcpf(x); }
__device__ __forceinline__ float sigmoidf_(float x) { return rcp_(1.f + __expf(-x)); }
__device__ __forceinline__ int rfl(int v) { return __builtin_amdgcn_readfirstlane(v); }
__device__ __forceinline__ int tid_l() { int t = threadIdx.x; asm volatile("" : "+v"(t)); return t; }
extern __shared__ __attribute__((aligned(16))) unsigned char lds_raw[];
__device__ __forceinline__ volatile LAS unsigned* misc_words() { return (volatile LAS unsigned*)((LAS unsigned char*)lds_raw + LDS_MISC); }
__device__ __forceinline__ void park_launch_scalars() {

    if (threadIdx.x == 0) { volatile LAS unsigned* m = misc_words(); const unsigned long long ka = (unsigned long long)__builtin_amdgcn_kernarg_segment_ptr();
        m[4] = (unsigned)ka; m[5] = (unsigned)(ka >> 32); m[6] = blockIdx.x; m[7] = gridDim.x; }
}
__device__ __forceinline__ int bid_l() { return rfl((int)misc_words()[6]); }
__device__ __forceinline__ int gdim_l() { return rfl((int)misc_words()[7]); }
typedef const __attribute__((address_space(4))) Params* KParams;
__device__ __forceinline__ Params load_params() { Params r;
#if defined(__HIP_DEVICE_COMPILE__)
    volatile LAS unsigned* m = misc_words();
    const unsigned lo_ = (unsigned)rfl((int)m[4]), hi_ = (unsigned)rfl((int)m[5]);
    KParams k = (KParams)(((unsigned long long)hi_ << 32) | lo_); asm volatile("" : "+s"(k));
#pragma unroll
    for (int i = 0; i < N_IN; ++i) r.in[i] = k->in[i];
    r.out = k->out; r.ws = k->ws; r.ph_lo = k->ph_lo; r.ph_hi = k->ph_hi;
#endif
    return r; }
__device__ __forceinline__ float keep_or_ninf(float x, int keep) { const unsigned m = (unsigned)(keep >> 31); return __uint_as_float((__float_as_uint(x) & ~m) | (0xff800000u & m)); }

__device__ __forceinline__ int gdim_l();
#define XB_TMO      128
#define XB_XCNT(j)  (256  + 64 * (j))
#define XB_XSUB(j)  (1280 + 64 * (j))
#define XB_XGEN(j)  (2304 + 64 * (j))
#define XB_TOP      3328
#define XB_TOPGEN   3392
#define XCD_BAR_WORDS 3456
#define XB_SPIN_CAP (1u << 23)
__device__ __forceinline__ unsigned xb_ld(unsigned* p)              { return __hip_atomic_load(p, __ATOMIC_RELAXED, __HIP_MEMORY_SCOPE_AGENT); }
__device__ __forceinline__ unsigned xb_add(unsigned* p, unsigned v) { return __hip_atomic_fetch_add(p, v, __ATOMIC_RELAXED, __HIP_MEMORY_SCOPE_AGENT); }
__device__ __forceinline__ unsigned xb_xcc_id() { return (unsigned)__builtin_amdgcn_s_getreg((3 << 11) | 20) & 0xFu; }
#define XB_SPIN(cond, bar) do { unsigned _sp = 0; while (cond) { __builtin_amdgcn_s_sleep(1); \
    if ((++_sp & 255u) == 0u) { if (xb_ld(&(bar)[XB_TMO])) break; if (_sp > XB_SPIN_CAP) { atomicAdd(&(bar)[XB_TMO], 1u); break; } } } } while (0)
struct XcdBarrier { unsigned* bar; unsigned x; volatile LAS unsigned* st; };
__device__ __forceinline__ XcdBarrier xcd_barrier_post(unsigned* bar, volatile LAS unsigned* st) {
    XcdBarrier b; b.bar = bar; b.x = xb_xcc_id(); b.st = st;
    if (threadIdx.x == 0) (void)xb_add(&bar[XB_XCNT(b.x)], 1u);
    return b;
}
__device__ __forceinline__ void xcd_barrier_complete(unsigned* bar, unsigned x, unsigned& nloc, unsigned& nx) {
    const unsigned G = (unsigned)gdim_l();
    unsigned sum, cnt, mine, sp = 0u;
    for (;;) {
        sum = 0u; cnt = 0u; mine = 0u;
#pragma unroll
        for (unsigned j = 0; j < 16; ++j) { const unsigned c = xb_ld(&bar[XB_XCNT(j)]); sum += c; cnt += (c > 0u) ? 1u : 0u; mine = (j == x) ? c : mine; }
        if (sum == G) break;
        __builtin_amdgcn_s_sleep(1);
        if ((++sp & 255u) == 0u) { if (xb_ld(&bar[XB_TMO])) break; if (sp > XB_SPIN_CAP) { atomicAdd(&bar[XB_TMO], 1u); break; } }
    }
    nloc = mine > 0u ? mine : 1u; nx = cnt > 0u ? cnt : 1u;
}
__device__ __forceinline__ void xcd_barrier(const XcdBarrier& b) {
    asm volatile("s_waitcnt vmcnt(0)" ::: "memory");
    __syncthreads();
    if (threadIdx.x == 0) {
        unsigned* bar = b.bar; asm volatile("" : "+s"(bar));
        __builtin_amdgcn_s_waitcnt(0);
        unsigned nloc = b.st[0], nx = b.st[1];
        unsigned bx = b.x; asm volatile("" : "+s"(bx));
        if (nloc == 0u) { xcd_barrier_complete(bar, bx, nloc, nx); b.st[0] = nloc; b.st[1] = nx; }
        const unsigned old = xb_add(&bar[XB_XSUB(bx)], 1u);
        const unsigned gen = old / nloc;
        if (old + 1u == (gen + 1u) * nloc) {
            __builtin_amdgcn_fence(__ATOMIC_RELEASE, "agent");
            asm volatile("s_waitcnt vmcnt(0)" ::: "memory");
            const unsigned og = xb_add(&bar[XB_TOP], 1u);
            const unsigned tg = og / nx;
            if (og + 1u == (tg + 1u) * nx) xb_add(&bar[XB_TOPGEN], 1u);
            else XB_SPIN(xb_ld(&bar[XB_TOPGEN]) == tg, bar);
            __builtin_amdgcn_fence(__ATOMIC_ACQUIRE, "agent");
            xb_add(&bar[XB_XGEN(bx)], 1u);
            asm volatile("s_waitcnt vmcnt(0)" ::: "memory");
        } else {
            XB_SPIN(xb_ld(&bar[XB_XGEN(bx)]) == gen, bar);
            __builtin_amdgcn_fence(__ATOMIC_ACQUIRE, "agent");
            asm volatile("s_waitcnt vmcnt(0)" ::: "memory");
        }
    }
    __syncthreads();
}

__device__ __forceinline__ int t5_bucket(int dist) {
    dist = dist < 0 ? 0 : dist;
    const int big = 16 + (dist >= 22) + (dist >= 30) + (dist >= 40) + (dist >= 54) + (dist >= 73) + (dist >= 99) + (dist >= 134) + (dist >= 182)
                  + (dist >= 246) + (dist >= 332) + (dist >= 450) + (dist >= 609) + (dist >= 825) + (dist >= 1117) + (dist >= 1513);
    return dist < 16 ? dist : big;
}
constexpr int PT_WIN = 0, PT_BR = PT_WIN + 2 * 32 * 128, PT_OUT = PT_BR + 2 * 40 * 16, PT_FU = PT_OUT + 2 * 32 * 16, PT_FD = PT_FU + 32 * 88,
              PT_MU = PT_FD + 88 * 16, PT_MD = PT_MU + 8 * 16 * 112, PT_C1 = PT_MD + 8 * 56 * 16, PT_C2 = PT_C1 + 4 * 64 * 2, PT_END = PT_C2 + 4 * 4;

__device__ __forceinline__ void prep_decode(const Params& p, int id, const float*& s, int& ld_s, bf16_t*& d, int& ld_d, int& nk, const float*& gk) {
    nk = 64; gk = nullptr;
    unsigned char* ws = p.ws;
    if (id < PT_BR) { const int l = id / 4096, q_ = id % 4096, r = (q_ & 255) | ((q_ >> 9) << 8), kt = (r / 128) * 2 + ((q_ >> 8) & 1), nt = r % 128;     const int n = nt * 128, sc = n + (n < 3072 ? 0 : (n < 10240 ? 8 : 32));
        s = p.in[IN_WIN] + (size_t)l * 2048 * D_IN + (size_t)(kt * 64) * D_IN + sc; ld_s = D_IN;
        if ((MK_FUSE_N1) && l == 1) gk = p.in[IN_NMIX] + 2048 + kt * 64;
        if (n < PC_MERGE) { d = (bf16_t*)(ws + WS_WIN + l * SZ_WIN) + (size_t)n * 2048 + kt * 64; ld_d = 2048; }
        else { d = (bf16_t*)(ws + WS_WIN + l * SZ_WIN + (size_t)PC_MERGE * 4096 + (size_t)(n - PC_MERGE) * 2048 + kt * 64); ld_d = -2048; }
        return; }
    if (id < PT_OUT) { id -= PT_BR; const int l = id / 640, r = id % 640, kt = r / 16, nt = r % 16;
        const float* src = kt < 16 ? p.in[IN_WBA] + (size_t)l * 1024 * 2048 + (size_t)(kt * 64) * 2048
                         : kt < 24 ? p.in[IN_WBB] + (size_t)l * 512 * 2048 + (size_t)((kt - 16) * 64) * 2048
                                   : p.in[IN_WBC] + (size_t)l * 1024 * 2048 + (size_t)((kt - 24) * 64) * 2048;
        s = src + nt * 128; ld_s = 2048; d = (bf16_t*)(ws + WS_WBR + l * SZ_WBR) + (size_t)(nt * 128) * 2560 + kt * 64; ld_d = 2560; return; }
    if (id < PT_FU) { id -= PT_OUT; const int l = id / 512, r = id % 512, kt = r / 16, nt = r % 16;
        s = p.in[IN_WOUT] + (size_t)l * 2048 * 2048 + (size_t)(kt * 64) * 2048 + nt * 128; ld_s = 2048; d = (bf16_t*)(ws + WS_WOUT + l * SZ_WOUT) + (size_t)(nt * 128) * 2048 + kt * 64; ld_d = 2048; return; }
    if (id < PT_FD) { id -= PT_FU; const int kt = id / 88, nt = id % 88;
        s = ((nt & 1) ? p.in[IN_FU] : p.in[IN_FG]) + (size_t)(kt * 64) * DFF + (nt >> 1) * 128; ld_s = DFF;
        if (MK_FUSE_N2) gk = p.in[IN_NFFN] + kt * 64;
        if (MK_FFN_F8 & 1) { d = (bf16_t*)(ws + WS_WFU + (size_t)(nt * 128) * 2048 + kt * 64); ld_d = -2048; } else { d = (bf16_t*)(ws + WS_WFU) + (size_t)(nt * 128) * 2048 + kt * 64; ld_d = 2048; } return; }
    if (id < PT_MU) { id -= PT_FD; const int kt = id / 16, nt = id % 16;
        s = p.in[IN_FD] + (size_t)(kt * 64) * 2048 + nt * 128; ld_s = 2048;
        if (MK_FFN_F8 & 2) { d = (bf16_t*)(ws + WS_WFD + (size_t)(nt * 128) * DFF + kt * 64); ld_d = -DFF; } else { d = (bf16_t*)(ws + WS_WFD) + (size_t)(nt * 128) * DFF + kt * 64; ld_d = DFF; } return; }
    if (id < PT_MD) { id -= PT_MU; const int e = id / 1792, r = id % 1792, kh = r / 112, nt = r % 112; nk = 128;
        s = ((nt & 1) ? p.in[IN_MU] : p.in[IN_MG]) + (size_t)e * 2048 * DFFE + (size_t)(kh * 128) * DFFE + (nt >> 1) * 128; ld_s = DFFE;
        if (MK_FUSE_N2) gk = p.in[IN_NFFN] + 2048 + kh * 128;
        d = (bf16_t*)(ws + WS_WMU + e * (SZ_WMU1 / 2) + (size_t)(nt * 128) * 2048 + kh * 128); ld_d = -2048; return; }
    if (id < PT_C1) { id -= PT_MD; const int e = id / 896, r = id % 896, kh = r / 16, nt = r % 16; nk = 128;
        s = p.in[IN_MD] + (size_t)e * DFFE * 2048 + (size_t)(kh * 128) * 2048 + nt * 128; ld_s = 2048; d = (bf16_t*)(ws + WS_WMD + e * (SZ_WMD1 / 2) + (size_t)(nt * 128) * DFFE + kh * 128); ld_d = -DFFE; return; }
    if (id < PT_C2) { id -= PT_C1; const int j = id / 128, r = id % 128, kt = r / 2, nt = r % 2; const int l = j >> 1, kv = j & 1;
        s = p.in[kv ? IN_W1V : IN_W1K] + (size_t)l * 4096 * 256 + (size_t)(kt * 64) * 256 + nt * 128; ld_s = 256; d = (bf16_t*)(ws + WS_WC1 + j * SZ_WC1) + (size_t)(nt * 128) * 4096 + kt * 64; ld_d = 4096; return; }
    { id -= PT_C2; const int j = id / 4, kt = id % 4; const int l = j >> 1, kv = j & 1;
        s = p.in[kv ? IN_W2V : IN_W2K] + (size_t)l * 256 * 128 + (size_t)(kt * 64) * 128; ld_s = 128; d = (bf16_t*)(ws + WS_WC2 + j * SZ_WC2) + kt * 64; ld_d = 256; return; }
}

typedef int i32x8 __attribute__((ext_vector_type(8)));
#if MK_FP8PROBE
__device__ __forceinline__ void fp8_probe(const Params& p) {
    if (bid_l() != 0 || tid_l() >= 64) return;
    const int l = tid_l() & 63, i = l & 15, q = l >> 4;
    i32x8 A, B;
#pragma unroll
    for (int w = 0; w < 8; ++w) { int aw = 0, bw = 0;
#define HALF_(h) { const int pp = w * 4 + h * 2, k0 = 32 * q + pp, k1 = k0 + 1; \
            const float a0 = ((k0 & 15) == i) ? 1.f : 0.f, a1 = ((k1 & 15) == i) ? 1.f : 0.f; \
            const float b0 = ((k0 >> 4) == (i & 7)) ? (float)((k0 & 15) + 1) : 0.f, b1 = ((k1 >> 4) == (i & 7)) ? (float)((k1 & 15) + 1) : 0.f; \
            aw = __builtin_amdgcn_cvt_pk_fp8_f32(a0, a1, aw, h); bw = __builtin_amdgcn_cvt_pk_fp8_f32(b0, b1, bw, h); }
        HALF_(0) HALF_(1)
#undef HALF_
        A[w] = aw; B[w] = bw; }
    const f32x4 c = {0.f, 0.f, 0.f, 0.f};
    const f32x4 d0 = __builtin_amdgcn_mfma_scale_f32_16x16x128_f8f6f4(A, B, c, 0, 0, 0, 0, 0, 0);
    const f32x4 d1 = __builtin_amdgcn_mfma_scale_f32_16x16x128_f8f6f4(A, B, c, 0, 0, 0, 0x7f7f7f7f, 0, 0x7f7f7f7f);
    bool ok0 = true, ok1 = true;
#pragma unroll
    for (int r = 0; r < 4; ++r) { const float e = (float)(4 * q + r + 1); ok0 = ok0 && (d0[r] == e); ok1 = ok1 && (d1[r] == e); }
    const unsigned long long m0 = __ballot(ok0), m1 = __ballot(ok1);
    if (l == 0) { unsigned* ctl = (unsigned*)(p.ws + WS_CTL); ctl[CW_DBG + 8] = (m0 == ~0ull) ? 1u : 0u; ctl[CW_DBG + 9] = (m1 == ~0ull) ? 1u : 0u; }
}
#endif
#ifndef MK_PREP_NTLD
#define MK_PREP_NTLD 0
#endif
#if MK_PREP_NTLD
#define PREP_LD(ptr) __builtin_nontemporal_load(ptr)
#else
#define PREP_LD(ptr) (*(ptr))
#endif
#ifndef MK_PREP_NT
#define MK_PREP_NT 3
#endif
#if MK_PREP_NT & 1
#define PREP_ST(ptr, v) __builtin_nontemporal_store(v, ptr)
#else
#define PREP_ST(ptr, v) (*(ptr) = (v))
#endif
#if MK_PREP_NT & 2
#define PREP_ST_HALF(ptr, v) __builtin_nontemporal_store(v, ptr)
#else
#define PREP_ST_HALF(ptr, v) (*(ptr) = (v))
#endif
__device__ __forceinline__ void phase_prep(const Params& p, LAS unsigned char* lds, const bool nostore = false) {
#if MK_FP8PROBE
    fp8_probe(p);
#endif
    const int tid = tid_l(), G = gdim_l();
    LAS float* sm = (LAS float*)lds;
    const int lk = tid >> 5, ln = (tid & 31) * 4;
    f32x4 v[8];
    const float* s; int ld_s; bf16_t* d; int ld_d; int nk; const float* gk;
    int id = bid_l();
    if (id < PT_END) { prep_decode(p, id, s, ld_s, d, ld_d, nk, gk);
#pragma unroll
        for (int i = 0; i < 8; ++i) if (i < 4 || nk == 128) v[i] = PREP_LD((const f32x4*)(s + (size_t)(lk + 16 * i) * ld_s + ln)); }
    for (; id < PT_END; id += G) {
        bf16_t* dcur = d; const int ldc = ld_d; const bool big = nk == 128;
        if (gk) {
#pragma unroll
            for (int i = 0; i < 8; ++i) if (i < 4 || big) v[i] = v[i] * gk[lk + 16 * i]; }
        { const int sh = (ldc > 0 || big) ? 3 : 4;
#pragma unroll
          for (int i = 0; i < 8; ++i) if (i < 4 || big) *(LAS f32x4*)(sm + (lk + 16 * i) * 132 + (ln ^ (i << sh))) = v[i]; }
        const int nid = id + G;
        if (nid < PT_END) { prep_decode(p, nid, s, ld_s, d, ld_d, nk, gk);
#pragma unroll
            for (int i = 0; i < 8; ++i) if (i < 4 || nk == 128) v[i] = PREP_LD((const f32x4*)(s + (size_t)(lk + 16 * i) * ld_s + ln)); }
        __syncthreads();
        if (nostore && dcur != nullptr) {} else
        if (ldc > 0) { const int kc = tid & 7;
#pragma unroll
            for (int ps = 0; ps < 2; ++ps) { const int n = (tid >> 3) + 64 * ps; LAS const float* sp = sm + (8 * kc) * 132 + (n ^ ((kc >> 1) << 3)); unsigned w[4];
#pragma unroll
                for (int j = 0; j < 4; ++j) w[j] = cvt_pk_bf16(sp[(2 * j) * 132], sp[(2 * j + 1) * 132]);
                PREP_ST((u32x4*)(dcur + (size_t)n * ldc + 8 * kc), ((u32x4){w[0], w[1], w[2], w[3]})); } }
        else if (big) { const int kc = tid & 7;
#pragma unroll
            for (int ps = 0; ps < 2; ++ps) { const int n = (tid >> 3) + 64 * ps; LAS const float* sp = sm + (16 * kc) * 132 + (n ^ (kc << 3)); int qq[4] = {0, 0, 0, 0};
#pragma unroll
                for (int j = 0; j < 4; ++j) { const unsigned w0 = cvt_pk_bf16(sp[(4 * j) * 132], sp[(4 * j + 1) * 132]), w1 = cvt_pk_bf16(sp[(4 * j + 2) * 132], sp[(4 * j + 3) * 132]);
                    qq[j] = __builtin_amdgcn_cvt_pk_fp8_f32(64.f * bflo(w0), 64.f * bfhi(w0), qq[j], false); qq[j] = __builtin_amdgcn_cvt_pk_fp8_f32(64.f * bflo(w1), 64.f * bfhi(w1), qq[j], true); }
                PREP_ST((u32x4*)((unsigned char*)dcur + (size_t)n * (size_t)(-ldc) + 16 * kc), ((u32x4){(unsigned)qq[0], (unsigned)qq[1], (unsigned)qq[2], (unsigned)qq[3]})); } }
        else { const int kc = tid & 3, n = tid >> 2; LAS const float* sp = sm + (16 * kc) * 132 + (n ^ (kc << 4)); int qq[4] = {0, 0, 0, 0};
#pragma unroll
            for (int j = 0; j < 4; ++j) { const unsigned w0 = cvt_pk_bf16(sp[(4 * j) * 132], sp[(4 * j + 1) * 132]), w1 = cvt_pk_bf16(sp[(4 * j + 2) * 132], sp[(4 * j + 3) * 132]);
                qq[j] = __builtin_amdgcn_cvt_pk_fp8_f32(64.f * bflo(w0), 64.f * bfhi(w0), qq[j], false); qq[j] = __builtin_amdgcn_cvt_pk_fp8_f32(64.f * bflo(w1), 64.f * bfhi(w1), qq[j], true); }
            PREP_ST_HALF((u32x4*)((unsigned char*)dcur + (size_t)n * (size_t)(-ldc) + 16 * kc), ((u32x4){(unsigned)qq[0], (unsigned)qq[1], (unsigned)qq[2], (unsigned)qq[3]})); }
        __syncthreads();
    }
    const int gt = bid_l() * 512 + tid;
    for (int i = gt; i < 2 * 32 * 2048; i += G * 512) { const int l = i >> 16, r = (i >> 11) & 31, k = i & 2047; const int sc = r < 8 ? 3072 + r : 10248 + (r - 8);
        const float gsc_ = ((MK_FUSE_N1) && l == 1) ? p.in[IN_NMIX][2048 + k] : 1.f;
        ((bf16_t*)(p.ws + WS_WG32))[i] = f2bf(gsc_ * p.in[IN_WIN][(size_t)l * 2048 * D_IN + (size_t)k * D_IN + sc]); }
    { const int wv = gt >> 6, lane = tid & 63;
      if (wv < 1024) { const int j = wv >> 8, n = wv & 255, l = j >> 1, kv = j & 1;
        const float* pe = p.in[kv ? IN_PEV : IN_PEK] + (size_t)l * 4096; const float* w1 = p.in[kv ? IN_W1V : IN_W1K] + (size_t)l * 4096 * 256 + n;
        float a = 0.f;
#pragma unroll 1
        for (int k0 = lane; k0 < 4096; k0 += 1024) { float x_[16], y_[16];
#pragma unroll
            for (int i = 0; i < 16; ++i) { x_[i] = pe[k0 + 64 * i]; y_[i] = w1[(size_t)(k0 + 64 * i) * 256]; }
#pragma unroll
            for (int i = 0; i < 16; ++i) a += x_[i] * y_[i]; }
        for (int o = 32; o >= 1; o >>= 1) a += __shfl_xor(a, o);
        if (lane == 0) ((float*)(p.ws + WS_CB1))[wv] = a; } }
}

template <bool ROUTE, bool F8OUT, bool XB16>
__device__ __forceinline__ void phase_norm(const Params& p, const void* x, const float* g, bf16_t* h, LAS unsigned char* lds) {
    const int tid = tid_l(), wid = tid >> 6, lane = tid & 63;
    LAS int* cnt = (LAS int*)lds;
    if (ROUTE) { if (tid < 8) cnt[tid] = 0; __syncthreads(); }
    const unsigned vo16 = (unsigned)lane * 16u, vo128 = (unsigned)lane * 128u;
    for (int rb0 = bid_l(); rb0 < T / 64; rb0 += gdim_l()) {
        const int rb = (gdim_l() == 256) ? ((rb0 & 7) * 32 + (rb0 >> 3)) : rb0;
        if constexpr (!XB16 && (MK_FUSE_N2)) { if (tid < 64) { ((unsigned*)(p.ws + WS_SS))[rb * 64 + tid] = 0u; ((unsigned*)(p.ws + WS_SS1))[rb * 64 + tid] = 0u; } }
        f32x4 vn[8]; u32x2 vb[8];
        { const size_t r0_ = (size_t)(rb * 64 + wid * 8);
#pragma unroll
          for (int j = 0; j < 8; ++j) { if constexpr (XB16) vb[j] = *(const u32x2*)((const char*)x + r0_ * 4096 + j * 512 + lane * 8); else vn[j] = *(const f32x4*)((const char*)x + r0_ * 8192 + j * 1024 + vo16); } }
#pragma unroll 1
        for (int i = 0; i < 8; ++i) {
            const int row = rb * 64 + wid * 8 + i;
            f32x4 v[8]; float ss = 0.f;
#pragma unroll
            for (int j = 0; j < 8; ++j) { if constexpr (XB16) v[j] = (f32x4){bflo(vb[j].x), bfhi(vb[j].x), bflo(vb[j].y), bfhi(vb[j].y)}; else v[j] = vn[j];
                ss += v[j][0] * v[j][0] + v[j][1] * v[j][1] + v[j][2] * v[j][2] + v[j][3] * v[j][3]; }
            if (i < 7) { const size_t r1_ = (size_t)(row + 1);
#pragma unroll
                for (int j = 0; j < 8; ++j) { if constexpr (XB16) vb[j] = *(const u32x2*)((const char*)x + r1_ * 4096 + j * 512 + lane * 8); else vn[j] = *(const f32x4*)((const char*)x + r1_ * 8192 + j * 1024 + vo16); } }
            for (int o = 32; o >= 1; o >>= 1) ss += __shfl_xor(ss, o);
            const float inv = rsqrtf(ss * (1.0f / 2048.0f) + RMS_EPS);
            float lg[8] = {0.f, 0.f, 0.f, 0.f, 0.f, 0.f, 0.f, 0.f};
#pragma unroll
            for (int j = 0; j < 8; ++j) { const f32x4 gv = *(const f32x4*)((const char*)g + j * 1024 + vo16); const f32x4 y = v[j] * inv * gv;
                u32x2 w; w.x = cvt_pk_bf16(y[0], y[1]); w.y = cvt_pk_bf16(y[2], y[3]);
                if (!(ROUTE && (MK_FUSE_N2))) *(u32x2*)(h + (size_t)row * 2048 + (lane + 64 * j) * 4) = w;
                if (F8OUT) { int q8 = 0; q8 = __builtin_amdgcn_cvt_pk_fp8_f32(4.f * y[0], 4.f * y[1], q8, false); q8 = __builtin_amdgcn_cvt_pk_fp8_f32(4.f * y[2], 4.f * y[3], q8, true);
                    *(int*)(p.ws + WS_H8 + (size_t)row * 2048 + (lane + 64 * j) * 4) = q8; }
                if (ROUTE) { const char* rw = (const char*)p.in[IN_ROUTER] + j * 8192;
#pragma unroll
                    for (int q = 0; q < 4; ++q) { const f32x4 a = *(const f32x4*)(rw + vo128 + q * 32), b = *(const f32x4*)(rw + vo128 + q * 32 + 16);
                        lg[0] += y[q] * a[0]; lg[1] += y[q] * a[1]; lg[2] += y[q] * a[2]; lg[3] += y[q] * a[3];
                        lg[4] += y[q] * b[0]; lg[5] += y[q] * b[1]; lg[6] += y[q] * b[2]; lg[7] += y[q] * b[3]; }
                    asm volatile("" ::: "memory"); } }
            if (ROUTE) {
#pragma unroll
                for (int e = 0; e < 8; ++e) for (int o = 32; o >= 1; o >>= 1) lg[e] += __shfl_xor(lg[e], o);
                if (lane == 0) {
                    if (MK_FUSE_N2) ((float*)(p.ws + WS_SS))[row] = inv;
                    int e0 = 0; float v0 = lg[0];
#pragma unroll
                    for (int e = 1; e < 8; ++e) if (lg[e] > v0) { v0 = lg[e]; e0 = e; }
                    int e1 = -1; float v1 = -__builtin_inff();
#pragma unroll
                    for (int e = 0; e < 8; ++e) if (e != e0 && lg[e] > v1) { v1 = lg[e]; e1 = e; }
                    const float w0 = 1.f / (1.f + expf(v1 - v0)), w1 = 1.f - w0;
                    int* toke = (int*)(p.ws + WS_ROUTE); float* tokw = (float*)(p.ws + WS_ROUTE + (size_t)T * 8);
                    toke[row * 2] = e0; toke[row * 2 + 1] = e1; tokw[row * 2] = w0; tokw[row * 2 + 1] = w1;
                    atomicAdd((int*)&cnt[e0], 1); atomicAdd((int*)&cnt[e1], 1);
                }
            }
        }
        if (ROUTE) { __syncthreads(); if (tid < 8) { ((int*)(p.ws + WS_CTL))[CW_CNT + rb * 8 + tid] = cnt[tid]; cnt[tid] = 0; } __syncthreads(); }
    }
}

__device__ __forceinline__ void phase_final(const Params& p, const float* g, float* dst) {
    const int tid = tid_l(), wid = tid >> 6, lane = tid & 63;
    const int* slot = (const int*)(p.ws + WS_ROUTE + (size_t)T * 16);
    const bf16_t* om = (const bf16_t*)(p.ws + WS_HG);
    for (int rb0 = bid_l(); rb0 < T / 64; rb0 += gdim_l()) {
        const int rb = (gdim_l() == 256) ? ((rb0 & 7) * 32 + (rb0 >> 3)) : rb0;
        const int myslot = lane < 16 ? slot[(rb * 64 + wid * 8) * 2 + lane] : 0;
#pragma unroll 1
        for (int i = 0; i < 8; ++i) {
            const int row = rb * 64 + wid * 8 + i;
            const int s0 = __shfl(myslot, 2 * i), s1 = __shfl(myslot, 2 * i + 1);
            const u32x4* xr = (const u32x4*)((const bf16_t*)(p.ws + WS_XB) + (size_t)row * 2048);
            const u32x4* o0 = (const u32x4*)(om + (size_t)s0 * 2048); const u32x4* o1 = (const u32x4*)(om + (size_t)s1 * 2048);
            f32x4 v[4][2]; u32x4 a[4], b[4], xw[4];
            const unsigned* tmap = (const unsigned*)(p.ws + WS_CTL) + CW_TMAP; const bf16_t* part = (const bf16_t*)(p.ws + WS_OMPART);
            unsigned tm0[4], tm1[4];
#pragma unroll
            for (int j = 0; j < 4; ++j) { const int pn = 2 * j + (lane >> 5); tm0[j] = tmap[(s0 >> 8) * 8 + pn]; tm1[j] = tmap[(s1 >> 8) * 8 + pn]; }
#pragma unroll
            for (int j = 0; j < 4; ++j) { xw[j] = xr[lane + 64 * j]; a[j] = o0[lane + 64 * j]; b[j] = o1[lane + 64 * j]; }
#pragma unroll
            for (int j = 0; j < 4; ++j) {
                if (tm0[j]) { const bf16_t* pp = part + ((size_t)(tm0[j] - 1) * 256 + (s0 & 255)) * 256 + (lane & 31) * 8; float s_[8] = {0.f, 0.f, 0.f, 0.f, 0.f, 0.f, 0.f, 0.f};
#pragma unroll
                    for (int ks = 0; ks < 4; ++ks) { const u32x4 w = *(const u32x4*)(pp + (size_t)ks * 64 * 65536);
                        s_[0] += bflo(w.x); s_[1] += bfhi(w.x); s_[2] += bflo(w.y); s_[3] += bfhi(w.y); s_[4] += bflo(w.z); s_[5] += bfhi(w.z); s_[6] += bflo(w.w); s_[7] += bfhi(w.w); }
                    a[j] = (u32x4){cvt_pk_bf16(s_[0], s_[1]), cvt_pk_bf16(s_[2], s_[3]), cvt_pk_bf16(s_[4], s_[5]), cvt_pk_bf16(s_[6], s_[7])}; }
                if (tm1[j]) { const bf16_t* pp = part + ((size_t)(tm1[j] - 1) * 256 + (s1 & 255)) * 256 + (lane & 31) * 8; float s_[8] = {0.f, 0.f, 0.f, 0.f, 0.f, 0.f, 0.f, 0.f};
#pragma unroll
                    for (int ks = 0; ks < 4; ++ks) { const u32x4 w = *(const u32x4*)(pp + (size_t)ks * 64 * 65536);
                        s_[0] += bflo(w.x); s_[1] += bfhi(w.x); s_[2] += bflo(w.y); s_[3] += bfhi(w.y); s_[4] += bflo(w.z); s_[5] += bfhi(w.z); s_[6] += bflo(w.w); s_[7] += bfhi(w.w); }
                    b[j] = (u32x4){cvt_pk_bf16(s_[0], s_[1]), cvt_pk_bf16(s_[2], s_[3]), cvt_pk_bf16(s_[4], s_[5]), cvt_pk_bf16(s_[6], s_[7])}; } }
#pragma unroll
            for (int j = 0; j < 4; ++j) { v[j][0] = (f32x4){bflo(xw[j].x), bfhi(xw[j].x), bflo(xw[j].y), bfhi(xw[j].y)}; v[j][1] = (f32x4){bflo(xw[j].z), bfhi(xw[j].z), bflo(xw[j].w), bfhi(xw[j].w)}; }
            float ss = 0.f;
#pragma unroll
            for (int j = 0; j < 4; ++j) {
                v[j][0][0] += bflo(a[j][0]) + bflo(b[j][0]); v[j][0][1] += bfhi(a[j][0]) + bfhi(b[j][0]); v[j][0][2] += bflo(a[j][1]) + bflo(b[j][1]); v[j][0][3] += bfhi(a[j][1]) + bfhi(b[j][1]);
                v[j][1][0] += bflo(a[j][2]) + bflo(b[j][2]); v[j][1][1] += bfhi(a[j][2]) + bfhi(b[j][2]); v[j][1][2] += bflo(a[j][3]) + bflo(b[j][3]); v[j][1][3] += bfhi(a[j][3]) + bfhi(b[j][3]);
#pragma unroll
                for (int q = 0; q < 2; ++q) ss += v[j][q][0] * v[j][q][0] + v[j][q][1] * v[j][q][1] + v[j][q][2] * v[j][q][2] + v[j][q][3] * v[j][q][3]; }
            for (int o = 32; o >= 1; o >>= 1) ss += __shfl_xor(ss, o);
            const float inv = rsqrtf(ss * (1.0f / 2048.0f) + RMS_EPS);
#pragma unroll
            for (int j = 0; j < 4; ++j)
#pragma unroll
                for (int q = 0; q < 2; ++q) ((f32x4*)(dst + (size_t)row * 2048))[(lane + 64 * j) * 2 + q] = v[j][q] * inv * ((const f32x4*)g)[(lane + 64 * j) * 2 + q];
        }
    }
}

__device__ __forceinline__ void moe_offsets(const Params& p, LAS int* sm  , int& nrt) {
    const int tid = tid_l();
    const int* cnt = (const int*)(p.ws + WS_CTL) + CW_CNT;
    for (int i = tid; i < 2048; i += 512) sm[i] = cnt[i];
    __syncthreads();
    if (tid < 8) { int s = 0; for (int c = 0; c < 256; ++c) s += sm[c * 8 + tid]; sm[2048 + tid] = s; }
    __syncthreads();
    if (tid == 0) { int off = 0; for (int e = 0; e < 8; ++e) { sm[2056 + e] = off; off += (sm[2048 + e] + 255) & ~255; } sm[2064] = off; }
    __syncthreads();
    nrt = sm[2064] >> 8;
}
__device__ __forceinline__ void phase_moe_scatter(const Params& p, LAS unsigned char* lds) {
    const int tid = tid_l(), wid = tid >> 6, lane = tid & 63;
    LAS int* sm = (LAS int*)lds; int nrt; moe_offsets(p, sm, nrt);
    const int* toke = (const int*)(p.ws + WS_ROUTE); const float* tokw = (const float*)(p.ws + WS_ROUTE + (size_t)T * 8);
    int* slot = (int*)(p.ws + WS_ROUTE + (size_t)T * 16); float* roww = (float*)(p.ws + WS_ROUTE + (size_t)T * 24);
    const bf16_t* h2 = (const bf16_t*)(p.ws + ((MK_FUSE_N2) ? WS_XB : WS_H)); bf16_t* hg = (bf16_t*)(p.ws + WS_HG); const float* invs = (const float*)(p.ws + WS_SS);
    LAS int* ls = sm + 2080;
    for (int c = bid_l(); c < 256; c += gdim_l()) {
        LAS int* le = ls + 128; LAS float* lw = (LAS float*)(ls + 256);
        if (tid < 128) { le[tid] = toke[c * 128 + tid]; lw[tid] = tokw[c * 128 + tid]; }
        __syncthreads();
        if (tid < 8) { const int e = tid; int base = sm[2056 + e]; for (int cc = 0; cc < c; ++cc) base += sm[cc * 8 + e];
            for (int r = 0; r < 128; ++r) if (le[r] == e) { ls[r] = base; ++base; } }
        __syncthreads();
        if (tid < 128) { const int s = ls[tid]; slot[c * 128 + tid] = s; roww[s] = lw[tid]; }
#pragma unroll 1
        for (int tb = 0; tb < 8; tb += 4) {
            u32x4 a[4][2], b2[4][2];
#pragma unroll
            for (int q = 0; q < 4; ++q) { const int tok = c * 64 + wid + 8 * (tb + q); const u32x4* src = (const u32x4*)(h2 + (size_t)tok * 2048);
#pragma unroll
                for (int j = 0; j < 2; ++j) { a[q][j] = src[2 * lane + 128 * j]; b2[q][j] = src[2 * lane + 1 + 128 * j]; } }
#pragma unroll
            for (int q = 0; q < 4; ++q) { const int tl = wid + 8 * (tb + q); const int s0 = ls[2 * tl], s1 = ls[2 * tl + 1]; const float f4 = (MK_FUSE_N2) ? 4.f * invs[c * 64 + tl] : 4.f;
                u32x4* d0 = (u32x4*)((unsigned char*)hg + (size_t)s0 * 2048); u32x4* d1 = (u32x4*)((unsigned char*)hg + (size_t)s1 * 2048);
#pragma unroll
                for (int j = 0; j < 2; ++j) { const u32x4 x = a[q][j], y = b2[q][j]; int w[4] = {0, 0, 0, 0};
                    w[0] = __builtin_amdgcn_cvt_pk_fp8_f32(f4 * bflo(x[0]), f4 * bfhi(x[0]), w[0], false); w[0] = __builtin_amdgcn_cvt_pk_fp8_f32(f4 * bflo(x[1]), f4 * bfhi(x[1]), w[0], true);
                    w[1] = __builtin_amdgcn_cvt_pk_fp8_f32(f4 * bflo(x[2]), f4 * bfhi(x[2]), w[1], false); w[1] = __builtin_amdgcn_cvt_pk_fp8_f32(f4 * bflo(x[3]), f4 * bfhi(x[3]), w[1], true);
                    w[2] = __builtin_amdgcn_cvt_pk_fp8_f32(f4 * bflo(y[0]), f4 * bfhi(y[0]), w[2], false); w[2] = __builtin_amdgcn_cvt_pk_fp8_f32(f4 * bflo(y[1]), f4 * bfhi(y[1]), w[2], true);
                    w[3] = __builtin_amdgcn_cvt_pk_fp8_f32(f4 * bflo(y[2]), f4 * bfhi(y[2]), w[3], false); w[3] = __builtin_amdgcn_cvt_pk_fp8_f32(f4 * bflo(y[3]), f4 * bfhi(y[3]), w[3], true);
                    const u32x4 o = {(unsigned)w[0], (unsigned)w[1], (unsigned)w[2], (unsigned)w[3]};
                    d0[lane + 64 * j] = o; d1[lane + 64 * j] = o; } } }
        __syncthreads();
    }
    if (bid_l() == 0 && tid < 8) { const int e = tid; const int b = sm[2056 + e] + sm[2048 + e], en = sm[2056 + e] + ((sm[2048 + e] + 255) & ~255); for (int r = b; r < en; ++r) roww[r] = 0.f; }
}

__device__ __forceinline__ void phase_fox_cumsum(const Params& p, int layer) {
    const int gw = (bid_l() * 512 + tid_l()) >> 6, lane = tid_l() & 63, nw = (gdim_l() * 512) >> 6;
    const float* gates = (const float*)(p.ws + WS_GATES); float* cneg = (float*)(p.ws + WS_CNEG); float* ctot = (float*)(p.ws + WS_CTOT);
    for (int u = gw; u < 256; u += nw) { const int b = u >> 6, ch = u & 63; const int tok = b * SEQ + ch * 64 + lane;
        const f32x4 f0 = *(const f32x4*)(gates + (size_t)tok * 32), f1 = *(const f32x4*)(gates + (size_t)tok * 32 + 4);
        float x[8] = {f0[0], f0[1], f0[2], f0[3], f1[0], f1[1], f1[2], f1[3]};
#pragma unroll
        for (int hh = 0; hh < 8; ++hh) { const float v = x[hh] + p.in[IN_FOXB][layer * 8 + hh]; float inc = fminf(v, 0.f) - log1pf(expf(-fabsf(v)));
            for (int o = 1; o < 64; o <<= 1) { const float t = __shfl_up(inc, o); if (lane >= o) inc += t; }
            cneg[(size_t)(b * 8 + hh) * SEQ + ch * 64 + lane] = -inc * (1.0f / SM_SCALE);
            if (lane == 63) ctot[(b * 8 + hh) * 64 + ch] = -inc * (1.0f / SM_SCALE); } }
}

__device__ __forceinline__ void phase_gates(const Params& p, int layer) {
    const int gw = (bid_l() * 512 + tid_l()) >> 6, lane = tid_l() & 63, nw = (gdim_l() * 512) >> 6;
    const bool fused = (MK_FUSE_N1) && layer == 1; const unsigned* ss1 = (const unsigned*)(p.ws + WS_SS1);
    const bf16_t* h = (const bf16_t*)(p.ws + (fused ? WS_XB : WS_H)); const bf16_t* w = (const bf16_t*)(p.ws + WS_WG32 + layer * SZ_WG32);
    float* gates = (float*)(p.ws + WS_GATES);
    const int fr = lane & 15, fq = lane >> 4;
    for (int u2 = gw; u2 < T / 8; u2 += nw) { const int u = u2 >> 1, ct = u2 & 1;
        f32x4 a0 = {0.f, 0.f, 0.f, 0.f}, a1 = {0.f, 0.f, 0.f, 0.f};
        const bf16_t* ap = h + (size_t)(u * 16 + fr) * 2048 + fq * 8; const bf16_t* b0 = w + (size_t)(ct * 16 + fr) * 2048 + fq * 8;
#pragma unroll 8
        for (int ks = 0; ks < 64; ks += 2) { const bf16x8 x0 = *(const bf16x8*)(ap + ks * 32), y0 = *(const bf16x8*)(b0 + ks * 32), x1 = *(const bf16x8*)(ap + ks * 32 + 32), y1 = *(const bf16x8*)(b0 + ks * 32 + 32);
            a0 = __builtin_amdgcn_mfma_f32_16x16x32_bf16(x0, y0, a0, 0, 0, 0); a1 = __builtin_amdgcn_mfma_f32_16x16x32_bf16(x1, y1, a1, 0, 0, 0); }
#pragma unroll
        for (int i = 0; i < 4; ++i) { const int row_ = u * 16 + fq * 4 + i; const float iv_ = fused ? rsqrtf((float)ss1[row_] * (1.0f / 4096.0f / 2048.0f) + RMS_EPS) : 1.f;
            gates[(size_t)row_ * 32 + ct * 16 + fr] = (a0[i] + a1[i]) * iv_; }
    }
}
namespace pg8 {
constexpr int BM = 256, BK = 64, HALF = 128, HTB = HALF * BK * 2, STAGE_BYTES = 8 * HTB, NXCD = 8, WGM = 4;
__device__ __forceinline__ int lds_byte(int r, int c) { const int st = (r >> 4) * 2 + (c >> 5), rr = r & 15, cc = c & 31, ob = rr * 64 + cc * 2; return st * 1024 + (ob ^ (((ob >> 9) & 1) << 5)); }
__device__ __forceinline__ void stage_rc(int b, int& R, int& C) { const int st = b / 1024, sb = b % 1024, swz = sb ^ (((sb >> 9) & 1) << 5); R = (st >> 1) * 16 + swz / 64; C = (st & 1) * 32 + (swz % 64) / 2; }
__device__ __forceinline__ int perm32(int rho) { const int n = rho >> 4, i = rho & 15; return 8 * (i >> 2) + 4 * n + (i & 3); }

struct GUnit { size_t aoff, boff; int row0, col0, aux; int nt = 0, sub = 0; };
struct GemmP { const char* A; const char* B; unsigned rsB; size_t ks2A; int nt; };
struct LinRow { unsigned rs; __device__ __forceinline__ unsigned operator()(int R) const { return (unsigned)R * rs; } };

__device__ __forceinline__ bool static_tile_L(long L, int nM, int nN, int& pm, int& pn, int wgm = WGM) {
    const int nwg = nM * nN; if (L >= nwg) return false;
    int wgid = (int)L; { const int q = nwg / NXCD, r = nwg % NXCD, xcd = wgid % NXCD, off = wgid / NXCD; wgid = (xcd < r ? xcd * (q + 1) : r * (q + 1) + (xcd - r) * q) + off; }
    const int nig = wgm * nN, gid = wgid / nig, fm = gid * wgm, gsz = (nM - fm) < wgm ? (nM - fm) : wgm;
    pm = fm + ((wgid % nig) % gsz); pn = (wgid % nig) / gsz; return true;
}
__device__ __forceinline__ bool static_tile(int i, int G, int c, int nM, int nN, int& pm, int& pn, int wgm = WGM) { return static_tile_L((long)i * G + c, nM, nN, pm, pn, wgm); }
struct StaticOrder {
    int nM, nN, G, c; size_t tsA, tsB; int wgm = WGM;
    __device__ __forceinline__ bool next(int i, GUnit& u) const { int pm, pn; if (!static_tile(i, G, c, nM, nN, pm, pn, wgm)) return false;
        u.aoff = (size_t)pm * tsA; u.boff = (size_t)pn * tsB; u.row0 = pm * BM; u.col0 = pn * BM; u.aux = 0; return true; }
};

template <class Epi, class Sched, class RowA>
__device__ __forceinline__ void gemm_phase(LAS unsigned char* lds, const GemmP g, const Sched& S, const Epi& E, const RowA& rowA) {
    const int tid = tid_l(), wid = __builtin_amdgcn_readfirstlane(tid >> 6), lane = tid & 63, wr = wid >> 2, wc = wid & 3, fr = lane & 15, fq = lane >> 4;
    const int nt = g.nt;
    unsigned voffA[2], voffB[2];
#pragma unroll
    for (int i = 0; i < 2; ++i) { int R, C; stage_rc(tid * 16 + i * 8192, R, C); const int Rb = Epi::PERM ? ((R & ~31) + perm32(R & 31)) : R;
        voffA[i] = rowA(R) + (unsigned)C * 2u; voffB[i] = (unsigned)Rb * g.rsB + (unsigned)C * 2u; }
    const size_t hstepA = (size_t)rowA(HALF), hstepB = (size_t)HALF * g.rsB;
    const size_t ks2A = g.ks2A;
    const unsigned ldsw = (unsigned)wid * 1024u;
    const int aoff = lds_byte(wr * 64 + fr, fq * 8), boff = lds_byte(wc * 32 + fr, fq * 8);
#define PG8_SA(b, h) (((b) * 2 + (h)) * HTB)
#define PG8_SB(b, h) ((4 + (b) * 2 + (h)) * HTB)
#define PG8_STAGE(bufoff, gbase, voff) do { const unsigned long long gb_ = (unsigned long long)(gbase); const char* gu_ = (const char*)(((unsigned long long)(unsigned)__builtin_amdgcn_readfirstlane((int)(gb_ >> 32)) << 32) | (unsigned)__builtin_amdgcn_readfirstlane((int)gb_));   \
        _Pragma("unroll") for (int _i = 0; _i < 2; ++_i) \
        __builtin_amdgcn_global_load_lds((const unsigned*)(gu_ + (voff)[_i]), (LAS unsigned*)(lds + (bufoff) + ldsw + _i * 8192), 16, 0, 0); } while (0)
#define PG8_LDA(dst, b, h) do { _Pragma("unroll") for (int m = 0; m < 4; ++m) _Pragma("unroll") for (int k = 0; k < 2; ++k) dst[m][k] = *(const LAS bf16x8*)(lds + PG8_SA(b, h) + aoff + m * 2048 + k * 1024); } while (0)
#define PG8_LDB(dst, b, h) do { _Pragma("unroll") for (int n = 0; n < 2; ++n) _Pragma("unroll") for (int k = 0; k < 2; ++k) dst[n][k] = *(const LAS bf16x8*)(lds + PG8_SB(b, h) + boff + n * 2048 + k * 1024); } while (0)
#define PG8_MMA(ai, bj, At, Bt) do { __builtin_amdgcn_s_setprio(1); _Pragma("unroll") for (int m = 0; m < 4; ++m) _Pragma("unroll") for (int n = 0; n < 2; ++n) _Pragma("unroll") for (int k = 0; k < 2; ++k) \
        acc[ai][bj][m][n] = __builtin_amdgcn_mfma_f32_16x16x32_bf16(Bt[n][k], At[m][k], acc[ai][bj][m][n], 0, 0, 0); __builtin_amdgcn_s_setprio(0); } while (0)
#define PG8_WAIT_V(n) asm volatile("s_waitcnt vmcnt(" #n ")" ::: "memory")
#define PG8_WAIT_L(n) asm volatile("s_waitcnt lgkmcnt(" #n ")" ::: "memory")
#define PG8_BAR __builtin_amdgcn_s_barrier()
#define PG8_SCHED __builtin_amdgcn_sched_barrier(0)
    GUnit cur, nxt; int ui = 0;
    if (!S.next(0, cur)) return;
    f32x4 acc[2][2][4][2];
#pragma unroll
    for (int a = 0; a < 2; ++a)
#pragma unroll
        for (int b = 0; b < 2; ++b)
#pragma unroll
            for (int m = 0; m < 4; ++m)
#pragma unroll
                for (int n = 0; n < 2; ++n) acc[a][b][m][n] = (f32x4){0.f, 0.f, 0.f, 0.f};
    bf16x8 At[4][2], B0[2][2], B1[2][2];
    const char* cA = g.A + cur.aoff; const char* cB = g.B + cur.boff;
    PG8_STAGE(PG8_SB(0, 0), cB, voffB); PG8_STAGE(PG8_SA(0, 0), cA, voffA); PG8_STAGE(PG8_SB(0, 1), cB + hstepB, voffB); PG8_STAGE(PG8_SA(0, 1), cA + hstepA, voffA);
    if (wr == 1) PG8_BAR;
    PG8_WAIT_V(4); PG8_BAR;
    PG8_STAGE(PG8_SB(1, 0), cB + 128, voffB); PG8_STAGE(PG8_SA(1, 0), cA + 128, voffA); PG8_STAGE(PG8_SB(1, 1), cB + hstepB + 128, voffB);
    PG8_WAIT_V(6); PG8_BAR;
    for (;;) {
        const bool has_next = S.next(ui + 1, nxt);
        const char* nA = has_next ? g.A + nxt.aoff : cA; const char* nB = has_next ? g.B + nxt.boff : cB;
        for (int t = 0; t < nt; t += 2) {
            const bool last = (t == nt - 2);
            if constexpr (Epi::NHOOK > 0) { if (t == Epi::H1 || t == Epi::H2) E.hook(acc, cur, t, wr, wc, fr, fq); }
            const char* a1 = cA + (size_t)(t >> 1) * ks2A + 128;
            const char* a2 = last ? nA : cA + (size_t)((t >> 1) + 1) * ks2A; const char* b2 = last ? nB : cB + (size_t)(t + 2) * 128;
            const char* a3 = a2 + 128; const char* b3 = b2 + 128;
            PG8_LDB(B0, 0, 0); PG8_SCHED; PG8_LDA(At, 0, 0); PG8_STAGE(PG8_SA(1, 1), a1 + hstepA, voffA);
            PG8_WAIT_L(8); PG8_BAR; PG8_WAIT_L(0); PG8_MMA(0, 0, At, B0); PG8_BAR; PG8_SCHED;
            PG8_LDB(B1, 0, 1); PG8_STAGE(PG8_SB(0, 0), b2, voffB);
            PG8_BAR; PG8_WAIT_L(0); PG8_MMA(0, 1, At, B1); PG8_BAR;
            PG8_LDA(At, 0, 1); PG8_STAGE(PG8_SA(0, 0), a2, voffA);
            PG8_BAR; PG8_WAIT_L(0); PG8_MMA(1, 0, At, B0); PG8_BAR; PG8_SCHED;
            PG8_STAGE(PG8_SB(0, 1), b2 + hstepB, voffB);
            PG8_WAIT_V(6); PG8_BAR; PG8_MMA(1, 1, At, B1); PG8_BAR;
            PG8_LDB(B0, 1, 0); PG8_SCHED; PG8_LDA(At, 1, 0); PG8_STAGE(PG8_SA(0, 1), a2 + hstepA, voffA);
            PG8_WAIT_L(8); PG8_BAR; PG8_WAIT_L(0); PG8_MMA(0, 0, At, B0); PG8_BAR; PG8_SCHED;
            PG8_LDB(B1, 1, 1); PG8_STAGE(PG8_SB(1, 0), b3, voffB);
            PG8_BAR; PG8_WAIT_L(0); PG8_MMA(0, 1, At, B1); PG8_BAR;
            PG8_LDA(At, 1, 1); PG8_STAGE(PG8_SA(1, 0), a3, voffA);
            PG8_BAR; PG8_WAIT_L(0); PG8_MMA(1, 0, At, B0); PG8_BAR; PG8_SCHED;
            PG8_STAGE(PG8_SB(1, 1), b3 + hstepB, voffB);
            PG8_WAIT_V(6); PG8_BAR; PG8_MMA(1, 1, At, B1); PG8_BAR;
        }
        E(acc, cur, wr, wc, fr, fq);
        if (!has_next) break;
#pragma unroll
        for (int a = 0; a < 2; ++a)
#pragma unroll
            for (int b = 0; b < 2; ++b)
#pragma unroll
                for (int m = 0; m < 4; ++m)
#pragma unroll
                    for (int n = 0; n < 2; ++n) acc[a][b][m][n] = (f32x4){0.f, 0.f, 0.f, 0.f};
        cur = nxt; cA = nA; cB = nB; ++ui;
    }
    PG8_WAIT_V(0);
    if (wr == 0) PG8_BAR;
    PG8_BAR;
#undef PG8_SA
#undef PG8_SB
#undef PG8_STAGE
#undef PG8_LDA
#undef PG8_LDB
#undef PG8_MMA
#undef PG8_WAIT_V
#undef PG8_WAIT_L
#undef PG8_BAR
#undef PG8_SCHED
}

typedef int i32x4_ __attribute__((ext_vector_type(4)));
typedef int i32x8_ __attribute__((ext_vector_type(8)));
template <class Epi, class Sched, class RowA>
__device__ __forceinline__ void gemm_phase_fp8(LAS unsigned char* lds, const GemmP g, const Sched& S, const Epi& E, const RowA& rowA) {
    const int tid = tid_l(), wid = __builtin_amdgcn_readfirstlane(tid >> 6), lane = tid & 63, wr = wid >> 2, wc = wid & 3, fr = lane & 15, fq = lane >> 4;
    const int nt = g.nt;
    unsigned voffA[2], voffB[2];
#pragma unroll
    for (int i = 0; i < 2; ++i) { int R, C; stage_rc(tid * 16 + i * 8192, R, C); const int Rb = Epi::PERM ? ((R & ~31) + perm32(R & 31)) : R;
        voffA[i] = rowA(R) + (unsigned)C * 2u; voffB[i] = (unsigned)Rb * g.rsB + (unsigned)C * 2u; }
    const size_t hstepA = (size_t)rowA(HALF), hstepB = (size_t)HALF * g.rsB;
    const size_t ks2A = g.ks2A;
    const unsigned ldsw = (unsigned)wid * 1024u;
    const int aoff0 = lds_byte(wr * 64 + fr, fq * 16), aoff1 = lds_byte(wr * 64 + fr, fq * 16 + 8), boff0 = lds_byte(wc * 32 + fr, fq * 16), boff1 = lds_byte(wc * 32 + fr, fq * 16 + 8);
#define PG8_SA(b, h) (((b) * 2 + (h)) * HTB)
#define PG8_SB(b, h) ((4 + (b) * 2 + (h)) * HTB)
#define PG8_STAGE(bufoff, gbase, voff) do { const unsigned long long gb_ = (unsigned long long)(gbase); const char* gu_ = (const char*)(((unsigned long long)(unsigned)__builtin_amdgcn_readfirstlane((int)(gb_ >> 32)) << 32) | (unsigned)__builtin_amdgcn_readfirstlane((int)gb_));   \
        _Pragma("unroll") for (int _i = 0; _i < 2; ++_i) \
        __builtin_amdgcn_global_load_lds((const unsigned*)(gu_ + (voff)[_i]), (LAS unsigned*)(lds + (bufoff) + ldsw + _i * 8192), 16, 0, 0); } while (0)
#define PG8_LDA(dst, b, h) do { _Pragma("unroll") for (int m = 0; m < 4; ++m) dst[m] = __builtin_shufflevector(*(const LAS i32x4_*)(lds + PG8_SA(b, h) + aoff0 + m * 2048), *(const LAS i32x4_*)(lds + PG8_SA(b, h) + aoff1 + m * 2048), 0, 1, 2, 3, 4, 5, 6, 7); } while (0)
#define PG8_LDB(dst, b, h) do { _Pragma("unroll") for (int n = 0; n < 2; ++n) dst[n] = __builtin_shufflevector(*(const LAS i32x4_*)(lds + PG8_SB(b, h) + boff0 + n * 2048), *(const LAS i32x4_*)(lds + PG8_SB(b, h) + boff1 + n * 2048), 0, 1, 2, 3, 4, 5, 6, 7); } while (0)
#define PG8_F8(x) __builtin_shufflevector(__builtin_bit_cast(i32x4_, (x)[0]), __builtin_bit_cast(i32x4_, (x)[1]), 0, 1, 2, 3, 4, 5, 6, 7)
#define PG8_MMA(ai, bj, At, Bt) do { __builtin_amdgcn_s_setprio(1); _Pragma("unroll") for (int m = 0; m < 4; ++m) _Pragma("unroll") for (int n = 0; n < 2; ++n) \
        asm volatile("v_mfma_f32_16x16x128_f8f6f4 %0, %1, %2, %0" : "+v"(acc[ai][bj][m][n]) : "v"(Bt[n]), "v"(At[m]));   \
        __builtin_amdgcn_s_setprio(0); } while (0)
#define PG8_WAIT_V(n) asm volatile("s_waitcnt vmcnt(" #n ")" ::: "memory")
#define PG8_WAIT_L(n) asm volatile("s_waitcnt lgkmcnt(" #n ")" ::: "memory")
#define PG8_BAR __builtin_amdgcn_s_barrier()
#define PG8_SCHED __builtin_amdgcn_sched_barrier(0)
    GUnit cur, nxt; int ui = 0;
    if (!S.next(0, cur)) return;
    f32x4 acc[2][2][4][2];
#pragma unroll
    for (int a = 0; a < 2; ++a)
#pragma unroll
        for (int b = 0; b < 2; ++b)
#pragma unroll
            for (int m = 0; m < 4; ++m)
#pragma unroll
                for (int n = 0; n < 2; ++n) acc[a][b][m][n] = (f32x4){0.f, 0.f, 0.f, 0.f};
    i32x8_ At[4], B0[2], B1[2];
    const char* cA = g.A + cur.aoff; const char* cB = g.B + cur.boff;
    PG8_STAGE(PG8_SB(0, 0), cB, voffB); PG8_STAGE(PG8_SA(0, 0), cA, voffA); PG8_STAGE(PG8_SB(0, 1), cB + hstepB, voffB); PG8_STAGE(PG8_SA(0, 1), cA + hstepA, voffA);
    if (wr == 1) PG8_BAR;
    PG8_WAIT_V(4); PG8_BAR;
    PG8_STAGE(PG8_SB(1, 0), cB + 128, voffB); PG8_STAGE(PG8_SA(1, 0), cA + 128, voffA); PG8_STAGE(PG8_SB(1, 1), cB + hstepB + 128, voffB);
    PG8_WAIT_V(6); PG8_BAR;
    for (;;) {
        const bool has_next = S.next(ui + 1, nxt);
        const char* nA = has_next ? g.A + nxt.aoff : cA; const char* nB = has_next ? g.B + nxt.boff : cB;
        const int nt_ = cur.nt ? cur.nt : nt;
        for (int t = 0; t < nt_; t += 2) {
            const bool last = (t == nt_ - 2);
            if constexpr (Epi::NHOOK > 0) { if (t == Epi::H1 || t == Epi::H2) E.hook(acc, cur, t, wr, wc, fr, fq); }
            const char* a1 = cA + (size_t)(t >> 1) * ks2A + 128;
            const char* a2 = last ? nA : cA + (size_t)((t >> 1) + 1) * ks2A; const char* b2 = last ? nB : cB + (size_t)(t + 2) * 128;
            const char* a3 = a2 + 128; const char* b3 = b2 + 128;
            PG8_LDB(B0, 0, 0); PG8_SCHED; PG8_LDA(At, 0, 0); PG8_STAGE(PG8_SA(1, 1), a1 + hstepA, voffA);
            PG8_WAIT_L(8); PG8_BAR; PG8_WAIT_L(0); PG8_MMA(0, 0, At, B0); PG8_BAR; PG8_SCHED;
            PG8_LDB(B1, 0, 1); PG8_STAGE(PG8_SB(0, 0), b2, voffB);
            PG8_BAR; PG8_WAIT_L(0); PG8_MMA(0, 1, At, B1); PG8_BAR;
            PG8_LDA(At, 0, 1); PG8_STAGE(PG8_SA(0, 0), a2, voffA);
            PG8_BAR; PG8_WAIT_L(0); PG8_MMA(1, 0, At, B0); PG8_BAR; PG8_SCHED;
            PG8_STAGE(PG8_SB(0, 1), b2 + hstepB, voffB);
            PG8_WAIT_V(6); PG8_BAR; PG8_MMA(1, 1, At, B1); PG8_BAR;
            PG8_LDB(B0, 1, 0); PG8_SCHED; PG8_LDA(At, 1, 0); PG8_STAGE(PG8_SA(0, 1), a2 + hstepA, voffA);
            PG8_WAIT_L(8); PG8_BAR; PG8_WAIT_L(0); PG8_MMA(0, 0, At, B0); PG8_BAR; PG8_SCHED;
            PG8_LDB(B1, 1, 1); PG8_STAGE(PG8_SB(1, 0), b3, voffB);
            PG8_BAR; PG8_WAIT_L(0); PG8_MMA(0, 1, At, B1); PG8_BAR;
            PG8_LDA(At, 1, 1); PG8_STAGE(PG8_SA(1, 0), a3, voffA);
            PG8_BAR; PG8_WAIT_L(0); PG8_MMA(1, 0, At, B0); PG8_BAR; PG8_SCHED;
            PG8_STAGE(PG8_SB(1, 1), b3 + hstepB, voffB);
            PG8_WAIT_V(6); PG8_BAR; PG8_MMA(1, 1, At, B1); PG8_BAR;
        }
        asm volatile("s_nop 15\n\ts_nop 15" ::: "memory");
        E(acc, cur, wr, wc, fr, fq);
        if (!has_next) break;
#pragma unroll
        for (int a = 0; a < 2; ++a)
#pragma unroll
            for (int b = 0; b < 2; ++b)
#pragma unroll
                for (int m = 0; m < 4; ++m)
#pragma unroll
                    for (int n = 0; n < 2; ++n) acc[a][b][m][n] = (f32x4){0.f, 0.f, 0.f, 0.f};
        cur = nxt; cA = nA; cB = nB; ++ui;
    }
    PG8_WAIT_V(0);
    if (wr == 0) PG8_BAR;
    PG8_BAR;
#undef PG8_SA
#undef PG8_SB
#undef PG8_STAGE
#undef PG8_LDA
#undef PG8_LDB
#undef PG8_MMA
#undef PG8_F8
#undef PG8_WAIT_V
#undef PG8_WAIT_L
#undef PG8_BAR
#undef PG8_SCHED
}

#ifndef MK_NTST
#define MK_NTST 1
#endif
#define MK_EPI_STORE_B(bit, ptr, v) do { if constexpr ((MK_NTST) & (bit)) __builtin_nontemporal_store(v, ptr); else *(ptr) = (v); } while (0)
#define MK_EPI_STORE(ptr, v) MK_EPI_STORE_B(1, ptr, v)
template <bool ROWINV>
struct EpiBf16T {
    static constexpr bool PERM = true; static constexpr int NHOOK = 0, H1 = -1, H2 = -1;
    bf16_t* O; int ldc; float sc; bool off = false;
    __device__ __forceinline__ void operator()(const f32x4 (&acc)[2][2][4][2], const GUnit& u, int wr, int wc, int fr, int fq) const {
        if (off && acc[0][0][0][0][0] != 12345.678f) return;
        const int row0 = u.row0 + wr * 64 + fr, col0 = u.col0 + wc * 32 + 8 * fq;
        const unsigned* ss1 = (const unsigned*)((const unsigned char*)O + (WS_SS1 - WS_PROJ));
#pragma unroll
        for (int ai = 0; ai < 2; ++ai)
#pragma unroll
            for (int m = 0; m < 4; ++m) { bf16_t* rowp = O + (size_t)(row0 + ai * HALF + m * 16) * ldc + col0;
                float sc_ = sc; if constexpr (ROWINV) sc_ = sc * rsqrtf((float)ss1[row0 + ai * HALF + m * 16] * (1.0f / 4096.0f / 2048.0f) + RMS_EPS);
#pragma unroll
                for (int bj = 0; bj < 2; ++bj) { const f32x4 v0 = acc[ai][bj][m][0] * sc_, v1 = acc[ai][bj][m][1] * sc_;
                    u32x4 w; w.x = cvt_pk_bf16(v0[0], v0[1]); w.y = cvt_pk_bf16(v0[2], v0[3]); w.z = cvt_pk_bf16(v1[0], v1[1]); w.w = cvt_pk_bf16(v1[2], v1[3]);
                    MK_EPI_STORE((u32x4*)(rowp + bj * HALF), w); } }
    }
};
typedef EpiBf16T<false> EpiBf16;
__device__ __forceinline__ f32x2 silu_mul2(f32x2 ag, f32x2 au, float kneg, float c) {
    const f32x2 kv = {kneg, kneg}, cv = {c, c}, one = {1.f, 1.f};
    f32x2 t = ag * kv; t[0] = __builtin_amdgcn_exp2f(t[0]); t[1] = __builtin_amdgcn_exp2f(t[1]);
    f32x2 d = t + one; d[0] = rcp_(d[0]); d[1] = rcp_(d[1]);
    return ((ag * au) * cv) * d;
}
struct EpiSilu {
    static constexpr bool PERM = true; static constexpr int NHOOK = 0, H1 = -1, H2 = -1;
    bf16_t* O; int ldc; float sc;
    __device__ __forceinline__ void operator()(const f32x4 (&acc)[2][2][4][2], const GUnit& u, int wr, int wc, int fr, int fq) const {
        const int row0 = u.row0 + wr * 64 + fr, col0 = (u.col0 >> 1) + wc * 32 + 8 * fq;
#pragma unroll
        for (int ai = 0; ai < 2; ++ai)
#pragma unroll
            for (int m = 0; m < 4; ++m) { bf16_t* rowp = O + (size_t)(row0 + ai * HALF + m * 16) * ldc + col0;
                float r[8];
#pragma unroll
                for (int n = 0; n < 2; ++n)
#pragma unroll
                    for (int i = 0; i < 4; i += 2) { const f32x2 v = silu_mul2((f32x2){acc[ai][0][m][n][i], acc[ai][0][m][n][i + 1]}, (f32x2){acc[ai][1][m][n][i], acc[ai][1][m][n][i + 1]}, -sc * LOG2E, sc * sc); r[n * 4 + i] = v[0]; r[n * 4 + i + 1] = v[1]; }
                u32x4 w; w.x = cvt_pk_bf16(r[0], r[1]); w.y = cvt_pk_bf16(r[2], r[3]); w.z = cvt_pk_bf16(r[4], r[5]); w.w = cvt_pk_bf16(r[6], r[7]);
                MK_EPI_STORE_B(2, (u32x4*)rowp, w); }
    }
};
struct EpiSiluF8 {
    static constexpr bool PERM = true; static constexpr int NHOOK = 0, H1 = -1, H2 = -1;
    unsigned char* O; int ldc; float sc, osc; const unsigned* ss = nullptr;
    __device__ __forceinline__ void operator()(const f32x4 (&acc)[2][2][4][2], const GUnit& u, int wr, int wc, int fr, int fq) const {
        const int row0 = u.row0 + wr * 64 + fr, col0 = (u.col0 >> 1) + wc * 32 + 8 * fq;
#pragma unroll
        for (int ai = 0; ai < 2; ++ai)
#pragma unroll
            for (int m = 0; m < 4; ++m) { unsigned char* rowp = O + (size_t)(row0 + ai * HALF + m * 16) * ldc + col0;
                float inv = 1.f; if (ss) inv = rsqrtf((float)ss[row0 + ai * HALF + m * 16] * (1.0f / 4096.0f / 2048.0f) + RMS_EPS);
                const float kn_ = -sc * LOG2E * inv, cc_ = osc * sc * sc * inv * inv;
                float r[8];
#pragma unroll
                for (int n = 0; n < 2; ++n)
#pragma unroll
                    for (int i = 0; i < 4; i += 2) { const f32x2 v = silu_mul2((f32x2){acc[ai][0][m][n][i], acc[ai][0][m][n][i + 1]}, (f32x2){acc[ai][1][m][n][i], acc[ai][1][m][n][i + 1]}, kn_, cc_);
                        r[n * 4 + i] = __builtin_amdgcn_fmed3f(v[0], -448.f, 448.f); r[n * 4 + i + 1] = __builtin_amdgcn_fmed3f(v[1], -448.f, 448.f); }
                int q0 = 0, q1 = 0;
                q0 = __builtin_amdgcn_cvt_pk_fp8_f32(r[0], r[1], q0, false); q0 = __builtin_amdgcn_cvt_pk_fp8_f32(r[2], r[3], q0, true);
                q1 = __builtin_amdgcn_cvt_pk_fp8_f32(r[4], r[5], q1, false); q1 = __builtin_amdgcn_cvt_pk_fp8_f32(r[6], r[7], q1, true);
                { const u32x2 qq = {(unsigned)q0, (unsigned)q1}; MK_EPI_STORE_B(2, (u32x2*)rowp, qq); } }
    }
};
template <bool ROWINV>
struct EpiF8T {
    static constexpr bool PERM = true; static constexpr int NHOOK = 0, H1 = -1, H2 = -1;
    unsigned char* O; int ldc; float sc;
    __device__ __forceinline__ void operator()(const f32x4 (&acc)[2][2][4][2], const GUnit& u, int wr, int wc, int fr, int fq) const {
        const int row0 = u.row0 + wr * 64 + fr, col0 = u.col0 + wc * 32 + 8 * fq;
#pragma unroll
        for (int ai = 0; ai < 2; ++ai)
#pragma unroll
            for (int m = 0; m < 4; ++m) { unsigned char* rowp = O + (size_t)(row0 + ai * HALF + m * 16) * ldc + col0;
                float sc_ = sc; if constexpr (ROWINV) { const unsigned* ss1 = (const unsigned*)(O + (WS_SS1 - WS_PROJ - (size_t)PC_MERGE * 2)); sc_ = sc * rsqrtf((float)ss1[row0 + ai * HALF + m * 16] * (1.0f / 4096.0f / 2048.0f) + RMS_EPS); }
#pragma unroll
                for (int bj = 0; bj < 2; ++bj) { float r[8];
#pragma unroll
                    for (int n = 0; n < 2; ++n)
#pragma unroll
                        for (int i = 0; i < 4; ++i) r[n * 4 + i] = fminf(fmaxf(acc[ai][bj][m][n][i] * sc_, -448.f), 448.f);
                    int q0 = 0, q1 = 0;
                    q0 = __builtin_amdgcn_cvt_pk_fp8_f32(r[0], r[1], q0, false); q0 = __builtin_amdgcn_cvt_pk_fp8_f32(r[2], r[3], q0, true);
                    q1 = __builtin_amdgcn_cvt_pk_fp8_f32(r[4], r[5], q1, false); q1 = __builtin_amdgcn_cvt_pk_fp8_f32(r[6], r[7], q1, true);
                    const u32x2 qq = {(unsigned)q0, (unsigned)q1}; MK_EPI_STORE_B(1, (u32x2*)(rowp + bj * HALF), qq); } }
    }
};
typedef EpiF8T<false> EpiF8;
struct EpiRes {
    static constexpr bool PERM = false; static constexpr int NHOOK = 0, H1 = -1, H2 = -1;
    const float* base; float* out; float sc;
    __device__ __forceinline__ void operator()(const f32x4 (&acc)[2][2][4][2], const GUnit& u, int wr, int wc, int fr, int fq) const {
        const int row0 = u.row0 + wr * 64 + fr, col0 = u.col0 + wc * 32 + 4 * fq;
#pragma unroll
        for (int ai = 0; ai < 2; ++ai) {
            f32x4 bs[4][2][2];
#pragma unroll
            for (int m = 0; m < 4; ++m) { const size_t off = (size_t)(row0 + ai * HALF + m * 16) * 2048 + col0;
#pragma unroll
                for (int bj = 0; bj < 2; ++bj)
#pragma unroll
                    for (int n = 0; n < 2; ++n) bs[m][bj][n] = *(const f32x4*)(base + off + bj * HALF + n * 16); }
#pragma unroll
            for (int m = 0; m < 4; ++m) { const size_t off = (size_t)(row0 + ai * HALF + m * 16) * 2048 + col0;
#pragma unroll
                for (int bj = 0; bj < 2; ++bj)
#pragma unroll
                    for (int n = 0; n < 2; ++n) { const f32x4 rv = bs[m][bj][n] + acc[ai][bj][m][n] * sc; MK_EPI_STORE_B(4, (f32x4*)(out + off + bj * HALF + n * 16), rv); } }
            asm volatile("" ::: "memory");
        }
    }
};
template <bool F32IN, bool SUMSQ = false, bool X8OUT = false, int SSIDX = 0>
struct EpiResB {
    static constexpr bool PERM = true; static constexpr int NHOOK = 0, H1 = -1, H2 = -1;
    const void* base; bf16_t* out; float sc;
    __device__ __forceinline__ void operator()(const f32x4 (&acc)[2][2][4][2], const GUnit& u, int wr, int wc, int fr, int fq) const {
        const int row0 = u.row0 + wr * 64 + fr, col0 = u.col0 + wc * 32 + 8 * fq;
        unsigned* ss = (unsigned*)((unsigned char*)out + (WS_SS - WS_XB)) + (size_t)SSIDX * T;
        unsigned char* x8 = (unsigned char*)out - (WS_XB - WS_H8);
        constexpr int MG = SUMSQ ? 2 : 4;
#pragma unroll
        for (int ai = 0; ai < 2; ++ai)
#pragma unroll
        for (int mb = 0; mb < 4; mb += MG) {
            f32x4 bs[MG][2][2];
#pragma unroll
            for (int mm = 0; mm < MG; ++mm) { const int m = mb + mm; const size_t off = (size_t)(row0 + ai * HALF + m * 16) * 2048 + col0;
#pragma unroll
                for (int bj = 0; bj < 2; ++bj) {
                    if constexpr (F32IN) { const float* bp = (const float*)base + off + bj * HALF; bs[mm][bj][0] = *(const f32x4*)bp; bs[mm][bj][1] = *(const f32x4*)(bp + 4); }
                    else { const u32x4 w = *(const u32x4*)((const bf16_t*)base + off + bj * HALF);
                        bs[mm][bj][0] = (f32x4){bflo(w.x), bfhi(w.x), bflo(w.y), bfhi(w.y)}; bs[mm][bj][1] = (f32x4){bflo(w.z), bfhi(w.z), bflo(w.w), bfhi(w.w)}; } } }
#pragma unroll
            for (int mm = 0; mm < MG; ++mm) { const int m = mb + mm; const size_t off = (size_t)(row0 + ai * HALF + m * 16) * 2048 + col0; float rsq = 0.f;
#pragma unroll
                for (int bj = 0; bj < 2; ++bj) { const f32x4 v0 = bs[mm][bj][0] + acc[ai][bj][m][0] * sc, v1 = bs[mm][bj][1] + acc[ai][bj][m][1] * sc;
                    u32x4 w; w.x = cvt_pk_bf16(v0[0], v0[1]); w.y = cvt_pk_bf16(v0[2], v0[3]); w.z = cvt_pk_bf16(v1[0], v1[1]); w.w = cvt_pk_bf16(v1[2], v1[3]);
                    *(u32x4*)(out + off + bj * HALF) = w;
                    if constexpr (X8OUT) { int q0 = 0, q1 = 0;
                        q0 = __builtin_amdgcn_cvt_pk_fp8_f32(4.f * v0[0], 4.f * v0[1], q0, false); q0 = __builtin_amdgcn_cvt_pk_fp8_f32(4.f * v0[2], 4.f * v0[3], q0, true);
                        q1 = __builtin_amdgcn_cvt_pk_fp8_f32(4.f * v1[0], 4.f * v1[1], q1, false); q1 = __builtin_amdgcn_cvt_pk_fp8_f32(4.f * v1[2], 4.f * v1[3], q1, true);
                        *(u32x2*)(x8 + off + bj * HALF) = (u32x2){(unsigned)q0, (unsigned)q1}; }
                    if constexpr (SUMSQ) rsq += v0[0] * v0[0] + v0[1] * v0[1] + v0[2] * v0[2] + v0[3] * v0[3] + v1[0] * v1[0] + v1[1] * v1[1] + v1[2] * v1[2] + v1[3] * v1[3]; }
                if constexpr (SUMSQ) { rsq += __shfl_xor(rsq, 16); rsq += __shfl_xor(rsq, 32);
                    if (fq == 0) (void)__hip_atomic_fetch_add(ss + row0 + ai * HALF + m * 16, (unsigned)(rsq * 4096.f + 0.5f), __ATOMIC_RELAXED, __HIP_MEMORY_SCOPE_AGENT); } }
            asm volatile("" ::: "memory");
        }
    }
};
struct EpiSlab {
    static constexpr bool PERM = false; static constexpr int NHOOK = 0, H1 = -1, H2 = -1;
    bf16_t* slab;
    __device__ __forceinline__ void operator()(const f32x4 (&acc)[2][2][4][2], const GUnit& u, int wr, int wc, int fr, int fq) const {
        const int row0 = u.row0 + wr * 64 + fr, col0 = wc * 32 + 4 * fq;
        bf16_t* sb = slab + (size_t)u.aux * 2048 * 256;
#pragma unroll
        for (int ai = 0; ai < 2; ++ai)
#pragma unroll
            for (int m = 0; m < 4; ++m) { bf16_t* rowp = sb + (size_t)(row0 + ai * HALF + m * 16) * 256 + col0;
#pragma unroll
                for (int bj = 0; bj < 2; ++bj)
#pragma unroll
                    for (int n = 0; n < 2; ++n) { const f32x4 v = acc[ai][bj][m][n]; *(u32x2*)(rowp + bj * HALF + n * 16) = (u32x2){cvt_pk_bf16(v[0], v[1]), cvt_pk_bf16(v[2], v[3])}; } }
    }
};
struct EpiBranch {
    static constexpr bool PERM = true; static constexpr int NHOOK = 2, H1 = 16, H2 = 24;
    const bf16_t* proj; bf16_t* O;
    __device__ __forceinline__ void scale(f32x4 (&acc)[2][2][4][2], const GUnit& u, int mode, int wr, int wc, int fr, int fq) const {
        const unsigned voff = (unsigned)(fr * LDP * 2 + 8 * fq);
        constexpr float K_ = -LOG2E / 16.0f;
#pragma unroll
        for (int ai = 0; ai < 2; ++ai)
#pragma unroll
            for (int mp = 0; mp < 2; ++mp) {
                u32x2 za[2][2], zb[2][2];
#pragma unroll
                for (int mm = 0; mm < 2; ++mm) { const int m = mp * 2 + mm; const char* gp = (const char*)proj + ((size_t)(u.row0 + wr * 64 + ai * HALF + m * 16) * LDP + PC_MERGE) * 2 + u.col0 + wc * 32;
#pragma unroll
                    for (int bj = 0; bj < 2; ++bj) {
                        if (mode == 2) { za[mm][bj] = *(const u32x2*)(gp + (2 * 2048 + bj * HALF) + voff); zb[mm][bj] = za[mm][bj]; }
                        else { za[mm][bj] = *(const u32x2*)(gp + (mode * 2048 + bj * HALF) + voff); zb[mm][bj] = *(const u32x2*)(gp + ((mode + 1) * 2048 + bj * HALF) + voff); } } }
#pragma unroll
                for (int mm = 0; mm < 2; ++mm) { const int m = mp * 2 + mm;
#pragma unroll
                    for (int bj = 0; bj < 2; ++bj)
#pragma unroll
                        for (int n = 0; n < 2; ++n) { const int a_ = (int)(n ? za[mm][bj].y : za[mm][bj].x), b_ = (int)(n ? zb[mm][bj].y : zb[mm][bj].x); f32x4 f;
                            const f32x2 a0 = __builtin_amdgcn_cvt_pk_f32_fp8(a_, false), a1 = __builtin_amdgcn_cvt_pk_f32_fp8(a_, true);
                            if (mode == 2) { f[0] = rcp_(1.f + __builtin_amdgcn_exp2f(a0[0] * K_)); f[1] = rcp_(1.f + __builtin_amdgcn_exp2f(a0[1] * K_)); f[2] = rcp_(1.f + __builtin_amdgcn_exp2f(a1[0] * K_)); f[3] = rcp_(1.f + __builtin_amdgcn_exp2f(a1[1] * K_)); }
                            else { const f32x2 b0 = __builtin_amdgcn_cvt_pk_f32_fp8(b_, false), b1 = __builtin_amdgcn_cvt_pk_f32_fp8(b_, true);
                                   f[0] = (1.f + __builtin_amdgcn_exp2f(b0[0] * K_)) * rcp_(1.f + __builtin_amdgcn_exp2f(a0[0] * K_)); f[1] = (1.f + __builtin_amdgcn_exp2f(b0[1] * K_)) * rcp_(1.f + __builtin_amdgcn_exp2f(a0[1] * K_));
                                   f[2] = (1.f + __builtin_amdgcn_exp2f(b1[0] * K_)) * rcp_(1.f + __builtin_amdgcn_exp2f(a1[0] * K_)); f[3] = (1.f + __builtin_amdgcn_exp2f(b1[1] * K_)) * rcp_(1.f + __builtin_amdgcn_exp2f(a1[1] * K_)); }
                            acc[ai][bj][m][n] *= f; } }
                asm volatile("" ::: "memory");
            }
    }
    __device__ __forceinline__ void hook(f32x4 (&acc)[2][2][4][2], const GUnit& u, int t, int wr, int wc, int fr, int fq) const { scale(acc, u, t == 16 ? 0 : 1, wr, wc, fr, fq); }
    __device__ __forceinline__ void operator()(f32x4 (&acc)[2][2][4][2], const GUnit& u, int wr, int wc, int fr, int fq) const {
        scale(acc, u, 2, wr, wc, fr, fq);
        EpiBf16 e{O, 2048, 1.0f}; e(acc, u, wr, wc, fr, fq);
    }
};
struct EpiMoeDown {
    static constexpr bool PERM = true; static constexpr int NHOOK = 0, H1 = -1, H2 = -1;
    bf16_t* O; const float* roww; float sc; bf16_t* part; unsigned* tmap;
    __device__ __forceinline__ void operator()(const f32x4 (&acc)[2][2][4][2], const GUnit& u, int wr, int wc, int fr, int fq) const {
        const int row0 = u.row0 + wr * 64 + fr, col0 = u.col0 + wc * 32 + 8 * fq;
        float rws[2][4];
#pragma unroll
        for (int ai = 0; ai < 2; ++ai)
#pragma unroll
            for (int m = 0; m < 4; ++m) rws[ai][m] = roww[row0 + ai * HALF + m * 16];
        bf16_t* base = O + (size_t)row0 * 2048 + col0; size_t ld = 2048;
        if (u.sub) { const int ks = (u.sub - 1) & 3, tu = (u.sub - 1) >> 2;
            base = part + ((size_t)(ks * 64 + tu) * 256 + (wr * 64 + fr)) * 256 + wc * 32 + 8 * fq; ld = 256;
            if (ks == 0 && wr == 0 && wc == 0 && fr == 0 && fq == 0) tmap[(u.row0 >> 8) * 8 + (u.col0 >> 8)] = (unsigned)tu + 1u; }
#pragma unroll
        for (int ai = 0; ai < 2; ++ai)
#pragma unroll
            for (int m = 0; m < 4; ++m) { const float rw = rws[ai][m] * sc; bf16_t* rowp = base + (size_t)(ai * HALF + m * 16) * ld;
#pragma unroll
                for (int bj = 0; bj < 2; ++bj) { const f32x4 v0 = acc[ai][bj][m][0] * rw, v1 = acc[ai][bj][m][1] * rw;
                    u32x4 w; w.x = cvt_pk_bf16(v0[0], v0[1]); w.y = cvt_pk_bf16(v0[2], v0[3]); w.z = cvt_pk_bf16(v1[0], v1[1]); w.w = cvt_pk_bf16(v1[2], v1[3]);
                    MK_EPI_STORE_B(8, (u32x4*)(rowp + bj * HALF), w); } }
    }
};
}
#define KSWZ(row, colB) ((row) * 256 + ((colB) ^ (((row) & 7) << 4)))
__device__ __forceinline__ int v_st(int k, int c) { const int kk = (k & ~0xC) | ((k & 4) << 1) | ((k & 8) >> 1); return ((kk >> 3) * 4 + (c >> 5)) * 512 + ((kk & 7) * 32 + (c & 31)) * 2; }
__device__ __forceinline__ int v_rd_base(int lane) { return ((lane & 3) << 3) | (((lane >> 2) & 3) << 6) | (((lane >> 4) & 1) << 5) | (((lane >> 5) & 1) << 8); }
constexpr int v_rd_off(int d0, int ks, int half) { return d0 * 512 + ks * 4096 + half * 2048; }
__device__ __forceinline__ int crow(int r, int hi) { return (r & 3) + 8 * (r >> 2) + 4 * hi; }

__device__ __forceinline__ void qkt(f32x16& p0, f32x16& p1, LAS const unsigned char* Kb, int r32, int hi, const bf16x8* qr) {
    unsigned ka[4];
#pragma unroll
    for (int dd = 0; dd < 4; ++dd) ka[dd] = (unsigned)(uintptr_t)(Kb + KSWZ(r32, (dd * 16 + hi * 8) * 2));
    bf16x8 b00, b01, b10, b11, b20, b21, b30, b31, b40, b41, b50, b51, b60, b61, b70, b71;
#define KRD_(dst, a_, off) asm volatile("ds_read_b128 %0, %1 offset:%2" : "=&v"(dst) : "v"(a_), "i"(off) : "memory")
#define KISS(s) do { KRD_(b##s##0, ka[(s) & 3], ((s) >> 2) * 128); KRD_(b##s##1, ka[(s) & 3], ((s) >> 2) * 128 + 8192); } while (0)
#define KUSE(s, n) do { asm volatile("s_waitcnt lgkmcnt(" #n ")" : "+v"(b##s##0), "+v"(b##s##1) :: "memory"); \
        p0 = __builtin_amdgcn_mfma_f32_32x32x16_bf16(b##s##0, qr[s], p0, 0, 0, 0); p1 = __builtin_amdgcn_mfma_f32_32x32x16_bf16(b##s##1, qr[s], p1, 0, 0, 0); } while (0)
    KISS(0); KISS(1); KISS(2);
    asm volatile("" : "+v"(p0), "+v"(p1));
    KISS(3); KUSE(0, 6); KISS(4); KUSE(1, 6); KISS(5); KUSE(2, 6); KISS(6); KUSE(3, 6); KISS(7); KUSE(4, 6); KUSE(5, 4); KUSE(6, 2); KUSE(7, 0);
#undef KUSE
#undef KISS
#undef KRD_
}
__device__ __forceinline__ void pv_tile(f32x16* o, unsigned vb, bf16x8 pa0, bf16x8 pa1, bf16x8 pa2, bf16x8 pa3) {
#define TRRD(dst, off) asm volatile("ds_read_b64_tr_b16 %0, %1 offset:%2" : "=&v"(dst) : "v"(vb), "i"(off) : "memory")
#define PV_D0(d0) do { s16x4 l0, l1, l2, l3, h0, h1, h2, h3; constexpr int b_ = v_rd_off(d0, 0, 0); \
        TRRD(l0, b_); TRRD(h0, b_ + 2048); TRRD(l1, b_ + 4096); TRRD(h1, b_ + 6144); TRRD(l2, b_ + 8192); TRRD(h2, b_ + 10240); TRRD(l3, b_ + 12288); TRRD(h3, b_ + 14336); \
        asm volatile("s_waitcnt lgkmcnt(0)" ::: "memory"); __builtin_amdgcn_sched_barrier(0); \
        o[d0] = __builtin_amdgcn_mfma_f32_32x32x16_bf16(pa0, (bf16x8){l0[0], l0[1], l0[2], l0[3], h0[0], h0[1], h0[2], h0[3]}, o[d0], 0, 0, 0);   \
        o[d0] = __builtin_amdgcn_mfma_f32_32x32x16_bf16(pa1, (bf16x8){l1[0], l1[1], l1[2], l1[3], h1[0], h1[1], h1[2], h1[3]}, o[d0], 0, 0, 0);   \
        o[d0] = __builtin_amdgcn_mfma_f32_32x32x16_bf16(pa2, (bf16x8){l2[0], l2[1], l2[2], l2[3], h2[0], h2[1], h2[2], h2[3]}, o[d0], 0, 0, 0);   \
        o[d0] = __builtin_amdgcn_mfma_f32_32x32x16_bf16(pa3, (bf16x8){l3[0], l3[1], l3[2], l3[3], h3[0], h3[1], h3[2], h3[3]}, o[d0], 0, 0, 0); } while (0)
    PV_D0(0); PV_D0(1); PV_D0(2); PV_D0(3);
#undef PV_D0
#undef TRRD
}
__device__ __forceinline__ float swapmax(float v) { auto rr = __builtin_amdgcn_permlane32_swap(__float_as_uint(v), __float_as_uint(v), false, false); return fmaxf(__uint_as_float(rr[0]), __uint_as_float(rr[1])); }
__device__ __forceinline__ float swapadd(float v) { auto rr = __builtin_amdgcn_permlane32_swap(__float_as_uint(v), __float_as_uint(v), false, false); return __uint_as_float(rr[0]) + __uint_as_float(rr[1]); }
__device__ __forceinline__ void pack_p(const f32x16& p0, const f32x16& p1, bf16x8& pa0, bf16x8& pa1, bf16x8& pa2, bf16x8& pa3) {
#define PK4(P, B_, OUT) do { unsigned a0 = cvt_pk_bf16(P[B_+0], P[B_+1]), a1 = cvt_pk_bf16(P[B_+2], P[B_+3]);                          \
        unsigned b0 = cvt_pk_bf16(P[B_+4], P[B_+5]), b1 = cvt_pk_bf16(P[B_+6], P[B_+7]);                                             \
        auto r0 = __builtin_amdgcn_permlane32_swap(a0, b0, false, false); auto r1 = __builtin_amdgcn_permlane32_swap(a1, b1, false, false); \
        u32x4 w = {r0[0], r1[0], r0[1], r1[1]}; OUT = *reinterpret_cast<bf16x8*>(&w); } while (0)
    PK4(p0, 0, pa0); PK4(p0, 8, pa1); PK4(p1, 0, pa2); PK4(p1, 8, pa3);
#undef PK4
}

template <class F>
__device__ __forceinline__ void attn_unit(const F& f, LAS unsigned char* lds) {
    constexpr int NPOS = F::NPOS, NH = F::NH, TW = NPOS + 63, TABN = NH * TW;
    constexpr int TWS = NH == 1 ? TW : 136, TBUF = 576;
    static_assert(NH * TWS <= TBUF, "table buffer");
    static_assert(NPOS * NH == 256 && TABN <= 512, "unit geometry");
    const int tid = tid_l(), wid = rfl(tid >> 6), lane = tid & 63, r32 = lane & 31, hi = lane >> 5;
    LAS unsigned char* V_lds = lds; LAS unsigned char* K_lds = lds + 3 * SHM_V;
    LAS float* als = (LAS float*)(lds + ALS_OFF) + wid * 64;
    LAS float* tab = (LAS float*)(lds + TAB_OFF);
    LAS float* keyb = (LAS float*)(lds + KEYB_OFF);
    const int row = wid * 32 + r32;
    const int pl = NH == 1 ? row : (row >> 2), gh = NH == 1 ? 0 : (row & 3);
    bf16x8 qr[8];
    { const bf16_t* qp = f.qptr(row);
#pragma unroll
      for (int d0 = 0; d0 < 8; ++d0) qr[d0] = *(const bf16x8*)(qp + d0 * 16 + hi * 8); }
    float m_reg = -1e30f, l_reg = 0.f;
    f32x16 o[4];
#pragma unroll
    for (int d = 0; d < 4; ++d)
#pragma unroll
        for (int r = 0; r < 16; ++r) o[d][r] = 0.f;
    const int nt = f.nt;
    const int tlb = gh * TWS + NPOS - 1 - pl + 4 * hi;
    const unsigned vb0 = (unsigned)(uintptr_t)V_lds + (unsigned)v_rd_base(lane);
    int ko0, ko1, vo0, vo1;
    { const int rs_ = (int)f.rs();
#define A_OFFS(i, KO, VO) { const int ch = wid * 2 + i; const int krow = ch * 4 + (lane >> 4), kcolB = ((lane & 15) * 16) ^ ((krow & 7) << 4); \
        const int sub = ch * 2 + (lane >> 5), j = lane & 31; const int kk = (sub >> 2) * 8 + (j >> 2); const int vk = (kk & ~0xC) | ((kk & 4) << 1) | ((kk & 8) >> 1); \
        KO = krow * rs_ + (kcolB >> 1); VO = vk * rs_ + (sub & 3) * 32 + (j & 3) * 8; }
      A_OFFS(0, ko0, vo0) A_OFFS(1, ko1, vo1)
#undef A_OFFS
    }
#define A_DMA(t, bf) do { const int kb_ = f.kbase(t); const bf16_t* kp_ = f.kptr(kb_); const bf16_t* vp_ = f.vptr(kb_); \
        __builtin_amdgcn_global_load_lds((const unsigned*)(kp_ + ko0), (LAS unsigned*)(K_lds + (bf) * SHM_K + (wid * 2) * 1024), 16, 0, 0); \
        __builtin_amdgcn_global_load_lds((const unsigned*)(vp_ + vo0), (LAS unsigned*)(V_lds + (bf) * SHM_V + (wid * 2) * 1024), 16, 0, 0); \
        __builtin_amdgcn_global_load_lds((const unsigned*)(kp_ + ko1), (LAS unsigned*)(K_lds + (bf) * SHM_K + (wid * 2 + 1) * 1024), 16, 0, 0); \
        __builtin_amdgcn_global_load_lds((const unsigned*)(vp_ + vo1), (LAS unsigned*)(V_lds + (bf) * SHM_V + (wid * 2 + 1) * 1024), 16, 0, 0); } while (0)
#define A_TAB(t, bf) do { if (tid < TABN) { const int g_ = tid / TW, j_ = tid - g_ * TW; tab[(bf) * TBUF + g_ * TWS + j_] = f.tabval(rbl, g_, f.q0 - f.kbase(t) + NPOS - 1 - j_) * (1.0f / C2); } } while (0)
    LAS float* rbl = (LAS float*)(lds + RBL_OFF);
    float gpre[16]; f.gate_prefetch(gpre, wid, hi);
    if (nt > 0) { A_DMA(0, 0); }
    if (nt > 1) { A_DMA(1, 1); }
    f.load_bias(rbl, tid);
    if constexpr (F::NEEDS_BIAS) __syncthreads();
    if (nt > 0) { A_TAB(0, 0); }
    if constexpr (F::KEYBIAS) {
        LAS float* pref = (LAS float*)(lds + ALS_OFF);
        if (tid < 64) { const float tt = f.ctot[tid]; float inc = tt; for (int o = 1; o < 64; o <<= 1) { const float t_ = __shfl_up(inc, o); if (tid >= o) inc += t_; } pref[tid] = inc - tt; }
        __syncthreads();
        const f32x4* kbg = (const f32x4*)f.keyb;
        ((LAS f32x4*)keyb)[tid] = kbg[tid] + pref[tid >> 4]; ((LAS f32x4*)keyb)[tid + 512] = kbg[tid + 512] + pref[(tid + 512) >> 4]; }
#define A_SYNC(more) do { if (more) asm volatile("s_waitcnt vmcnt(4)" ::: "memory"); else asm volatile("s_waitcnt vmcnt(0)" ::: "memory"); \
        asm volatile("s_waitcnt lgkmcnt(0)" ::: "memory"); __builtin_amdgcn_s_barrier(); asm volatile("" ::: "memory"); } while (0)
    A_SYNC(nt > 1);
    auto tile = [&](const int t, const int kvb, const int bf) __attribute__((always_inline)) {
        if (f.wave_active(t, wid)) {
            f32x16 p0, p1;
            LAS const float* tp = tab + bf * TBUF + tlb;
            bool addtab = false;
            if constexpr (F::KEYBIAS) { const int kb_ = f.kbase(t);
#pragma unroll
                for (int a = 0; a < 4; ++a) { const f32x4 x0 = *(LAS const f32x4*)(keyb + kb_ + 8 * a + 4 * hi), x1 = *(LAS const f32x4*)(keyb + kb_ + 32 + 8 * a + 4 * hi);
#pragma unroll
                    for (int i = 0; i < 4; ++i) { p0[4 * a + i] = x0[i]; p1[4 * a + i] = x1[i]; } }
                addtab = !f.unmasked(t, wid); }
            else {
#pragma unroll
                for (int r = 0; r < 16; ++r) { const int c = (r & 3) + 8 * (r >> 2); p0[r] = tp[c]; p1[r] = tp[c + 32]; } }
            qkt(p0, p1, K_lds + kvb * SHM_K, r32, hi, qr);
            if constexpr (F::KEYBIAS) { if (addtab) {
#pragma unroll
                for (int r = 0; r < 16; ++r) { const int c = (r & 3) + 8 * (r >> 2); p0[r] += tp[c]; p1[r] += tp[c + 32]; } } }
            if (F::ROWMASK) { if (!f.row_on(t, row)) {
#pragma unroll
                for (int r = 0; r < 16; ++r) { p0[r] = -__builtin_inff(); p1[r] = -__builtin_inff(); } } }
            float pmax = fmaxf(p0[0], p1[0]);
#pragma unroll
            for (int r = 1; r < 16; ++r) pmax = fmaxf(fmaxf(pmax, p0[r]), p1[r]);
            pmax = swapmax(pmax);
            const float mn = __all(pmax - m_reg <= 24.f / C2) ? m_reg : fmaxf(m_reg, pmax);
            const float alpha = __builtin_amdgcn_exp2f((m_reg - mn) * C2); m_reg = mn;
            const f32x2 c2v = {C2, C2}, nmv = {-mn * C2, -mn * C2};
            f32x2 ps2 = {0.f, 0.f};
#pragma unroll
            for (int r = 0; r < 16; r += 2) {
                f32x2 u = (f32x2){p0[r], p0[r + 1]} * c2v + nmv, w = (f32x2){p1[r], p1[r + 1]} * c2v + nmv;
                u[0] = __builtin_amdgcn_exp2f(u[0]); u[1] = __builtin_amdgcn_exp2f(u[1]); w[0] = __builtin_amdgcn_exp2f(w[0]); w[1] = __builtin_amdgcn_exp2f(w[1]);
                p0[r] = u[0]; p0[r + 1] = u[1]; p1[r] = w[0]; p1[r + 1] = w[1]; ps2 += u; ps2 += w; }
            float ps = swapadd(ps2[0] + ps2[1]);
            l_reg = l_reg * alpha + ps;
            bf16x8 pa0, pa1, pa2, pa3; pack_p(p0, p1, pa0, pa1, pa2, pa3);
            if (__any(alpha < 1.f)) { if (hi == 0) als[r32] = alpha; asm volatile("s_waitcnt lgkmcnt(0)" ::: "memory");
#pragma unroll
                for (int r = 0; r < 16; ++r) { const float a_ = als[crow(r, hi)];
#pragma unroll
                    for (int d = 0; d < 4; ++d) o[d][r] *= a_; } }
            pv_tile(o, vb0 + (unsigned)(kvb * SHM_V), pa0, pa1, pa2, pa3);
        }
    };
    int kvb = 0;
#pragma unroll 1
    for (int t = 0; t < nt; ++t) {
        const int nb2 = kvb == 0 ? 2 : kvb - 1;
        if (t + 2 < nt) A_DMA(t + 2, nb2);
        tile(t, kvb, t & 1);
        if (t + 1 < nt) { A_TAB(t + 1, (t + 1) & 1); }
        A_SYNC(t + 2 < nt);
        kvb = kvb == 2 ? 0 : kvb + 1;
    }
#undef A_DMA
#undef A_SYNC
#undef A_TAB
    if (hi == 0) { als[r32] = l_reg; f.stats(row, m_reg * C2, l_reg); }
    asm volatile("s_waitcnt lgkmcnt(0)" ::: "memory");
    float rl[16];
#pragma unroll
    for (int r = 0; r < 16; ++r) { const float lv = als[crow(r, hi)]; rl[r] = lv > 0.f ? 1.f / lv : 0.f; }
    f.epilogue(o, rl, wid, r32, hi, gpre);
    __syncthreads();
}
constexpr int A3_KEYB = KEYB_OFF;

struct AV_Fox {
    static constexpr int NPOS = 256, NH = 1; static constexpr bool KEYBIAS = true, ROWMASK = false, SKIP = false;
    const bf16_t *Q, *K, *V; const float* keyb; const float* ctot; bf16_t* Y; int q0, nt;
    __device__ __forceinline__ const bf16_t* qptr(int row) const { return Q + (size_t)(q0 + row) * LDP; }
    __device__ __forceinline__ size_t rs() const { return LDP; }
    __device__ __forceinline__ int kbase(int t) const { return 64 * t; }
    __device__ __forceinline__ const bf16_t* kptr(int key) const { return K + (size_t)key * LDP; }
    __device__ __forceinline__ const bf16_t* vptr(int key) const { return V + (size_t)key * LDP; }
    __device__ __forceinline__ bool wave_active(int t, int wid) const { return 64 * t <= q0 + wid * 32 + 31; }
    __device__ __forceinline__ bool unmasked(int t, int wid) const { return 64 * t + 63 <= q0 + wid * 32; }
    static constexpr bool NEEDS_BIAS = false;
    __device__ __forceinline__ void load_bias(LAS float*, int) const {}
    __device__ __forceinline__ float tabval(LAS const float*, int, int dist) const { return dist >= 0 ? 0.f : -__builtin_inff(); }
    __device__ __forceinline__ bool row_on(int, int) const { return true; }
    __device__ __forceinline__ void stats(int, float, float) const {}
    __device__ __forceinline__ void gate_prefetch(float*, int, int) const {}
    __device__ __forceinline__ void epilogue(const f32x16* o, const float* rl, int wid, int r32, int hi, const float*) const {
#pragma unroll
        for (int r = 0; r < 16; ++r) { bf16_t* yp = Y + (size_t)(q0 + wid * 32 + crow(r, hi)) * LDY + r32;
#pragma unroll
            for (int d = 0; d < 4; ++d) yp[d * 32] = f2bf(o[d][r] * rl[r]); } }
};
struct AV_Dil {
    static constexpr int NPOS = 256, NH = 1; static constexpr bool KEYBIAS = false, ROWMASK = false, SKIP = false;
    const bf16_t *Q, *K, *V; const float* keyb; const float* relb; bf16_t* O; f32x2* ST; int q0, nt, t0, dil, hb;
    size_t rs_, os;
    __device__ __forceinline__ const bf16_t* qptr(int row) const { return Q + (size_t)(q0 + row) * rs_; }
    __device__ __forceinline__ size_t rs() const { return rs_; }
    __device__ __forceinline__ int kbase(int t) const { return 64 * (t0 + t); }
    __device__ __forceinline__ const bf16_t* kptr(int key) const { return K + (size_t)key * rs_; }
    __device__ __forceinline__ const bf16_t* vptr(int key) const { return V + (size_t)key * rs_; }
    __device__ __forceinline__ bool wave_active(int t, int wid) const { const int kb = 64 * (t0 + t), ulo = q0 + wid * 32; return kb <= ulo + 31 && kb + 63 >= ulo - 128; }
    static constexpr bool NEEDS_BIAS = true;
    __device__ __forceinline__ void load_bias(LAS float* rbl, int tid) const { if (tid < 32) rbl[tid] = relb[tid * 20 + hb] * LOG2E; }
    __device__ __forceinline__ float tabval(LAS const float* rbl, int, int dist) const { const float v = rbl[t5_bucket(dist * dil)]; return (dist >= 0 && dist <= 128) ? v : -__builtin_inff(); }
    __device__ __forceinline__ bool row_on(int, int) const { return true; }
    __device__ __forceinline__ void stats(int row, float m, float l) const { ST[(size_t)(q0 + row) * (os / 128)] = (f32x2){m, l}; }
    __device__ __forceinline__ void gate_prefetch(float*, int, int) const {}
    __device__ __forceinline__ void epilogue(const f32x16* o, const float* rl, int wid, int r32, int hi, const float*) const {
#pragma unroll
        for (int r = 0; r < 16; ++r) { bf16_t* yp = O + (size_t)(q0 + wid * 32 + crow(r, hi)) * os + r32;
#pragma unroll
            for (int d = 0; d < 4; ++d) yp[d * 32] = f2bf(o[d][r] * rl[r]); } }
};
struct AV_Win {
    static constexpr int NPOS = 64, NH = 4; static constexpr bool KEYBIAS = false, ROWMASK = false, SKIP = false;
    const bf16_t *Q, *K, *V; const float* keyb; const float* relb; const float* gates; bf16_t* YCF; int q0, nt, t0, hb, tok0;
    __device__ __forceinline__ const bf16_t* qptr(int row) const { return Q + (size_t)(q0 + (row >> 2)) * LDP + (row & 3) * 128; }
    __device__ __forceinline__ size_t rs() const { return LDP; }
    __device__ __forceinline__ int kbase(int t) const { return 64 * (t0 + t); }
    __device__ __forceinline__ const bf16_t* kptr(int key) const { return K + (size_t)key * LDP; }
    __device__ __forceinline__ const bf16_t* vptr(int key) const { return V + (size_t)key * LDP; }
    __device__ __forceinline__ bool wave_active(int, int) const { return true; }
    static constexpr bool NEEDS_BIAS = true;
    __device__ __forceinline__ void load_bias(LAS float* rbl, int tid) const { if (tid < 128) rbl[tid] = relb[(tid & 31) * 20 + hb + (tid >> 5)] * LOG2E; }
    __device__ __forceinline__ float tabval(LAS const float* rbl, int g, int dist) const { const float v = rbl[g * 32 + t5_bucket(dist)]; return (dist >= 0 && dist < 512) ? v : -__builtin_inff(); }
    __device__ __forceinline__ bool row_on(int, int) const { return true; }
    __device__ __forceinline__ void stats(int, float, float) const {}
    __device__ __forceinline__ void gate_prefetch(float* gt, int wid, int hi) const {
#pragma unroll
        for (int r = 0; r < 16; ++r) { const int R = wid * 32 + crow(r, hi); gt[r] = gates[(size_t)(tok0 + q0 + (R >> 2)) * 32 + 8 + 16 + (hb - 12) + (R & 3)]; } }
    __device__ __forceinline__ void epilogue(const f32x16* o, const float* rl, int wid, int r32, int hi, const float* gt) const {
#pragma unroll
        for (int r = 0; r < 16; ++r) { const int R = wid * 32 + crow(r, hi); const float s = sigmoidf_(gt[r]) * rl[r];
            bf16_t* yp = YCF + (size_t)(tok0 + q0 + (R >> 2)) * 1024 + ((hb - 12) + (R & 3)) * 128 + r32;
#pragma unroll
            for (int d = 0; d < 4; ++d) yp[d * 32] = f2bf(s * o[d][r]); } }
};
struct AV_Slc {
    static constexpr int NPOS = 64, NH = 4; static constexpr bool KEYBIAS = false, ROWMASK = true, SKIP = false;
    const bf16_t *Q, *K, *V; const float* keyb; const float* relb; const float* gates; const bf16_t* YCF; const bf16_t* YCF2; bf16_t* Y; int q0, nt, hb, tok0;
    LAS const int* tl; LAS const unsigned long long* msk;
    __device__ __forceinline__ const bf16_t* qptr(int row) const { return Q + (size_t)(q0 + (row >> 2)) * LDP + (row & 3) * 128; }
    __device__ __forceinline__ size_t rs() const { return LDP; }
    __device__ __forceinline__ int kbase(int t) const { return 64 * tl[t]; }
    __device__ __forceinline__ const bf16_t* kptr(int key) const { return K + (size_t)key * LDP; }
    __device__ __forceinline__ const bf16_t* vptr(int key) const { return V + (size_t)key * LDP; }
    __device__ __forceinline__ bool wave_active(int, int) const { return true; }
    static constexpr bool NEEDS_BIAS = true;
    __device__ __forceinline__ void load_bias(LAS float* rbl, int tid) const { if (tid < 128) rbl[tid] = relb[(tid & 31) * 20 + hb + (tid >> 5)] * LOG2E; }
    __device__ __forceinline__ float tabval(LAS const float* rbl, int g, int dist) const { const float v = rbl[g * 32 + t5_bucket(dist)]; return dist >= 0 ? v : -__builtin_inff(); }
    __device__ __forceinline__ bool row_on(int t, int row) const { return (msk[row >> 2] >> tl[t]) & 1ull; }
    __device__ __forceinline__ void stats(int, float, float) const {}
    __device__ __forceinline__ void gate_prefetch(float* gt, int wid, int hi) const {
#pragma unroll
        for (int r = 0; r < 16; ++r) { const int R = wid * 32 + crow(r, hi); gt[r] = gates[(size_t)(tok0 + q0 + (R >> 2)) * 32 + 8 + 8 + (hb - 12) + (R & 3)]; } }
    __device__ __forceinline__ void epilogue(const f32x16* o, const float* rl, int wid, int r32, int hi, const float* gpre) const {
#pragma unroll
        for (int hf = 0; hf < 2; ++hf) {
            float gt[8]; float yc[8][4];
#pragma unroll
            for (int rr = 0; rr < 8; ++rr) { const int r = hf * 8 + rr; const int R = wid * 32 + crow(r, hi); const int tok = tok0 + q0 + (R >> 2), hd = (hb - 12) + (R & 3);
                gt[rr] = gpre[r]; const bf16_t* yp = YCF + (size_t)tok * 1024 + hd * 128 + r32; const bf16_t* yq = YCF2 + (size_t)tok * 1024 + hd * 128 + r32;
#pragma unroll
                for (int d = 0; d < 4; ++d) yc[rr][d] = bf2f(yp[d * 32]) + bf2f(yq[d * 32]); }
#pragma unroll
            for (int rr = 0; rr < 8; ++rr) { const int r = hf * 8 + rr; const int R = wid * 32 + crow(r, hi); const int tok = tok0 + q0 + (R >> 2), hd = (hb - 12) + (R & 3); const float s = sigmoidf_(gt[rr]) * rl[r];
                bf16_t* yo = Y + (size_t)tok * LDY + YC_C + hd * 128 + r32;
#pragma unroll
                for (int d = 0; d < 4; ++d) yo[d * 32] = f2bf(yc[rr][d] + s * o[d][r]); }
            asm volatile("" ::: "memory");
        } }
};
__device__ __forceinline__ float gelu_tanh(float x) { const float u = 0.7978845608028654f * (x + 0.044715f * x * x * x); const float e = __expf(2.f * u); const float th = 1.f - 2.f / (1.f + e); return 0.5f * x * (1.f + th); }
__device__ __forceinline__ void cmp_stage2_unit(const Params& p, int layer, int unit, LAS unsigned char* lds) {
    const int tid = tid_l(), wid = tid >> 6, lane = tid & 63, fr = lane & 15, fq = lane >> 4;
    const int kv = unit >> 7, rg = unit & 127;
    LAS bf16_t* hid = (LAS bf16_t*)lds;
    const bf16_t* slab = (const bf16_t*)(p.ws + WS_SLAB) + (size_t)kv * 16 * 2048 * 256;
    const float* cb1 = (const float*)(p.ws + WS_CB1) + (layer * 2 + kv) * 256;
    { const int r = tid >> 5, n = (tid & 31) * 8;
      f32x4 a0 = *(const f32x4*)(cb1 + n), a1 = *(const f32x4*)(cb1 + n + 4);
#pragma unroll 4
      for (int s = 0; s < 16; ++s) { const u32x4 w_ = *(const u32x4*)(slab + ((size_t)s * 2048 + rg * 16 + r) * 256 + n);
          a0 += (f32x4){bflo(w_.x), bfhi(w_.x), bflo(w_.y), bfhi(w_.y)}; a1 += (f32x4){bflo(w_.z), bfhi(w_.z), bflo(w_.w), bfhi(w_.w)}; }
      u32x4 w; w.x = cvt_pk_bf16(gelu_tanh(a0[0]), gelu_tanh(a0[1])); w.y = cvt_pk_bf16(gelu_tanh(a0[2]), gelu_tanh(a0[3]));
      w.z = cvt_pk_bf16(gelu_tanh(a1[0]), gelu_tanh(a1[1])); w.w = cvt_pk_bf16(gelu_tanh(a1[2]), gelu_tanh(a1[3]));
      *(LAS u32x4*)(hid + r * 264 + n) = w; }
    __syncthreads();
    const bf16_t* w2 = (const bf16_t*)(p.ws + WS_WC2 + (size_t)(layer * 2 + kv) * SZ_WC2) + (size_t)(wid * 16 + fr) * 256 + fq * 8;
    f32x4 acc = {0.f, 0.f, 0.f, 0.f};
#pragma unroll
    for (int ks = 0; ks < 8; ++ks) { const bf16x8 a = *(LAS const bf16x8*)(hid + fr * 264 + ks * 32 + fq * 8); const bf16x8 b = *(const bf16x8*)(w2 + ks * 32);
        acc = __builtin_amdgcn_mfma_f32_16x16x32_bf16(a, b, acc, 0, 0, 0); }
    bf16_t* out = (bf16_t*)(p.ws + (kv ? WS_VC : WS_KC));
#pragma unroll
    for (int i = 0; i < 4; ++i) { const int grow = rg * 16 + fq * 4 + i; const int hk = grow & 1, bc = grow >> 1, c = bc & 255, b = bc >> 8;
        out[((size_t)(b * 2 + hk) * 256 + c) * 128 + wid * 16 + fr] = c == 255 ? (bf16_t)0 : f2bf(acc[i]); }
    __syncthreads();
}

__device__ __forceinline__ float qxor1(float v) { return __int_as_float(__builtin_amdgcn_update_dpp(0, __float_as_int(v), 0xB1, 0xF, 0xF, true)); }
__device__ __forceinline__ float qxor2(float v) { return __int_as_float(__builtin_amdgcn_update_dpp(0, __float_as_int(v), 0x4E, 0xF, 0xF, true)); }
__device__ __forceinline__ void cmp_attn_unit(const Params& p, int unit, LAS unsigned char* lds) {
    const int tid = tid_l(), wid = rfl(tid >> 6), lane = tid & 63, r32 = lane & 31, hi = lane >> 5;
    const int b = unit >> 7, hk = (unit >> 6) & 1, qb = unit & 63, q0 = qb * 64;
    LAS unsigned char* V_lds = lds; LAS unsigned char* K_lds = lds + 2 * SHM_V;
    LAS float* als = (LAS float*)(lds + CMP_ALS_OFF) + wid * 64;
    LAS float* imp = (LAS float*)(lds + CMP_IMP_OFF);
    const bf16_t* proj = (const bf16_t*)(p.ws + WS_PROJ);
    const bf16_t* Kc = (const bf16_t*)(p.ws + WS_KC) + (size_t)(b * 2 + hk) * 256 * 128; const bf16_t* Vc = (const bf16_t*)(p.ws + WS_VC) + (size_t)(b * 2 + hk) * 256 * 128;
    const int sr = tid >> 4, sc = (tid & 15) * 8;
    const int kws = KSWZ(sr, sc * 2), vst0 = v_st(sr, sc), vst1 = v_st(32 + sr, sc);
    const int row = wid * 32 + r32, pl = row >> 2, gh = row & 3, pos = q0 + pl;
    bf16x8 qr[8];
    { const bf16_t* qp = proj + (size_t)(b * SEQ + pos) * LDP + PC_NSAQ + (hk * 4 + gh) * 128;
#pragma unroll
      for (int d0 = 0; d0 < 8; ++d0) qr[d0] = *(const bf16x8*)(qp + d0 * 16 + hi * 8); }
    const int nt = (q0 + 32) / 1024 + 1;
    for (int i = tid; i < 64 * 257; i += 512) imp[i] = 0.f;
    const unsigned vb0 = (unsigned)(uintptr_t)V_lds + (unsigned)v_rd_base(lane);
    const int cmax = pos >= 31 ? (pos - 31) >> 4 : -1;
    float m_reg = -1e30f, l_reg = 0.f;
    bf16x8 k0 = *(const bf16x8*)(Kc + (size_t)sr * 128 + sc), k1 = *(const bf16x8*)(Kc + (size_t)(32 + sr) * 128 + sc);
#pragma unroll 1
    for (int t = 0; t < nt; ++t) {
        __syncthreads();
        *(LAS bf16x8*)(K_lds + kws) = k0; *(LAS bf16x8*)(K_lds + kws + 32 * 256) = k1;
        __syncthreads();
        { const int tn = t + 1 < nt ? t + 1 : 0;
          k0 = *(const bf16x8*)(Kc + (size_t)(64 * tn + sr) * 128 + sc); k1 = *(const bf16x8*)(Kc + (size_t)(64 * tn + 32 + sr) * 128 + sc); }
        f32x16 p0, p1;
#pragma unroll
        for (int r = 0; r < 16; ++r) { p0[r] = 0.f; p1[r] = 0.f; }
        qkt(p0, p1, K_lds, r32, hi, qr);
        float pmax = -__builtin_inff();
#pragma unroll
        for (int r = 0; r < 16; ++r) { const int dc = cmax - 64 * t - crow(r, hi); p0[r] = keep_or_ninf(p0[r] * C2, dc); p1[r] = keep_or_ninf(p1[r] * C2, dc - 32); pmax = fmaxf(pmax, fmaxf(p0[r], p1[r])); }
        pmax = swapmax(pmax);
        const float mn = fmaxf(m_reg, pmax); const float alpha = __builtin_amdgcn_exp2f(m_reg - mn); m_reg = mn;
        float ps = 0.f;
#pragma unroll
        for (int r = 0; r < 16; ++r) ps += __builtin_amdgcn_exp2f(p0[r] - mn) + __builtin_amdgcn_exp2f(p1[r] - mn);
        ps = swapadd(ps); l_reg = l_reg * alpha + ps;
    }
    const float invl = l_reg > 0.f ? 1.f / l_reg : 0.f;
    f32x16 o[4];
#pragma unroll
    for (int d = 0; d < 4; ++d)
#pragma unroll
        for (int r = 0; r < 16; ++r) o[d][r] = 0.f;
    bf16x8 v0 = *(const bf16x8*)(Vc + (size_t)sr * 128 + sc), v1 = *(const bf16x8*)(Vc + (size_t)(32 + sr) * 128 + sc);
#pragma unroll 1
    for (int t = 0; t < nt; ++t) {
        __syncthreads();
        *(LAS bf16x8*)(K_lds + kws) = k0; *(LAS bf16x8*)(K_lds + kws + 32 * 256) = k1;
        *(LAS bf16x8*)(V_lds + vst0) = v0; *(LAS bf16x8*)(V_lds + vst1) = v1;
        __syncthreads();
        if (t + 1 < nt) { k0 = *(const bf16x8*)(Kc + (size_t)(64 * (t + 1) + sr) * 128 + sc); k1 = *(const bf16x8*)(Kc + (size_t)(64 * (t + 1) + 32 + sr) * 128 + sc);
                          v0 = *(const bf16x8*)(Vc + (size_t)(64 * (t + 1) + sr) * 128 + sc); v1 = *(const bf16x8*)(Vc + (size_t)(64 * (t + 1) + 32 + sr) * 128 + sc); }
        f32x16 p0, p1;
#pragma unroll
        for (int r = 0; r < 16; ++r) { p0[r] = 0.f; p1[r] = 0.f; }
        qkt(p0, p1, K_lds, r32, hi, qr);
#pragma unroll
        for (int r = 0; r < 16; ++r) { const int c = 64 * t + crow(r, hi);
            p0[r] = __builtin_amdgcn_exp2f(keep_or_ninf(p0[r] * C2, cmax - c) - m_reg) * invl; p1[r] = __builtin_amdgcn_exp2f(keep_or_ninf(p1[r] * C2, cmax - c - 32) - m_reg) * invl;
            float s0 = p0[r], s1 = p1[r];
            s0 += qxor1(s0); s0 += qxor2(s0); s1 += qxor1(s1); s1 += qxor2(s1);
            if (gh == 0) { imp[pl * 257 + c] = s0; imp[pl * 257 + c + 32] = s1; } }
        bf16x8 pa0, pa1, pa2, pa3; pack_p(p0, p1, pa0, pa1, pa2, pa3);
        pv_tile(o, vb0, pa0, pa1, pa2, pa3);
    }
    __syncthreads();
    { const int ppl = tid >> 3, part = tid & 7; float* ps = (float*)(p.ws + WS_PSLC) + ((size_t)(b * 2 + hk) * SEQ + q0 + ppl) * 64 + part * 8;
      float r8[8];
#pragma unroll
      for (int jj = 0; jj < 8; ++jj) { const int j = part * 8 + jj; LAS const float* ip = imp + ppl * 257 + 4 * j;
          float s = 2.f * (ip[0] + ip[1] + ip[2]); if (j > 0) s += ip[-1]; if (j < 63) s += ip[3]; r8[jj] = s; }
      *(f32x4*)ps = (f32x4){r8[0], r8[1], r8[2], r8[3]}; *(f32x4*)(ps + 4) = (f32x4){r8[4], r8[5], r8[6], r8[7]}; }
    bf16_t* ycf = (bf16_t*)(p.ws + WS_YCF2); const float* gates = (const float*)(p.ws + WS_GATES);
    { float gt[16];
#pragma unroll
      for (int r = 0; r < 16; ++r) { const int R = wid * 32 + crow(r, hi); gt[r] = gates[(size_t)(b * SEQ + q0 + (R >> 2)) * 32 + 8 + hk * 4 + (R & 3)]; }
#pragma unroll
      for (int r = 0; r < 16; ++r) { const int R = wid * 32 + crow(r, hi); const int tok = b * SEQ + q0 + (R >> 2), hd = hk * 4 + (R & 3); const float s = sigmoidf_(gt[r]);
          bf16_t* yp = ycf + (size_t)tok * 1024 + hd * 128 + r32;
#pragma unroll
          for (int d = 0; d < 4; ++d) yp[d * 32] = f2bf(s * o[d][r]); } }
    __syncthreads();
}

__device__ __forceinline__ void phase_dil_combine(const Params& p) {
    const bf16_t* dilo = (const bf16_t*)(p.ws + WS_DILO); const f32x2* st = (const f32x2*)(p.ws + WS_DILST); bf16_t* Y = (bf16_t*)(p.ws + WS_Y);
    for (int i = bid_l() * 512 + tid_l(); i < T * 64; i += gdim_l() * 512) { const int tok = i >> 6, h = (i >> 4) & 3, dc = (i & 15) * 8;
        const f32x2 s0 = st[(size_t)tok * 4 + h], s1 = st[((size_t)T + tok) * 4 + h], s2 = st[((size_t)2 * T + tok) * 4 + h];
        const float M = fmaxf(s0.x, fmaxf(s1.x, s2.x));
        float w0 = s0.y * __builtin_amdgcn_exp2f(s0.x - M), w1 = s1.y * __builtin_amdgcn_exp2f(s1.x - M), w2 = s2.y * __builtin_amdgcn_exp2f(s2.x - M);
        const float iw = 1.f / (w0 + w1 + w2); w0 *= iw; w1 *= iw; w2 *= iw;
        const u32x4 a = *(const u32x4*)(dilo + (size_t)tok * 512 + h * 128 + dc), bq = *(const u32x4*)(dilo + ((size_t)T + tok) * 512 + h * 128 + dc), c = *(const u32x4*)(dilo + ((size_t)2 * T + tok) * 512 + h * 128 + dc);
        u32x4 w;
#pragma unroll
        for (int j = 0; j < 4; ++j) w[j] = cvt_pk_bf16(w0 * bflo(a[j]) + w1 * bflo(bq[j]) + w2 * bflo(c[j]), w0 * bfhi(a[j]) + w1 * bfhi(bq[j]) + w2 * bfhi(c[j]));
        *(u32x4*)(Y + (size_t)tok * LDY + YC_B + h * 128 + dc) = w; }
}

constexpr int SLC_SCW = 65;
constexpr int SLC_SC_OFF = A3_KEYB, SLC_MSK_OFF = A3_KEYB + 64 * SLC_SCW * 8, SLC_TL_OFF = SLC_MSK_OFF + 512, SLC_UNI_OFF = SLC_TL_OFF + 256;
__device__ __forceinline__ int slc_select(const Params& p, int b, int hk, int qb, LAS unsigned char* lds) {
    const int tid = tid_l(), lane = tid & 63;
    LAS unsigned long long* sc = (LAS unsigned long long*)(lds + SLC_SC_OFF); LAS unsigned long long* msk = (LAS unsigned long long*)(lds + SLC_MSK_OFF);
    LAS int* tl = (LAS int*)(lds + SLC_TL_OFF); LAS unsigned long long* uni = (LAS unsigned long long*)(lds + SLC_UNI_OFF);
    const float* ps = (const float*)(p.ws + WS_PSLC) + ((size_t)(b * 2 + hk) * SEQ + qb * 64) * 64;
    { const int e = tid * 8, j0 = e & 63; const f32x4 a = *(const f32x4*)(ps + e), c = *(const f32x4*)(ps + e + 4); float v[8] = {a[0], a[1], a[2], a[3], c[0], c[1], c[2], c[3]};
#pragma unroll
      for (int i = 0; i < 8; ++i) { const int j = j0 + i; const float s = (j == 0 || j == qb || j == qb - 1) ? __builtin_inff() : (j <= qb ? v[i] : -__builtin_inff());
          unsigned ub = __float_as_uint(s); ub ^= (ub >> 31) ? 0xffffffffu : 0x80000000u;
          sc[(e >> 6) * SLC_SCW + j] = ((unsigned long long)ub << 32) | (unsigned)(63 - j); } }
    __syncthreads();
    { const int ppl = tid >> 3, part = tid & 7; unsigned lo = 0u, hiw = 0u;
#pragma unroll 1
      for (int jj = 0; jj < 8; ++jj) { const int j = part * 8 + jj; const unsigned long long kj = sc[ppl * SLC_SCW + j]; int rank = 0;
#pragma unroll 4
          for (int i = 0; i < 64; ++i) { const unsigned long long ki = sc[ppl * SLC_SCW + i]; rank += ki > kj ? 1 : 0; }
          if (rank < 16 && j <= qb) { if (j < 32) lo |= 1u << j; else hiw |= 1u << (j - 32); } }
      lo |= __shfl_xor(lo, 1); hiw |= __shfl_xor(hiw, 1); lo |= __shfl_xor(lo, 2); hiw |= __shfl_xor(hiw, 2); lo |= __shfl_xor(lo, 4); hiw |= __shfl_xor(hiw, 4);
      if (part == 0) msk[ppl] = ((unsigned long long)hiw << 32) | lo; }
    __syncthreads();
    if (tid < 64) { const unsigned long long m = msk[lane]; unsigned lo = (unsigned)m, hiw = (unsigned)(m >> 32);
        for (int o = 1; o < 64; o <<= 1) { lo |= __shfl_xor(lo, o); hiw |= __shfl_xor(hiw, o); }
        const unsigned long long u = ((unsigned long long)hiw << 32) | lo;
        if (lane == 0) uni[0] = u;
        if ((u >> lane) & 1ull) tl[__popcll(u & ((1ull << lane) - 1ull))] = lane; }
    __syncthreads();
    return __popcll(uni[0]);
}
struct CmpOrder { int G, c; size_t bbase;
    __device__ __forceinline__ bool next(int i, pg8::GUnit& u) const { const int L = i * G + c; if (L >= 256) return false;
        const int kv = L >> 7, pm = (L >> 4) & 7, ks = L & 15, b = pm >> 1, c0 = (pm & 1) * 128;
        u.aoff = ((size_t)(b * SEQ + 16 * c0 + 2 * ks) * LDP + kv * 256) * 2; u.boff = (size_t)kv * SZ_WC1 + (size_t)ks * 4 * 128;
        u.row0 = pm * 256; u.col0 = 0; u.aux = kv * 16 + ks; return true; }
};
struct CmpRow { __device__ __forceinline__ unsigned operator()(int R) const { return (unsigned)(R >> 1) * (unsigned)(16 * LDP * 2) + (unsigned)(R & 1) * 256u; } };
#ifndef MK_WGM_F8
#define MK_WGM_F8 4
#endif
struct MoeOrder { int nM, nN, G, c; size_t tsA, tsB, esB; int o1, o2, o3, o4, o5, o6, o7;
    __device__ __forceinline__ bool next(int i, pg8::GUnit& u) const { int pm, pn; if (!pg8::static_tile(i, G, c, nM, nN, pm, pn, MK_WGM_F8)) return false;
        const int row0 = pm * 256;
        const int e = (o1 <= row0) + (o2 <= row0) + (o3 <= row0) + (o4 <= row0) + (o5 <= row0) + (o6 <= row0) + (o7 <= row0);
        u.aoff = (size_t)pm * tsA; u.boff = (size_t)e * esB + (size_t)pn * tsB; u.row0 = row0; u.col0 = pn * 256; u.aux = e; return true; }
};

struct MoeDownOrder { int nM, nN, G, c, ntq; size_t tsA, tsB, esB; int o1, o2, o3, o4, o5, o6, o7;
    __device__ __forceinline__ bool next(int i, pg8::GUnit& u) const {
        const int nwg = nM * nN, nfr = nwg / G, tail = nwg - nfr * G; const bool split = tail > 0 && 4 * tail <= G;
        long L = (long)i * G + c; int ks = -1, tu = 0;
        if (split && i >= nfr) { if (i > nfr) return false; tu = c >> 2; ks = c & 3; if (tu >= tail) return false; L = (long)nfr * G + tu; }
        int pm, pn; if (!pg8::static_tile_L(L, nM, nN, pm, pn, MK_WGM_F8)) return false;
        const int row0 = pm * 256;
        const int e = (o1 <= row0) + (o2 <= row0) + (o3 <= row0) + (o4 <= row0) + (o5 <= row0) + (o6 <= row0) + (o7 <= row0);
        u.aoff = (size_t)pm * tsA; u.boff = (size_t)e * esB + (size_t)pn * tsB; u.row0 = row0; u.col0 = pn * 256; u.aux = e; u.nt = 0; u.sub = 0;
        if (ks >= 0) { u.aoff += (size_t)ks * ntq * 128; u.boff += (size_t)ks * ntq * 128; u.nt = ntq; u.sub = 1 + ks + 4 * tu; }
        return true; }
};
constexpr int NPH = 34;
#ifndef MK_DUPA
#define MK_DUPA 0
#endif
#ifndef MK_DUP0
#define MK_DUP0 0u
#endif
#ifndef MK_DUP1
#define MK_DUP1 0u
#endif
#ifndef MK_EPI_OFF
#define MK_EPI_OFF 0
#endif
#ifndef MK_PREP_NOSTORE
#define MK_PREP_NOSTORE 0
#endif
#ifndef MK_DUP
#define MK_DUP 0u
#endif
#ifndef MK_FINAL_OOP
#define MK_FINAL_DST p.out
#else
#define MK_FINAL_DST ((float*)(p.ws + WS_PROJ))
#endif
#define PH_BEGIN asm volatile("; PHASE_MARK"); const Params p = load_params(); const int c = bid_l(), G = gdim_l(); (void)c; (void)G; const int cv = (G & 7) == 0 ? (c & 7) * (G >> 3) + (c >> 3) : c; (void)cv;     unsigned char* ws = p.ws; (void)ws; \
        bf16_t* PROJ = (bf16_t*)(ws + WS_PROJ); bf16_t* H = (bf16_t*)(ws + WS_H); bf16_t* Y = (bf16_t*)(ws + WS_Y); bf16_t* MERGED = (bf16_t*)(ws + WS_MERGED); \
        const float* GATES = (const float*)(ws + WS_GATES); const float* relb = p.in[IN_RELB]; bf16_t* XB = (bf16_t*)(ws + WS_XB); (void)XB; (void)PROJ; (void)H; (void)Y; (void)MERGED; (void)GATES; (void)relb;
#define INP(j) (LO <= pb + (j) && pb + (j) < HI)
#ifndef MK_STAG
#define MK_STAG 1
#endif
#ifndef MK_STAGN
#define MK_STAGN 48
#endif
#define STAGGER() do { if (MK_STAG) { const int g_ = (bid_l() >> 3) & 3; for (int i_ = 0; i_ < g_ * (MK_STAG); ++i_) __builtin_amdgcn_s_sleep(MK_STAGN); } } while (0)
#define BAR_NOW() do { XcdBarrier b_; b_.bar = (unsigned*)(load_params().ws + WS_CTL) + CW_BAR; b_.x = xb_xcc_id(); b_.st = (volatile LAS unsigned*)(lds + LDS_MISC); xcd_barrier(b_); } while (0)
#define SEAM(k) do { if constexpr ((k) + 1 < HI) BAR_NOW(); } while (0)
template <int L, int LO, int HI>
__device__ __forceinline__ void layer_phases(LAS unsigned char* lds) {
    constexpr int l = L, pb = 1 + 16 * L;
        if constexpr (INP(0) && !(l == 1 && (MK_FUSE_N1))) for (int rep_ = 0; rep_ < 1 + ((((L == 0 ? (MK_DUP0) : (MK_DUP1))) >> 0) & 1); ++rep_) { PH_BEGIN if constexpr (l == 0) phase_norm<false, true, false>(p, p.in[IN_X], p.in[IN_NMIX] + l * 2048, H, lds); else phase_norm<false, true, true>(p, XB, p.in[IN_NMIX] + l * 2048, H, lds); SEAM(pb + 0); }
        if constexpr (INP(1)) for (int rep_ = 0; rep_ < 1 + ((((L == 0 ? (MK_DUP0) : (MK_DUP1))) >> 1) & 1); ++rep_) { PH_BEGIN
            { pg8::GemmP g{(const char*)((l == 1 && (MK_FUSE_N1)) ? (const void*)XB : (const void*)H), (const char*)(ws + WS_WIN + l * SZ_WIN), 4096u, 256, 32};
              pg8::StaticOrder S{64, 40, G, c, (size_t)256 * 4096, (size_t)256 * 4096};
              pg8::EpiBf16T<(l == 1 && (MK_FUSE_N1))> E{PROJ, LDP, 1.0f, (MK_EPI_OFF) && rep_ == 0 && l == 0};
#if MK_PROBE == 3
              const unsigned long long w0_ = wall_clock64(), c0_ = clock64();
#endif
              STAGGER();
              pg8::gemm_phase(lds, g, S, E, pg8::LinRow{4096u});
#if MK_PROBE == 3
              if (l == 0 && bid_l() == 0 && tid_l() == 0) { const unsigned long long w1_ = wall_clock64(), c1_ = clock64(); unsigned* ctl = (unsigned*)(p.ws + WS_CTL);
                  ctl[CW_DBG + 2] = (unsigned)(c1_ - c0_); ctl[CW_DBG + 3] = (unsigned)(w1_ - w0_); }
#endif
            }
            { pg8::GemmP g{(const char*)(ws + WS_H8), (const char*)(ws + WS_WIN + l * SZ_WIN + (size_t)PC_MERGE * 4096), 2048u, 256, 16};
              pg8::StaticOrder S{64, 24, G, c, (size_t)256 * 2048, (size_t)256 * 2048, MK_WGM_F8};
              pg8::EpiF8T<(l == 1 && (MK_FUSE_N1))> E{(unsigned char*)(PROJ + PC_MERGE), LDP * 2, 16.0f / 256.0f};
              pg8::gemm_phase_fp8(lds, g, S, E, pg8::LinRow{2048u}); }
            phase_gates(p, l);
            SEAM(pb + 1);
        }
        if constexpr (INP(2)) for (int rep_ = 0; rep_ < 1 + ((((L == 0 ? (MK_DUP0) : (MK_DUP1))) >> 2) & 1); ++rep_) { PH_BEGIN
            pg8::GemmP g{(const char*)(PROJ + PC_NSAKV), (const char*)(ws + WS_WC1 + (size_t)l * 2 * SZ_WC1), 8192u, (size_t)LDP * 2, 4};
            CmpOrder S{G, c, 0};
            pg8::EpiSlab E{(bf16_t*)(ws + WS_SLAB)};
            pg8::gemm_phase(lds, g, S, E, CmpRow{});
            phase_fox_cumsum(p, l);
            SEAM(pb + 2);
        }
        if constexpr (INP(3)) for (int rep_ = 0; rep_ < 1 + ((((L == 0 ? (MK_DUP0) : (MK_DUP1))) >> 3) & 1); ++rep_) { PH_BEGIN
#pragma unroll 1
            for (int ra_ = 0; ra_ < 1 + (((MK_DUPA) >> 3) & 1); ++ra_)
#pragma unroll 1
            for (int u = cv; u < 256; u += G) cmp_stage2_unit(p, l, u, lds);
#pragma unroll 1
            for (int ra_ = 0; ra_ < 1 + ((MK_DUPA) & 1); ++ra_)
#pragma unroll 1
            for (int u = cv; u < 256; u += G) { const int b = u >> 6, h = (u >> 3) & 7, pr = u & 7;
#pragma unroll 1
                for (int half = 0; half < 2; ++half) { const int qt = half ? 15 - pr : pr;
                    AV_Fox f; const bf16_t* base = PROJ + (size_t)(b * SEQ) * LDP + h * 128;
                    f.Q = base + PC_FOXQ; f.K = base + PC_FOXK; f.V = base + PC_FOXV; f.keyb = (const float*)(ws + WS_CNEG) + (size_t)(b * 8 + h) * SEQ; f.ctot = (const float*)(ws + WS_CTOT) + (b * 8 + h) * 64;
                    f.Y = Y + (size_t)(b * SEQ) * LDY + YC_A + h * 128; f.q0 = qt * 256; f.nt = 4 * qt + 4;
                    attn_unit(f, lds); } }
#pragma unroll 1
            for (int ra_ = 0; ra_ < 1 + (((MK_DUPA) >> 1) & 1); ++ra_)
#pragma unroll 1
            for (int u = cv; u < 512; u += G) { const int b = u >> 7, hk = (u >> 6) & 1, qb = u & 63;
                AV_Win f; const bf16_t* base = PROJ + (size_t)(b * SEQ) * LDP;
                f.Q = base + PC_NSAQ + hk * 512; f.K = base + PC_NSAKV + 2 * 512 + hk * 128; f.V = base + PC_NSAKV + 2 * 512 + 256 + hk * 128; f.keyb = nullptr; f.relb = relb; f.gates = GATES;
                f.YCF = (bf16_t*)(ws + WS_YCF); f.q0 = qb * 64; f.t0 = qb > 8 ? qb - 8 : 0; f.nt = qb - f.t0 + 1; f.hb = 12 + hk * 4; f.tok0 = b * SEQ;
                attn_unit(f, lds); }
#pragma unroll 1
            for (int ra_ = 0; ra_ < 1 + (((MK_DUPA) >> 2) & 1); ++ra_)
#pragma unroll 1
            for (int u = cv; u < 768; u += G) { const int gi = u >> 8, r8 = u & 255, b = r8 >> 6, h = (r8 >> 4) & 3, x = r8 & 15;
                const int dil = gi == 0 ? 1 : (gi == 1 ? 4 : 16); const int r = gi == 0 ? 0 : (gi == 1 ? (x & 3) : x), ut = gi == 0 ? x : (gi == 1 ? (x >> 2) : 0);
                AV_Dil f; const int hh = gi * 4 + h; const bf16_t* base = PROJ + (size_t)(b * SEQ + r) * LDP + hh * 128;
                f.Q = base + PC_DILQ; f.K = base + PC_DILK; f.V = base + PC_DILV; f.keyb = nullptr; f.relb = relb;
                f.O = (bf16_t*)(ws + WS_DILO) + ((size_t)gi * T + b * SEQ + r) * 512 + h * 128; f.ST = (f32x2*)(ws + WS_DILST) + ((size_t)gi * T + b * SEQ + r) * 4 + h;
                f.q0 = ut * 256; f.t0 = ut == 0 ? 0 : 4 * ut - 2; f.nt = 4 * ut + 4 - f.t0; f.dil = dil; f.hb = hh; f.rs_ = (size_t)dil * LDP; f.os = (size_t)dil * 512;
                attn_unit(f, lds); }
            SEAM(pb + 3);
        }
        if constexpr (INP(4)) for (int rep_ = 0; rep_ < 1 + ((((L == 0 ? (MK_DUP0) : (MK_DUP1))) >> 4) & 1); ++rep_) { PH_BEGIN
#pragma unroll 1
            for (int u = cv; u < 512; u += G) cmp_attn_unit(p, u, lds);
            phase_dil_combine(p);
            SEAM(pb + 4);
        }
        if constexpr (INP(5)) for (int rep_ = 0; rep_ < 1 + ((((L == 0 ? (MK_DUP0) : (MK_DUP1))) >> 5) & 1); ++rep_) { PH_BEGIN
#pragma unroll 1
            for (int u = cv; u < 256; u += G) { const int b = u >> 6, hk = (u >> 5) & 1, pr = u & 31;
#pragma unroll 1
                for (int half = 0; half < 2; ++half) { const int qb = half ? 63 - pr : pr;
                    const int ntl = slc_select(p, b, hk, qb, lds);
                    AV_Slc f; const bf16_t* base = PROJ + (size_t)(b * SEQ) * LDP;
                    f.Q = base + PC_NSAQ + hk * 512; f.K = base + PC_NSAKV + 512 + hk * 128; f.V = base + PC_NSAKV + 512 + 256 + hk * 128; f.keyb = nullptr; f.relb = relb; f.gates = GATES;
                    f.YCF = (const bf16_t*)(ws + WS_YCF); f.YCF2 = (const bf16_t*)(ws + WS_YCF2); f.Y = Y; f.q0 = qb * 64; f.nt = ntl; f.hb = 12 + hk * 4; f.tok0 = b * SEQ;
                    f.tl = (LAS const int*)(lds + SLC_TL_OFF); f.msk = (LAS const unsigned long long*)(lds + SLC_MSK_OFF);
                    attn_unit(f, lds); } }
            SEAM(pb + 5);
        }
        if constexpr (INP(6)) for (int rep_ = 0; rep_ < 1 + ((((L == 0 ? (MK_DUP0) : (MK_DUP1))) >> 6) & 1); ++rep_) { PH_BEGIN
            pg8::GemmP g{(const char*)Y, (const char*)(ws + WS_WBR + l * SZ_WBR), 5120u, 256, 40};
            pg8::StaticOrder S{64, 8, G, c, (size_t)256 * 5120, (size_t)256 * 5120};
            pg8::EpiBranch E{PROJ, MERGED};
            pg8::gemm_phase(lds, g, S, E, pg8::LinRow{5120u});
            SEAM(pb + 6);
        }
        if constexpr (INP(7)) for (int rep_ = 0; rep_ < 1 + ((((L == 0 ? (MK_DUP0) : (MK_DUP1))) >> 7) & 1); ++rep_) { PH_BEGIN
            pg8::GemmP g{(const char*)MERGED, (const char*)(ws + WS_WOUT + l * SZ_WOUT), 4096u, 256, 32};
            pg8::StaticOrder S{64, 8, G, c, (size_t)256 * 4096, (size_t)256 * 4096};
            if constexpr (l == 0) { pg8::EpiResB<true, (MK_FUSE_N2) != 0> E{p.in[IN_X], XB, 1.0f}; pg8::gemm_phase(lds, g, S, E, pg8::LinRow{4096u}); }
            else { pg8::EpiResB<false> E{XB, XB, 1.0f}; pg8::gemm_phase(lds, g, S, E, pg8::LinRow{4096u}); }
            SEAM(pb + 7);
        }
        if constexpr (INP(8) && !(l == 0 && (MK_FUSE_N2))) for (int rep_ = 0; rep_ < 1 + ((((L == 0 ? (MK_DUP0) : (MK_DUP1))) >> 8) & 1); ++rep_) { PH_BEGIN if (l == 0) phase_norm<false, (MK_FFN_F8 & 1) != 0, true>(p, XB, p.in[IN_NFFN] + l * 2048, H, lds); else phase_norm<true, false, true>(p, XB, p.in[IN_NFFN] + l * 2048, H, lds); SEAM(pb + 8); }
        if constexpr (l == 0) {
            if constexpr (INP(10)) for (int rep_ = 0; rep_ < 1 + ((((L == 0 ? (MK_DUP0) : (MK_DUP1))) >> 10) & 1); ++rep_) { PH_BEGIN
#if MK_FFN_F8 & 1
                pg8::GemmP g{(const char*)(ws + WS_H8), (const char*)(ws + WS_WFU), 2048u, 256, 16};
                pg8::StaticOrder S{64, 44, G, c, (size_t)256 * 2048, (size_t)256 * 2048};
#if MK_FFN_F8 & 2
                pg8::EpiSiluF8 E{(unsigned char*)(ws + WS_ACT), DFF, 1.0f / 256.0f, 8.0f};
#else
                pg8::EpiSilu E{(bf16_t*)(ws + WS_ACT), DFF, 1.0f / 256.0f};
#endif
                pg8::gemm_phase_fp8(lds, g, S, E, pg8::LinRow{2048u});
#else
                pg8::GemmP g{(const char*)((MK_FUSE_N2) ? (const void*)XB : (const void*)H), (const char*)(ws + WS_WFU), 4096u, 256, 32};
                pg8::StaticOrder S{64, 44, G, c, (size_t)256 * 4096, (size_t)256 * 4096};
#if MK_FFN_F8 & 2
                pg8::EpiSiluF8 E{(unsigned char*)(ws + WS_ACT), DFF, 1.0f, 8.0f, (MK_FUSE_N2) ? (const unsigned*)(ws + WS_SS) : nullptr};
#else
                pg8::EpiSilu E{(bf16_t*)(ws + WS_ACT), DFF, 1.0f};
#endif
                pg8::gemm_phase(lds, g, S, E, pg8::LinRow{4096u});
#endif
                SEAM(pb + 10);
            }
            if constexpr (INP(11)) for (int rep_ = 0; rep_ < 1 + ((((L == 0 ? (MK_DUP0) : (MK_DUP1))) >> 11) & 1); ++rep_) { PH_BEGIN
#if MK_FFN_F8 & 2
                pg8::GemmP g{(const char*)(ws + WS_ACT), (const char*)(ws + WS_WFD), (unsigned)DFF, 256, DFF / 128};
                pg8::StaticOrder S{64, 8, G, c, (size_t)256 * DFF, (size_t)256 * DFF};
                pg8::EpiResB<false, (MK_FUSE_N1) != 0, (MK_FUSE_N1) != 0, 1> E{XB, XB, 1.0f / 512.0f};
                pg8::gemm_phase_fp8(lds, g, S, E, pg8::LinRow{(unsigned)DFF});
#else
                pg8::GemmP g{(const char*)(ws + WS_ACT), (const char*)(ws + WS_WFD), (unsigned)(DFF * 2), 256, DFF / 64};
                pg8::StaticOrder S{64, 8, G, c, (size_t)256 * DFF * 2, (size_t)256 * DFF * 2};
                pg8::EpiResB<false> E{XB, XB, 1.0f};
                pg8::gemm_phase(lds, g, S, E, pg8::LinRow{(unsigned)(DFF * 2)});
#endif
                SEAM(pb + 11);
            }
        } else {
            if constexpr (INP(9)) for (int rep_ = 0; rep_ < 1 + ((((L == 0 ? (MK_DUP0) : (MK_DUP1))) >> 9) & 1); ++rep_) { PH_BEGIN phase_moe_scatter(p, lds); SEAM(pb + 9); }
            if constexpr (INP(10)) for (int rep_ = 0; rep_ < 1 + ((((L == 0 ? (MK_DUP0) : (MK_DUP1))) >> 10) & 1); ++rep_) { PH_BEGIN
                LAS int* sm = (LAS int*)lds; int nrt; moe_offsets(p, sm, nrt);
                const int o1 = rfl(sm[2057]), o2 = rfl(sm[2058]), o3 = rfl(sm[2059]), o4 = rfl(sm[2060]), o5 = rfl(sm[2061]), o6 = rfl(sm[2062]), o7 = rfl(sm[2063]); __syncthreads();
                pg8::GemmP g{(const char*)(ws + WS_HG), (const char*)(ws + WS_WMU), 2048u, 256, 16};
                MoeOrder S{nrt, 56, G, c, (size_t)256 * 2048, (size_t)256 * 2048, SZ_WMU1 / 2, o1, o2, o3, o4, o5, o6, o7};
                pg8::EpiSiluF8 E{(unsigned char*)(ws + WS_ACTM), DFFE, 1.0f / 256.0f, 8.0f};
                pg8::gemm_phase_fp8(lds, g, S, E, pg8::LinRow{2048u});
                SEAM(pb + 10);
            }
            if constexpr (INP(11)) for (int rep_ = 0; rep_ < 1 + ((((L == 0 ? (MK_DUP0) : (MK_DUP1))) >> 11) & 1); ++rep_) { PH_BEGIN
                LAS int* sm = (LAS int*)lds; int nrt; moe_offsets(p, sm, nrt);
                const int o1 = rfl(sm[2057]), o2 = rfl(sm[2058]), o3 = rfl(sm[2059]), o4 = rfl(sm[2060]), o5 = rfl(sm[2061]), o6 = rfl(sm[2062]), o7 = rfl(sm[2063]); __syncthreads();
                pg8::GemmP g{(const char*)(ws + WS_ACTM), (const char*)(ws + WS_WMD), (unsigned)DFFE, 256, DFFE / 128};
                MoeDownOrder S{nrt, 8, G, c, DFFE / 128 / 4, (size_t)256 * DFFE, (size_t)256 * DFFE, SZ_WMD1 / 2, o1, o2, o3, o4, o5, o6, o7};
                pg8::EpiMoeDown E{(bf16_t*)(ws + WS_HG), (const float*)(ws + WS_ROUTE + (size_t)T * 24), 1.0f / 512.0f, (bf16_t*)(ws + WS_OMPART), (unsigned*)(ws + WS_CTL) + CW_TMAP};
                pg8::gemm_phase_fp8(lds, g, S, E, pg8::LinRow{(unsigned)DFFE});
                SEAM(pb + 11);
            }
        }
    }
template <int LO, int HI>
__global__ void __launch_bounds__(512, 2) mk_range(Params p_) {
    LAS unsigned char* lds = (LAS unsigned char*)lds_raw;
    volatile LAS unsigned* misc = (volatile LAS unsigned*)(lds + LDS_MISC);
    { const int t0 = tid_l(); if (t0 < 4) misc[t0] = 0u; }
    park_launch_scalars();
    __syncthreads();
#if MK_PROBE
    const unsigned long long t_start = wall_clock64();
#endif
    if constexpr (HI - LO > 1) (void)xcd_barrier_post((unsigned*)(p_.ws + WS_CTL) + CW_BAR, misc);
    if constexpr (LO <= 0 && 0 < HI) for (int rep_ = 0; rep_ < 1 + (((MK_DUP) >> 31) & 1); ++rep_) { const Params p = load_params(); phase_prep(p, lds, (MK_PREP_NOSTORE) && rep_ == 0); SEAM(0); }
    layer_phases<0, LO, HI>(lds);
    layer_phases<1, LO, HI>(lds);
#ifdef MK_PRECHECK
    if constexpr (HI == 34) {
        const Params p = load_params(); unsigned cs = 0u;
        for (size_t i_ = (size_t)bid_l() * 512 + tid_l(); i_ < (size_t)T * DM; i_ += (size_t)gdim_l() * 512) cs += __float_as_uint(p.out[i_]) * (unsigned)(2654435761u * (unsigned)(i_ + 1) | 1u);
        { const int* slot = (const int*)(p.ws + WS_ROUTE + (size_t)T * 16); const size_t rw = 1024;
          for (size_t i_ = (size_t)bid_l() * 512 + tid_l(); i_ < (size_t)2 * T * rw; i_ += (size_t)gdim_l() * 512) { const size_t tk = i_ / rw, w_ = i_ - tk * rw; const int s = slot[tk];
              const unsigned x_ = *(const unsigned*)(p.ws + WS_HG + ((size_t)s * rw + w_) * 4); cs += (x_ + (unsigned)s) * (unsigned)(2654435761u * (unsigned)(i_ + 1) | 1u); } }
        atomicAdd((unsigned*)(p.ws + WS_CTL) + CW_DBG + 1, cs);
        BAR_NOW();
    }
#endif
    if constexpr (LO <= 33 && 33 < HI) { const Params p = load_params(); phase_final(p, p.in[IN_NFIN], MK_FINAL_DST); }
#if MK_FP8PROBE
    {
        const Params p = load_params(); BAR_NOW();
        const unsigned f0 = __hip_atomic_load((unsigned*)(p.ws + WS_CTL) + CW_DBG + 8, __ATOMIC_RELAXED, __HIP_MEMORY_SCOPE_AGENT), f1 = __hip_atomic_load((unsigned*)(p.ws + WS_CTL) + CW_DBG + 9, __ATOMIC_RELAXED, __HIP_MEMORY_SCOPE_AGENT);
        if (!f0) { const float cv = sqrtf(f1 ? 3.f : 8.f); for (size_t i = (size_t)bid_l() * 512 + tid_l(); i < (size_t)T * DM; i += (size_t)gdim_l() * 512) p.out[i] = cv; }
    }
#endif
#if MK_PROBE
    if constexpr (HI - LO > 1) {
        const Params p = load_params();
        BAR_NOW();
        unsigned* ctl = (unsigned*)(p.ws + WS_CTL);
#if MK_PROBE == 1
        const unsigned long long t1 = wall_clock64();
        const unsigned tmo = __hip_atomic_load(ctl + XB_TMO, __ATOMIC_RELAXED, __HIP_MEMORY_SCOPE_AGENT);
        const float ms = (float)(t1 - t_start) * 1e-5f;
        int k = 1 + (int)fminf(45.f, rintf(4.f * log2f(1.f + ms))) + (tmo ? 50 : 0);
        const float cv = sqrtf((float)k);
#elif MK_PROBE == 3
        __builtin_amdgcn_fence(__ATOMIC_ACQUIRE, "agent");
        const unsigned dc_ = __hip_atomic_load(ctl + CW_DBG + 2, __ATOMIC_RELAXED, __HIP_MEMORY_SCOPE_AGENT), dw_ = __hip_atomic_load(ctl + CW_DBG + 3, __ATOMIC_RELAXED, __HIP_MEMORY_SCOPE_AGENT);
#if MK_PROBE3_MODE == 0
        const float ghz = (float)dc_ / (float)dw_ * 0.1f;
        int k = (int)rintf(ghz * 40.f); k = k < 1 ? 1 : (k > 98 ? 98 : k);
#else
#if MK_PROBE3_MODE == 1
        const float us = (float)dw_ * 0.01f;
        int k = (int)rintf(us / 16.f); k = k < 1 ? 1 : (k > 98 ? 98 : k);
#else
        int k = (int)rintf((float)dc_ / (320.f * 200.f)); k = k < 1 ? 1 : (k > 98 ? 98 : k);
#endif
#endif
        const float cv = sqrtf((float)k);
#else
        unsigned cs = 0u;
#define CKS(off, rows, rowbytes, stridebytes) do { const size_t nw_ = (size_t)(rowbytes) / 4; for (size_t i_ = (size_t)bid_l() * 512 + tid_l(); i_ < (size_t)(rows) * nw_; i_ += (size_t)gdim_l() * 512) { \
            const size_t r_ = i_ / nw_, w_ = i_ - r_ * nw_; const unsigned x_ = *(const unsigned*)(p.ws + (off) + r_ * (size_t)(stridebytes) + w_ * 4); cs += x_ * (unsigned)(2654435761u * (unsigned)(i_ + 1) | 1u); } } while (0)
        constexpr int PS = HI - 1;
        if constexpr (PS == 0) { CKS(WS_WIN, 1, WS_PROJ - WS_WIN, 0); }
        if constexpr (PS == 1 || PS == 9 || PS == 17 || PS == 25) { CKS(WS_H, T, 4096, 4096); }
        if constexpr (PS == 2 || PS == 18) { CKS(WS_PROJ, T, LDP * 2, LDP * 2); CKS(WS_GATES, T, 128, 128); }
        if constexpr (PS == 3 || PS == 19) { CKS(WS_SLAB, 1, 67108864, 0); CKS(WS_CNEG, 1, 32 * 4096 * 4, 0); }
        if constexpr (PS == 4 || PS == 20) { CKS(WS_YCF, T, 4096, 4096); CKS(WS_DILO, 3 * T, 1024, 1024); CKS(WS_DILST, 3 * T, 32, 32); CKS(WS_KC, 1, 8 * 256 * 128 * 2 * 2, 0); CKS(WS_Y, T, 2048, LDY * 2); }
        if constexpr (PS == 5 || PS == 21) { CKS(WS_YCF, T, 4096, 4096); CKS(WS_PSLC, 1, 8 * 4096 * 64 * 4, 0); CKS(WS_Y + 2048, T, 1024, LDY * 2); }
        if constexpr (PS == 6 || PS == 22) { CKS(WS_Y, T, LDY * 2, LDY * 2); }
        if constexpr (PS == 7 || PS == 23) { CKS(WS_MERGED, T, 4096, 4096); }
        if constexpr (PS == 8 || PS == 12 || PS == 24 || PS == 33 || PS == 28 || PS == 25) { for (size_t i_ = (size_t)bid_l() * 512 + tid_l(); i_ < (size_t)T * DM; i_ += (size_t)gdim_l() * 512) cs += __float_as_uint(p.out[i_]) * (unsigned)(2654435761u * (unsigned)(i_ + 1) | 1u); }
        if constexpr (PS == 11) { CKS(WS_ACT, T, DFF * 2, DFF * 2); }
#ifdef MK_FINAL_OOP
        if constexpr (PS == 33) { CKS(WS_PROJ, T, 8192, 8192); }
#endif
        if constexpr (PS == 25) { CKS(WS_ROUTE, 1, (size_t)T * 16, 0); CKS(WS_CTL + CW_CNT * 4, 1, 2048 * 4, 0); }
        if constexpr (PS == 26 || PS == 27 || PS == 28) { const int* slot = (const int*)(p.ws + WS_ROUTE + (size_t)T * 16);
            const size_t base = PS == 27 ? WS_ACTM : WS_HG; const size_t rw = PS == 27 ? DFFE / 2 : 1024;
            for (size_t i_ = (size_t)bid_l() * 512 + tid_l(); i_ < (size_t)2 * T * rw; i_ += (size_t)gdim_l() * 512) { const size_t tk = i_ / rw, w_ = i_ - tk * rw; const int s = slot[tk];
                const unsigned x_ = *(const unsigned*)(p.ws + base + ((size_t)s * rw + w_) * 4); cs += (x_ + (unsigned)s) * (unsigned)(2654435761u * (unsigned)(i_ + 1) | 1u); } }
#ifdef MK_PRECHECK
        cs = 0u;
#endif
        atomicAdd(ctl + CW_DBG, cs);
        BAR_NOW();
#ifdef MK_PRECHECK
        const unsigned tot = __hip_atomic_load(ctl + CW_DBG + 1, __ATOMIC_RELAXED, __HIP_MEMORY_SCOPE_AGENT);
#else
        const unsigned tot = __hip_atomic_load(ctl + CW_DBG, __ATOMIC_RELAXED, __HIP_MEMORY_SCOPE_AGENT);
#endif
        const float cv = 1.0f + (float)((tot ^ (tot >> 16)) & 0xffffu) * (1.0f / 65536.0f);
#endif
        for (size_t i = (size_t)bid_l() * 512 + tid_l(); i < (size_t)T * DM; i += (size_t)gdim_l() * 512) p.out[i] = cv;
    }
#endif
}
#undef INP
#undef SEAM
#undef PH_BEGIN
#if MK_ONE_LAUNCH && !MK_DEBUG
#ifndef MK_PSTAGE
#define MK_PSTAGE (NPH - 1)
#endif
#define MK_MAIN (mk_range<0, MK_PSTAGE + 1>)
#else
#define MK_MAIN (mk_range<2, 3>)
typedef void (*kern_t)(Params);
template <int... I> struct KernTab { kern_t k[sizeof...(I)] = { mk_range<I, I + 1>... }; };
template <int N, int... I> struct MakeTab : MakeTab<N - 1, N - 1, I...> {};
template <int... I> struct MakeTab<0, I...> { typedef KernTab<I...> type; };
static MakeTab<NPH>::type kerns;
#endif
extern "C" void kernel_launch(void* const* d_in, const int* in_sizes, int n_in, void* d_out, int out_size, void* d_ws, size_t ws_size, hipStream_t stream) {
    static int grid = 0;
    if (grid == 0) {
        if (n_in != N_IN || out_size != T * DM || ws_size < WS_END) { fprintf(stderr, "kernel_launch: unexpected shapes (n_in %d out %d ws %zu need %zu)\n", n_in, out_size, ws_size, (size_t)WS_END); grid = -1; return; }
        int dev = 0, cus = 0, per_cu = 0;
        if (hipGetDevice(&dev) != hipSuccess || hipDeviceGetAttribute(&cus, hipDeviceAttributeMultiprocessorCount, dev) != hipSuccess) { grid = -1; return; }
#if MK_ONE_LAUNCH && !MK_DEBUG
        if (hipFuncSetAttribute((const void*)MK_MAIN, hipFuncAttributeMaxDynamicSharedMemorySize, LDS_BYTES) != hipSuccess) { fprintf(stderr, "kernel_launch: hipFuncSetAttribute failed\n"); grid = -1; return; }
#else
        for (int i = 0; i < NPH; ++i) if (hipFuncSetAttribute((const void*)kerns.k[i], hipFuncAttributeMaxDynamicSharedMemorySize, LDS_BYTES) != hipSuccess) { fprintf(stderr, "kernel_launch: hipFuncSetAttribute failed\n"); grid = -1; return; }
#endif
        if (hipOccupancyMaxActiveBlocksPerMultiprocessor(&per_cu, (const void*)MK_MAIN, 512, LDS_BYTES) != hipSuccess || per_cu < 1) { fprintf(stderr, "kernel_launch: occupancy query says %d\n", per_cu); per_cu = 1; }
        (void)hipGetLastError();
        grid = cus;
    }
    if (grid < 0) return;
    (void)hipMemsetAsync((char*)d_ws + WS_CTL, 0, CTL_BYTES, stream);
    Params p{};
    for (int i = 0; i < N_IN; ++i) p.in[i] = (const float*)d_in[i];
    p.out = (float*)d_out; p.ws = (unsigned char*)d_ws;
#if MK_ONE_LAUNCH && !MK_DEBUG
    p.ph_lo = 0; p.ph_hi = NPH;
    hipLaunchKernelGGL(MK_MAIN, dim3(grid), dim3(512), LDS_BYTES, stream, p);
#else
    for (int ph = 0; ph < NPH; ++ph) {
        const bool empty = (ph >= 13 && ph <= 16) || (ph >= 29 && ph <= 32) || ph == 10;
        if (empty) continue;
#if MK_DEBUG
        dbg_before(p, ph, grid, stream);
#endif
        p.ph_lo = ph; p.ph_hi = ph + 1;
        hipLaunchKernelGGL(kerns.k[ph], dim3(grid), dim3(512), LDS_BYTES, stream, p);
#if MK_DEBUG
        dbg_after(p, ph, grid, stream);
#endif
    }
#endif
}
```

```cpp
#include <hip/hip_runtime.h>
#include <stdint.h>
#include <stdio.h>

#ifndef MK_DEBUG
#define MK_DEBUG 0
#endif
#ifndef MK_DBG_STAGE
#define MK_DBG_STAGE 0
#endif
#ifndef MK_PROBE
#define MK_PROBE 0
#endif
#ifndef MK_PROBE3_MODE
#define MK_PROBE3_MODE 0
#endif
#ifndef MK_FP8PROBE
#define MK_FP8PROBE 0
#endif
#ifndef MK_FFN_F8
#ifndef MK_FUSE_N1
#define MK_FUSE_N1 1
#endif
#ifndef MK_FUSE_N2
#define MK_FUSE_N2 1
#endif
#define MK_FFN_F8 2
#endif
#ifndef MK_ONE_LAUNCH
#define MK_ONE_LAUNCH 1
#endif

#define LAS __attribute__((address_space(3)))
typedef unsigned short bf16_t;
typedef short bf16x8 __attribute__((ext_vector_type(8)));
typedef short s16x4 __attribute__((ext_vector_type(4)));
typedef float f32x2 __attribute__((ext_vector_type(2)));
typedef float f32x4 __attribute__((ext_vector_type(4)));
typedef float f32x16 __attribute__((ext_vector_type(16)));
typedef unsigned u32x2 __attribute__((ext_vector_type(2)));
typedef unsigned u32x4 __attribute__((ext_vector_type(4)));

constexpr int T = 16384, DM = 2048, SEQ = 4096, NBATCH = 4;
constexpr int D_IN = 16416;
#ifndef MK_LDP
#define MK_LDP 16384
#endif
constexpr int LDP = MK_LDP;
constexpr int PC_FOXQ = 0, PC_FOXK = 1024, PC_FOXV = 2048;
constexpr int PC_DILQ = 3072, PC_DILK = 3072 + 1536, PC_DILV = 3072 + 3072;
constexpr int PC_NSAQ = 7680, PC_NSAKV = 8704, PC_MERGE = 10240;
constexpr int LDY = 2560;
constexpr int YC_A = 0, YC_B = 1024, YC_C = 1536;
constexpr int DFF = 5632, DFFE = 7168, NEXP = 8;
constexpr int MOE_ROWS = 2 * T + NEXP * 256;
constexpr float RMS_EPS = 1e-6f;
constexpr float LOG2E = 1.4426950408889634f;
constexpr float SM_SCALE = 0.08838834764831845f;
constexpr float C2 = SM_SCALE * LOG2E;

enum { IN_X = 0, IN_RELB, IN_NMIX, IN_NFFN, IN_NFIN, IN_WIN, IN_FOXB, IN_PEK, IN_W1K, IN_W2K, IN_PEV, IN_W1V, IN_W2V,
       IN_WBA, IN_WBB, IN_WBC, IN_WOUT, IN_FG, IN_FU, IN_FD, IN_ROUTER, IN_MG, IN_MU, IN_MD, N_IN };

constexpr size_t CTL_BYTES = 65536;
constexpr size_t SZ_WIN = (size_t)16384 * 2048 * 2, SZ_WG32 = (size_t)32 * 2048 * 2, SZ_WBR = (size_t)2048 * 2560 * 2, SZ_WOUT = (size_t)2048 * 2048 * 2;
constexpr size_t SZ_WFU = (size_t)2 * DFF * 2048 * 2, SZ_WFD = (size_t)2048 * DFF * 2;
constexpr size_t SZ_WMU1 = (size_t)2 * DFFE * 2048 * 2, SZ_WMD1 = (size_t)2048 * DFFE * 2;
constexpr size_t SZ_WC1 = (size_t)256 * 4096 * 2, SZ_WC2 = (size_t)128 * 256 * 2;
constexpr size_t WS_CTL = 0;
constexpr size_t WS_WIN = WS_CTL + CTL_BYTES;
constexpr size_t WS_WG32 = WS_WIN + 2 * SZ_WIN;
constexpr size_t WS_WBR = WS_WG32 + 2 * SZ_WG32;
constexpr size_t WS_WOUT = WS_WBR + 2 * SZ_WBR;
constexpr size_t WS_WFU = WS_WOUT + 2 * SZ_WOUT;
constexpr size_t WS_WFD = WS_WFU + SZ_WFU;
constexpr size_t WS_WMU = WS_WFD + SZ_WFD;
constexpr size_t WS_WMD = WS_WMU + 8 * SZ_WMU1;
constexpr size_t WS_WC1 = WS_WMD + 8 * SZ_WMD1;
constexpr size_t WS_WC2 = WS_WC1 + 4 * SZ_WC1;
constexpr size_t WS_CB1 = WS_WC2 + 4 * SZ_WC2;
constexpr size_t WS_PROJ = WS_CB1 + 4096;
constexpr size_t SZ_PROJ = (size_t)(T + 64) * LDP * 2;
constexpr size_t WS_H = WS_PROJ + SZ_PROJ;
constexpr size_t WS_Y = WS_H + (size_t)T * 2048 * 2;
constexpr size_t WS_MERGED = WS_Y + (size_t)T * LDY * 2;
constexpr size_t WS_YCF = WS_MERGED + (size_t)T * 2048 * 2;
constexpr size_t WS_YCF2 = WS_YCF + (size_t)T * 1024 * 4;
constexpr size_t WS_DILO = WS_YCF2 + (size_t)T * 1024 * 4;
constexpr size_t WS_DILST = WS_DILO + (size_t)3 * T * 512 * 2;
constexpr size_t WS_GATES = WS_DILST + (size_t)3 * T * 4 * 8;
constexpr size_t WS_CNEG = WS_GATES + (size_t)T * 32 * 4;
constexpr size_t WS_KC = WS_CNEG + (size_t)32 * 4096 * 4;
constexpr size_t WS_VC = WS_KC + (size_t)8 * 256 * 128 * 2;
constexpr size_t WS_PSLC = WS_VC + (size_t)8 * 256 * 128 * 2;
constexpr size_t WS_ROUTE = WS_PSLC + (size_t)8 * 4096 * 64 * 4;
constexpr size_t WS_H8 = WS_ROUTE + (size_t)T * 8 * 3 + (size_t)MOE_ROWS * 4 + 4096;
constexpr size_t WS_CTOT = WS_H8 + (size_t)T * 2048;
constexpr size_t WS_XB = WS_CTOT + 4 * 8 * 64 * 4;
constexpr size_t WS_SS = WS_XB + (size_t)T * 2048 * 2;
constexpr size_t WS_SS1 = WS_SS + (size_t)T * 4;
constexpr size_t WS_END = WS_SS1 + (size_t)T * 4;
constexpr size_t WS_SLAB = WS_MERGED;
constexpr size_t WS_OMPART = WS_YCF;
constexpr size_t WS_ACT = WS_PROJ;
constexpr size_t WS_ACTM = WS_PROJ;
constexpr size_t WS_HG = WS_Y;
static_assert((size_t)MOE_ROWS * 2048 * 2 <= (size_t)T * LDY * 2 + (size_t)T * 2048 * 2, "HG alias");
static_assert((size_t)MOE_ROWS * DFFE * 2 <= SZ_PROJ, "ACTM alias");

constexpr int CW_BAR = 0;
constexpr int CW_DBG = 4096;
constexpr int CW_CNT = 8192;
constexpr int CW_TMAP = 12288;

constexpr int LDS_BYTES = 147456;
constexpr int LDS_MISC = 146432;
constexpr int SHM_K = 16384, SHM_V = 16384;
constexpr int ALS_OFF = 98304, TAB_OFF = 100352, RBL_OFF = 104960, KEYB_OFF = 105472;
constexpr int CMP_ALS_OFF = 65536, CMP_IMP_OFF = 73728;

struct Params { const float* in[N_IN]; float* out; unsigned char* ws; int ph_lo, ph_hi; };

typedef __bf16 bf16x2_t __attribute__((ext_vector_type(2)));
__device__ __forceinline__ unsigned cvt_pk_bf16(float lo, float hi) { const f32x2 v = {lo, hi}; const bf16x2_t b = __builtin_convertvector(v, bf16x2_t); return __builtin_bit_cast(unsigned, b); }
__device__ __forceinline__ float bf2f(bf16_t b) { return __uint_as_float(((unsigned)b) << 16); }
__device__ __forceinline__ float bflo(unsigned w) { return __uint_as_float(w << 16); }
__device__ __forceinline__ float bfhi(unsigned w) { return __uint_as_float(w & 0xffff0000u); }
__device__ __forceinline__ bf16_t f2bf(float f) { return (bf16_t)(cvt_pk_bf16(f, 0.f) & 0xffffu); }
__device__ __forceinline__ float rcp_(float x) { return __builtin_amdgcn_rcpf(x); }
__device__ __forceinline__ float sigmoidf_(float x) { return rcp_(1.f + __expf(-x)); }
__device__ __forceinline__ int rfl(int v) { return __builtin_amdgcn_readfirstlane(v); }
__device__ __forceinline__ int tid_l() { int t = threadIdx.x; asm volatile("" : "+v"(t)); return t; }
extern __shared__ __attribute__((aligned(16))) unsigned char lds_raw[];
__device__ __forceinline__ volatile LAS unsigned* misc_words() { return (volatile LAS unsigned*)((LAS unsigned char*)lds_raw + LDS_MISC); }
__device__ __forceinline__ void park_launch_scalars() {

    if (threadIdx.x == 0) { volatile LAS unsigned* m = misc_words(); const unsigned long long ka = (unsigned long long)__builtin_amdgcn_kernarg_segment_ptr();
        m[4] = (unsigned)ka; m[5] = (unsigned)(ka >> 32); m[6] = blockIdx.x; m[7] = gridDim.x; }
}
__device__ __forceinline__ int bid_l() { return rfl((int)misc_words()[6]); }
__device__ __forceinline__ int gdim_l() { return rfl((int)misc_words()[7]); }
typedef const __attribute__((address_space(4))) Params* KParams;
__device__ __forceinline__ Params load_params() { Params r;
#if defined(__HIP_DEVICE_COMPILE__)
    volatile LAS unsigned* m = misc_words();
    const unsigned lo_ = (unsigned)rfl((int)m[4]), hi_ = (unsigned)rfl((int)m[5]);
    KParams k = (KParams)(((unsigned long long)hi_ << 32) | lo_); asm volatile("" : "+s"(k));
#pragma unroll
    for (int i = 0; i < N_IN; ++i) r.in[i] = k->in[i];
    r.out = k->out; r.ws = k->ws; r.ph_lo = k->ph_lo; r.ph_hi = k->ph_hi;
#endif
    return r; }
__device__ __forceinline__ float keep_or_ninf(float x, int keep) { const unsigned m = (unsigned)(keep >> 31); return __uint_as_float((__float_as_uint(x) & ~m) | (0xff800000u & m)); }

__device__ __forceinline__ int gdim_l();
#define XB_TMO      128
#define XB_XCNT(j)  (256  + 64 * (j))
#define XB_XSUB(j)  (1280 + 64 * (j))
#define XB_XGEN(j)  (2304 + 64 * (j))
#define XB_TOP      3328
#define XB_TOPGEN   3392
#define XCD_BAR_WORDS 3456
#define XB_SPIN_CAP (1u << 23)
__device__ __forceinline__ unsigned xb_ld(unsigned* p)              { return __hip_atomic_load(p, __ATOMIC_RELAXED, __HIP_MEMORY_SCOPE_AGENT); }
__device__ __forceinline__ unsigned xb_add(unsigned* p, unsigned v) { return __hip_atomic_fetch_add(p, v, __ATOMIC_RELAXED, __HIP_MEMORY_SCOPE_AGENT); }
__device__ __forceinline__ unsigned xb_xcc_id() { return (unsigned)__builtin_amdgcn_s_getreg((3 << 11) | 20) & 0xFu; }
#define XB_SPIN(cond, bar) do { unsigned _sp = 0; while (cond) { __builtin_amdgcn_s_sleep(1); \
    if ((++_sp & 255u) == 0u) { if (xb_ld(&(bar)[XB_TMO])) break; if (_sp > XB_SPIN_CAP) { atomicAdd(&(bar)[XB_TMO], 1u); break; } } } } while (0)
struct XcdBarrier { unsigned* bar; unsigned x; volatile LAS unsigned* st; };
__device__ __forceinline__ XcdBarrier xcd_barrier_post(unsigned* bar, volatile LAS unsigned* st) {
    XcdBarrier b; b.bar = bar; b.x = xb_xcc_id(); b.st = st;
    if (threadIdx.x == 0) (void)xb_add(&bar[XB_XCNT(b.x)], 1u);
    return b;
}
__device__ __forceinline__ void xcd_barrier_complete(unsigned* bar, unsigned x, unsigned& nloc, unsigned& nx) {
    const unsigned G = (unsigned)gdim_l();
    unsigned sum, cnt, mine, sp = 0u;
    for (;;) {
        sum = 0u; cnt = 0u; mine = 0u;
#pragma unroll
        for (unsigned j = 0; j < 16; ++j) { const unsigned c = xb_ld(&bar[XB_XCNT(j)]); sum += c; cnt += (c > 0u) ? 1u : 0u; mine = (j == x) ? c : mine; }
        if (sum == G) break;
        __builtin_amdgcn_s_sleep(1);
        if ((++sp & 255u) == 0u) { if (xb_ld(&bar[XB_TMO])) break; if (sp > XB_SPIN_CAP) { atomicAdd(&bar[XB_TMO], 1u); break; } }
    }
    nloc = mine > 0u ? mine : 1u; nx = cnt > 0u ? cnt : 1u;
}
__device__ __forceinline__ void xcd_barrier(const XcdBarrier& b) {
    asm volatile("s_waitcnt vmcnt(0)" ::: "memory");
    __syncthreads();
    if (threadIdx.x == 0) {
        unsigned* bar = b.bar; asm volatile("" : "+s"(bar));
        __builtin_amdgcn_s_waitcnt(0);
        unsigned nloc = b.st[0], nx = b.st[1];
        unsigned bx = b.x; asm volatile("" : "+s"(bx));
        if (nloc == 0u) { xcd_barrier_complete(bar, bx, nloc, nx); b.st[0] = nloc; b.st[1] = nx; }
        const unsigned old = xb_add(&bar[XB_XSUB(bx)], 1u);
        const unsigned gen = old / nloc;
        if (old + 1u == (gen + 1u) * nloc) {
            __builtin_amdgcn_fence(__ATOMIC_RELEASE, "agent");
            asm volatile("s_waitcnt vmcnt(0)" ::: "memory");
            const unsigned og = xb_add(&bar[XB_TOP], 1u);
            const unsigned tg = og / nx;
            if (og + 1u == (tg + 1u) * nx) xb_add(&bar[XB_TOPGEN], 1u);
            else XB_SPIN(xb_ld(&bar[XB_TOPGEN]) == tg, bar);
            __builtin_amdgcn_fence(__ATOMIC_ACQUIRE, "agent");
            xb_add(&bar[XB_XGEN(bx)], 1u);
            asm volatile("s_waitcnt vmcnt(0)" ::: "memory");
        } else {
            XB_SPIN(xb_ld(&bar[XB_XGEN(bx)]) == gen, bar);
            __builtin_amdgcn_fence(__ATOMIC_ACQUIRE, "agent");
            asm volatile("s_waitcnt vmcnt(0)" ::: "memory");
        }
    }
    __syncthreads();
}

__device__ __forceinline__ int t5_bucket(int dist) {
    dist = dist < 0 ? 0 : dist;
    const int big = 16 + (dist >= 22) + (dist >= 30) + (dist >= 40) + (dist >= 54) + (dist >= 73) + (dist >= 99) + (dist >= 134) + (dist >= 182)
                  + (dist >= 246) + (dist >= 332) + (dist >= 450) + (dist >= 609) + (dist >= 825) + (dist >= 1117) + (dist >= 1513);
    return dist < 16 ? dist : big;
}
constexpr int PT_WIN = 0, PT_BR = PT_WIN + 2 * 32 * 128, PT_OUT = PT_BR + 2 * 40 * 16, PT_FU = PT_OUT + 2 * 32 * 16, PT_FD = PT_FU + 32 * 88,
              PT_MU = PT_FD + 88 * 16, PT_MD = PT_MU + 8 * 16 * 112, PT_C1 = PT_MD + 8 * 56 * 16, PT_C2 = PT_C1 + 4 * 64 * 2, PT_END = PT_C2 + 4 * 4;

__device__ __forceinline__ void prep_decode(const Params& p, int id, const float*& s, int& ld_s, bf16_t*& d, int& ld_d, int& nk, const float*& gk) {
    nk = 64; gk = nullptr;
    unsigned char* ws = p.ws;
    if (id < PT_BR) { const int l = id / 4096, q_ = id % 4096, r = (q_ & 255) | ((q_ >> 9) << 8), kt = (r / 128) * 2 + ((q_ >> 8) & 1), nt = r % 128;     const int n = nt * 128, sc = n + (n < 3072 ? 0 : (n < 10240 ? 8 : 32));
        s = p.in[IN_WIN] + (size_t)l * 2048 * D_IN + (size_t)(kt * 64) * D_IN + sc; ld_s = D_IN;
        if ((MK_FUSE_N1) && l == 1) gk = p.in[IN_NMIX] + 2048 + kt * 64;
        if (n < PC_MERGE) { d = (bf16_t*)(ws + WS_WIN + l * SZ_WIN) + (size_t)n * 2048 + kt * 64; ld_d = 2048; }
        else { d = (bf16_t*)(ws + WS_WIN + l * SZ_WIN + (size_t)PC_MERGE * 4096 + (size_t)(n - PC_MERGE) * 2048 + kt * 64); ld_d = -2048; }
        return; }
    if (id < PT_OUT) { id -= PT_BR; const int l = id / 640, r = id % 640, kt = r / 16, nt = r % 16;
        const float* src = kt < 16 ? p.in[IN_WBA] + (size_t)l * 1024 * 2048 + (size_t)(kt * 64) * 2048
                         : kt < 24 ? p.in[IN_WBB] + (size_t)l * 512 * 2048 + (size_t)((kt - 16) * 64) * 2048
                                   : p.in[IN_WBC] + (size_t)l * 1024 * 2048 + (size_t)((kt - 24) * 64) * 2048;
        s = src + nt * 128; ld_s = 2048; d = (bf16_t*)(ws + WS_WBR + l * SZ_WBR) + (size_t)(nt * 128) * 2560 + kt * 64; ld_d = 2560; return; }
    if (id < PT_FU) { id -= PT_OUT; const int l = id / 512, r = id % 512, kt = r / 16, nt = r % 16;
        s = p.in[IN_WOUT] + (size_t)l * 2048 * 2048 + (size_t)(kt * 64) * 2048 + nt * 128; ld_s = 2048; d = (bf16_t*)(ws + WS_WOUT + l * SZ_WOUT) + (size_t)(nt * 128) * 2048 + kt * 64; ld_d = 2048; return; }
    if (id < PT_FD) { id -= PT_FU; const int kt = id / 88, nt = id % 88;
        s = ((nt & 1) ? p.in[IN_FU] : p.in[IN_FG]) + (size_t)(kt * 64) * DFF + (nt >> 1) * 128; ld_s = DFF;
        if (MK_FUSE_N2) gk = p.in[IN_NFFN] + kt * 64;
        if (MK_FFN_F8 & 1) { d = (bf16_t*)(ws + WS_WFU + (size_t)(nt * 128) * 2048 + kt * 64); ld_d = -2048; } else { d = (bf16_t*)(ws + WS_WFU) + (size_t)(nt * 128) * 2048 + kt * 64; ld_d = 2048; } return; }
    if (id < PT_MU) { id -= PT_FD; const int kt = id / 16, nt = id % 16;
        s = p.in[IN_FD] + (size_t)(kt * 64) * 2048 + nt * 128; ld_s = 2048;
        if (MK_FFN_F8 & 2) { d = (bf16_t*)(ws + WS_WFD + (size_t)(nt * 128) * DFF + kt * 64); ld_d = -DFF; } else { d = (bf16_t*)(ws + WS_WFD) + (size_t)(nt * 128) * DFF + kt * 64; ld_d = DFF; } return; }
    if (id < PT_MD) { id -= PT_MU; const int e = id / 1792, r = id % 1792, kh = r / 112, nt = r % 112; nk = 128;
        s = ((nt & 1) ? p.in[IN_MU] : p.in[IN_MG]) + (size_t)e * 2048 * DFFE + (size_t)(kh * 128) * DFFE + (nt >> 1) * 128; ld_s = DFFE;
        if (MK_FUSE_N2) gk = p.in[IN_NFFN] + 2048 + kh * 128;
        d = (bf16_t*)(ws + WS_WMU + e * (SZ_WMU1 / 2) + (size_t)(nt * 128) * 2048 + kh * 128); ld_d = -2048; return; }
    if (id < PT_C1) { id -= PT_MD; const int e = id / 896, r = id % 896, kh = r / 16, nt = r % 16; nk = 128;
        s = p.in[IN_MD] + (size_t)e * DFFE * 2048 + (size_t)(kh * 128) * 2048 + nt * 128; ld_s = 2048; d = (bf16_t*)(ws + WS_WMD + e * (SZ_WMD1 / 2) + (size_t)(nt * 128) * DFFE + kh * 128); ld_d = -DFFE; return; }
    if (id < PT_C2) { id -= PT_C1; const int j = id / 128, r = id % 128, kt = r / 2, nt = r % 2; const int l = j >> 1, kv = j & 1;
        s = p.in[kv ? IN_W1V : IN_W1K] + (size_t)l * 4096 * 256 + (size_t)(kt * 64) * 256 + nt * 128; ld_s = 256; d = (bf16_t*)(ws + WS_WC1 + j * SZ_WC1) + (size_t)(nt * 128) * 4096 + kt * 64; ld_d = 4096; return; }
    { id -= PT_C2; const int j = id / 4, kt = id % 4; const int l = j >> 1, kv = j & 1;
        s = p.in[kv ? IN_W2V : IN_W2K] + (size_t)l * 256 * 128 + (size_t)(kt * 64) * 128; ld_s = 128; d = (bf16_t*)(ws + WS_WC2 + j * SZ_WC2) + kt * 64; ld_d = 256; return; }
}

typedef int i32x8 __attribute__((ext_vector_type(8)));
#if MK_FP8PROBE
__device__ __forceinline__ void fp8_probe(const Params& p) {
    if (bid_l() != 0 || tid_l() >= 64) return;
    const int l = tid_l() & 63, i = l & 15, q = l >> 4;
    i32x8 A, B;
#pragma unroll
    for (int w = 0; w < 8; ++w) { int aw = 0, bw = 0;
#define HALF_(h) { const int pp = w * 4 + h * 2, k0 = 32 * q + pp, k1 = k0 + 1; \
            const float a0 = ((k0 & 15) == i) ? 1.f : 0.f, a1 = ((k1 & 15) == i) ? 1.f : 0.f; \
            const float b0 = ((k0 >> 4) == (i & 7)) ? (float)((k0 & 15) + 1) : 0.f, b1 = ((k1 >> 4) == (i & 7)) ? (float)((k1 & 15) + 1) : 0.f; \
            aw = __builtin_amdgcn_cvt_pk_fp8_f32(a0, a1, aw, h); bw = __builtin_amdgcn_cvt_pk_fp8_f32(b0, b1, bw, h); }
        HALF_(0) HALF_(1)
#undef HALF_
        A[w] = aw; B[w] = bw; }
    const f32x4 c = {0.f, 0.f, 0.f, 0.f};
    const f32x4 d0 = __builtin_amdgcn_mfma_scale_f32_16x16x128_f8f6f4(A, B, c, 0, 0, 0, 0, 0, 0);
    const f32x4 d1 = __builtin_amdgcn_mfma_scale_f32_16x16x128_f8f6f4(A, B, c, 0, 0, 0, 0x7f7f7f7f, 0, 0x7f7f7f7f);
    bool ok0 = true, ok1 = true;
#pragma unroll
    for (int r = 0; r < 4; ++r) { const float e = (float)(4 * q + r + 1); ok0 = ok0 && (d0[r] == e); ok1 = ok1 && (d1[r] == e); }
    const unsigned long long m0 = __ballot(ok0), m1 = __ballot(ok1);
    if (l == 0) { unsigned* ctl = (unsigned*)(p.ws + WS_CTL); ctl[CW_DBG + 8] = (m0 == ~0ull) ? 1u : 0u; ctl[CW_DBG + 9] = (m1 == ~0ull) ? 1u : 0u; }
}
#endif
#ifndef MK_PREP_NTLD
#define MK_PREP_NTLD 0
#endif
#if MK_PREP_NTLD
#define PREP_LD(ptr) __builtin_nontemporal_load(ptr)
#else
#define PREP_LD(ptr) (*(ptr))
#endif
#ifndef MK_PREP_NT
#define MK_PREP_NT 3
#endif
#if MK_PREP_NT & 1
#define PREP_ST(ptr, v) __builtin_nontemporal_store(v, ptr)
#else
#define PREP_ST(ptr, v) (*(ptr) = (v))
#endif
#if MK_PREP_NT & 2
#define PREP_ST_HALF(ptr, v) __builtin_nontemporal_store(v, ptr)
#else
#define PREP_ST_HALF(ptr, v) (*(ptr) = (v))
#endif
__device__ __forceinline__ void phase_prep(const Params& p, LAS unsigned char* lds, const bool nostore = false) {
#if MK_FP8PROBE
    fp8_probe(p);
#endif
    const int tid = tid_l(), G = gdim_l();
    LAS float* sm = (LAS float*)lds;
    const int lk = tid >> 5, ln = (tid & 31) * 4;
    f32x4 v[8];
    const float* s; int ld_s; bf16_t* d; int ld_d; int nk; const float* gk;
    int id = bid_l();
    float gs[8];
    if (id < PT_END) { prep_decode(p, id, s, ld_s, d, ld_d, nk, gk);
#pragma unroll
        for (int i = 0; i < 8; ++i) if (i < 4 || nk == 128) v[i] = PREP_LD((const f32x4*)(s + (size_t)(lk + 16 * i) * ld_s + ln));
#pragma unroll
        for (int i = 0; i < 8; ++i) gs[i] = (gk && (i < 4 || nk == 128)) ? gk[lk + 16 * i] : 1.f; }
    for (; id < PT_END; id += G) {
        bf16_t* dcur = d; const int ldc = ld_d; const bool big = nk == 128;
#pragma unroll
        for (int i = 0; i < 8; ++i) if (i < 4 || big) v[i] = v[i] * gs[i];
        { const int sh = (ldc > 0 || big) ? 3 : 4;
#pragma unroll
          for (int i = 0; i < 8; ++i) if (i < 4 || big) *(LAS f32x4*)(sm + (lk + 16 * i) * 132 + (ln ^ (i << sh))) = v[i]; }
        const int nid = id + G;
        if (nid < PT_END) { prep_decode(p, nid, s, ld_s, d, ld_d, nk, gk);
#pragma unroll
            for (int i = 0; i < 8; ++i) if (i < 4 || nk == 128) v[i] = PREP_LD((const f32x4*)(s + (size_t)(lk + 16 * i) * ld_s + ln));
#pragma unroll
            for (int i = 0; i < 8; ++i) gs[i] = (gk && (i < 4 || nk == 128)) ? gk[lk + 16 * i] : 1.f; }
        __syncthreads();
        if (nostore && dcur != nullptr) {} else
        if (ldc > 0) { const int kc = tid & 7;
#pragma unroll
            for (int ps = 0; ps < 2; ++ps) { const int n = (tid >> 3) + 64 * ps; LAS const float* sp = sm + (8 * kc) * 132 + (n ^ ((kc >> 1) << 3)); unsigned w[4];
#pragma unroll
                for (int j = 0; j < 4; ++j) w[j] = cvt_pk_bf16(sp[(2 * j) * 132], sp[(2 * j + 1) * 132]);
                PREP_ST((u32x4*)(dcur + (size_t)n * ldc + 8 * kc), ((u32x4){w[0], w[1], w[2], w[3]})); } }
        else if (big) { const int kc = tid & 7;
#pragma unroll
            for (int ps = 0; ps < 2; ++ps) { const int n = (tid >> 3) + 64 * ps; LAS const float* sp = sm + (16 * kc) * 132 + (n ^ (kc << 3)); int qq[4] = {0, 0, 0, 0};
#pragma unroll
                for (int j = 0; j < 4; ++j) { const unsigned w0 = cvt_pk_bf16(sp[(4 * j) * 132], sp[(4 * j + 1) * 132]), w1 = cvt_pk_bf16(sp[(4 * j + 2) * 132], sp[(4 * j + 3) * 132]);
                    qq[j] = __builtin_amdgcn_cvt_pk_fp8_f32(64.f * bflo(w0), 64.f * bfhi(w0), qq[j], false); qq[j] = __builtin_amdgcn_cvt_pk_fp8_f32(64.f * bflo(w1), 64.f * bfhi(w1), qq[j], true); }
                PREP_ST((u32x4*)((unsigned char*)dcur + (size_t)n * (size_t)(-ldc) + 16 * kc), ((u32x4){(unsigned)qq[0], (unsigned)qq[1], (unsigned)qq[2], (unsigned)qq[3]})); } }
        else { const int kc = tid & 3, n = tid >> 2; LAS const float* sp = sm + (16 * kc) * 132 + (n ^ (kc << 4)); int qq[4] = {0, 0, 0, 0};
#pragma unroll
            for (int j = 0; j < 4; ++j) { const unsigned w0 = cvt_pk_bf16(sp[(4 * j) * 132], sp[(4 * j + 1) * 132]), w1 = cvt_pk_bf16(sp[(4 * j + 2) * 132], sp[(4 * j + 3) * 132]);
                qq[j] = __builtin_amdgcn_cvt_pk_fp8_f32(64.f * bflo(w0), 64.f * bfhi(w0), qq[j], false); qq[j] = __builtin_amdgcn_cvt_pk_fp8_f32(64.f * bflo(w1), 64.f * bfhi(w1), qq[j], true); }
            PREP_ST_HALF((u32x4*)((unsigned char*)dcur + (size_t)n * (size_t)(-ldc) + 16 * kc), ((u32x4){(unsigned)qq[0], (unsigned)qq[1], (unsigned)qq[2], (unsigned)qq[3]})); }
        __syncthreads();
    }
    const int gt = bid_l() * 512 + tid;
    for (int i = gt; i < 2 * 32 * 2048; i += G * 512) { const int l = i >> 16, r = (i >> 11) & 31, k = i & 2047; const int sc = r < 8 ? 3072 + r : 10248 + (r - 8);
        const float gsc_ = ((MK_FUSE_N1) && l == 1) ? p.in[IN_NMIX][2048 + k] : 1.f;
        ((bf16_t*)(p.ws + WS_WG32))[i] = f2bf(gsc_ * p.in[IN_WIN][(size_t)l * 2048 * D_IN + (size_t)k * D_IN + sc]); }
    { const int wv = gt >> 6, lane = tid & 63;
      if (wv < 1024) { const int j = wv >> 8, n = wv & 255, l = j >> 1, kv = j & 1;
        const float* pe = p.in[kv ? IN_PEV : IN_PEK] + (size_t)l * 4096; const float* w1 = p.in[kv ? IN_W1V : IN_W1K] + (size_t)l * 4096 * 256 + n;
        float a = 0.f; for (int k = lane; k < 4096; k += 64) a += pe[k] * w1[(size_t)k * 256];
        for (int o = 32; o >= 1; o >>= 1) a += __shfl_xor(a, o);
        if (lane == 0) ((float*)(p.ws + WS_CB1))[wv] = a; } }
}

template <bool ROUTE, bool F8OUT, bool XB16>
__device__ __forceinline__ void phase_norm(const Params& p, const void* x, const float* g, bf16_t* h, LAS unsigned char* lds) {
    const int tid = tid_l(), wid = tid >> 6, lane = tid & 63;
    LAS int* cnt = (LAS int*)lds;
    if (ROUTE) { if (tid < 8) cnt[tid] = 0; __syncthreads(); }
    const unsigned vo16 = (unsigned)lane * 16u, vo128 = (unsigned)lane * 128u;
    for (int rb0 = bid_l(); rb0 < T / 64; rb0 += gdim_l()) {
        const int rb = (gdim_l() == 256) ? ((rb0 & 7) * 32 + (rb0 >> 3)) : rb0;
        if constexpr (!XB16 && (MK_FUSE_N2)) { if (tid < 64) { ((unsigned*)(p.ws + WS_SS))[rb * 64 + tid] = 0u; ((unsigned*)(p.ws + WS_SS1))[rb * 64 + tid] = 0u; } }
        f32x4 vn[8]; u32x2 vb[8];
        { const size_t r0_ = (size_t)(rb * 64 + wid * 8);
#pragma unroll
          for (int j = 0; j < 8; ++j) { if constexpr (XB16) vb[j] = *(const u32x2*)((const char*)x + r0_ * 4096 + j * 512 + lane * 8); else vn[j] = *(const f32x4*)((const char*)x + r0_ * 8192 + j * 1024 + vo16); } }
#pragma unroll 1
        for (int i = 0; i < 8; ++i) {
            const int row = rb * 64 + wid * 8 + i;
            f32x4 v[8]; float ss = 0.f;
#pragma unroll
            for (int j = 0; j < 8; ++j) { if constexpr (XB16) v[j] = (f32x4){bflo(vb[j].x), bfhi(vb[j].x), bflo(vb[j].y), bfhi(vb[j].y)}; else v[j] = vn[j];
                ss += v[j][0] * v[j][0] + v[j][1] * v[j][1] + v[j][2] * v[j][2] + v[j][3] * v[j][3]; }
            if (i < 7) { const size_t r1_ = (size_t)(row + 1);
#pragma unroll
                for (int j = 0; j < 8; ++j) { if constexpr (XB16) vb[j] = *(const u32x2*)((const char*)x + r1_ * 4096 + j * 512 + lane * 8); else vn[j] = *(const f32x4*)((const char*)x + r1_ * 8192 + j * 1024 + vo16); } }
            for (int o = 32; o >= 1; o >>= 1) ss += __shfl_xor(ss, o);
            const float inv = rsqrtf(ss * (1.0f / 2048.0f) + RMS_EPS);
            float lg[8] = {0.f, 0.f, 0.f, 0.f, 0.f, 0.f, 0.f, 0.f};
#pragma unroll
            for (int j = 0; j < 8; ++j) { const f32x4 gv = *(const f32x4*)((const char*)g + j * 1024 + vo16); const f32x4 y = v[j] * inv * gv;
                u32x2 w; w.x = cvt_pk_bf16(y[0], y[1]); w.y = cvt_pk_bf16(y[2], y[3]);
                if (!(ROUTE && (MK_FUSE_N2))) *(u32x2*)(h + (size_t)row * 2048 + (lane + 64 * j) * 4) = w;
                if (F8OUT) { int q8 = 0; q8 = __builtin_amdgcn_cvt_pk_fp8_f32(4.f * y[0], 4.f * y[1], q8, false); q8 = __builtin_amdgcn_cvt_pk_fp8_f32(4.f * y[2], 4.f * y[3], q8, true);
                    *(int*)(p.ws + WS_H8 + (size_t)row * 2048 + (lane + 64 * j) * 4) = q8; }
                if (ROUTE) { const char* rw = (const char*)p.in[IN_ROUTER] + j * 8192;
#pragma unroll
                    for (int q = 0; q < 4; ++q) { const f32x4 a = *(const f32x4*)(rw + vo128 + q * 32), b = *(const f32x4*)(rw + vo128 + q * 32 + 16);
                        lg[0] += y[q] * a[0]; lg[1] += y[q] * a[1]; lg[2] += y[q] * a[2]; lg[3] += y[q] * a[3];
                        lg[4] += y[q] * b[0]; lg[5] += y[q] * b[1]; lg[6] += y[q] * b[2]; lg[7] += y[q] * b[3]; }
                    asm volatile("" ::: "memory"); } }
            if (ROUTE) {
#pragma unroll
                for (int e = 0; e < 8; ++e) for (int o = 32; o >= 1; o >>= 1) lg[e] += __shfl_xor(lg[e], o);
                if (lane == 0) {
                    if (MK_FUSE_N2) ((float*)(p.ws + WS_SS))[row] = inv;
                    int e0 = 0; float v0 = lg[0];
#pragma unroll
                    for (int e = 1; e < 8; ++e) if (lg[e] > v0) { v0 = lg[e]; e0 = e; }
                    int e1 = -1; float v1 = -__builtin_inff();
#pragma unroll
                    for (int e = 0; e < 8; ++e) if (e != e0 && lg[e] > v1) { v1 = lg[e]; e1 = e; }
                    const float w0 = 1.f / (1.f + expf(v1 - v0)), w1 = 1.f - w0;
                    int* toke = (int*)(p.ws + WS_ROUTE); float* tokw = (float*)(p.ws + WS_ROUTE + (size_t)T * 8);
                    toke[row * 2] = e0; toke[row * 2 + 1] = e1; tokw[row * 2] = w0; tokw[row * 2 + 1] = w1;
                    atomicAdd((int*)&cnt[e0], 1); atomicAdd((int*)&cnt[e1], 1);
                }
            }
        }
        if (ROUTE) { __syncthreads(); if (tid < 8) { ((int*)(p.ws + WS_CTL))[CW_CNT + rb * 8 + tid] = cnt[tid]; cnt[tid] = 0; } __syncthreads(); }
    }
}

__device__ __forceinline__ void phase_final(const Params& p, const float* g, float* dst) {
    const int tid = tid_l(), wid = tid >> 6, lane = tid & 63;
    const int* slot = (const int*)(p.ws + WS_ROUTE + (size_t)T * 16);
    const bf16_t* om = (const bf16_t*)(p.ws + WS_HG);
    for (int rb0 = bid_l(); rb0 < T / 64; rb0 += gdim_l()) {
        const int rb = (gdim_l() == 256) ? ((rb0 & 7) * 32 + (rb0 >> 3)) : rb0;
        const int myslot = lane < 16 ? slot[(rb * 64 + wid * 8) * 2 + lane] : 0;
#pragma unroll 1
        for (int i = 0; i < 8; ++i) {
            const int row = rb * 64 + wid * 8 + i;
            const int s0 = __shfl(myslot, 2 * i), s1 = __shfl(myslot, 2 * i + 1);
            const u32x4* xr = (const u32x4*)((const bf16_t*)(p.ws + WS_XB) + (size_t)row * 2048);
            const u32x4* o0 = (const u32x4*)(om + (size_t)s0 * 2048); const u32x4* o1 = (const u32x4*)(om + (size_t)s1 * 2048);
            f32x4 v[4][2]; u32x4 a[4], b[4], xw[4];
            const unsigned* tmap = (const unsigned*)(p.ws + WS_CTL) + CW_TMAP; const bf16_t* part = (const bf16_t*)(p.ws + WS_OMPART);
            unsigned tm0[4], tm1[4];
#pragma unroll
            for (int j = 0; j < 4; ++j) { const int pn = 2 * j + (lane >> 5); tm0[j] = tmap[(s0 >> 8) * 8 + pn]; tm1[j] = tmap[(s1 >> 8) * 8 + pn]; }
#pragma unroll
            for (int j = 0; j < 4; ++j) { xw[j] = xr[lane + 64 * j]; a[j] = o0[lane + 64 * j]; b[j] = o1[lane + 64 * j]; }
#pragma unroll
            for (int j = 0; j < 4; ++j) {
                if (tm0[j]) { const bf16_t* pp = part + ((size_t)(tm0[j] - 1) * 256 + (s0 & 255)) * 256 + (lane & 31) * 8; float s_[8] = {0.f, 0.f, 0.f, 0.f, 0.f, 0.f, 0.f, 0.f};
#pragma unroll
                    for (int ks = 0; ks < 4; ++ks) { const u32x4 w = *(const u32x4*)(pp + (size_t)ks * 64 * 65536);
                        s_[0] += bflo(w.x); s_[1] += bfhi(w.x); s_[2] += bflo(w.y); s_[3] += bfhi(w.y); s_[4] += bflo(w.z); s_[5] += bfhi(w.z); s_[6] += bflo(w.w); s_[7] += bfhi(w.w); }
                    a[j] = (u32x4){cvt_pk_bf16(s_[0], s_[1]), cvt_pk_bf16(s_[2], s_[3]), cvt_pk_bf16(s_[4], s_[5]), cvt_pk_bf16(s_[6], s_[7])}; }
                if (tm1[j]) { const bf16_t* pp = part + ((size_t)(tm1[j] - 1) * 256 + (s1 & 255)) * 256 + (lane & 31) * 8; float s_[8] = {0.f, 0.f, 0.f, 0.f, 0.f, 0.f, 0.f, 0.f};
#pragma unroll
                    for (int ks = 0; ks < 4; ++ks) { const u32x4 w = *(const u32x4*)(pp + (size_t)ks * 64 * 65536);
                        s_[0] += bflo(w.x); s_[1] += bfhi(w.x); s_[2] += bflo(w.y); s_[3] += bfhi(w.y); s_[4] += bflo(w.z); s_[5] += bfhi(w.z); s_[6] += bflo(w.w); s_[7] += bfhi(w.w); }
                    b[j] = (u32x4){cvt_pk_bf16(s_[0], s_[1]), cvt_pk_bf16(s_[2], s_[3]), cvt_pk_bf16(s_[4], s_[5]), cvt_pk_bf16(s_[6], s_[7])}; } }
#pragma unroll
            for (int j = 0; j < 4; ++j) { v[j][0] = (f32x4){bflo(xw[j].x), bfhi(xw[j].x), bflo(xw[j].y), bfhi(xw[j].y)}; v[j][1] = (f32x4){bflo(xw[j].z), bfhi(xw[j].z), bflo(xw[j].w), bfhi(xw[j].w)}; }
            float ss = 0.f;
#pragma unroll
            for (int j = 0; j < 4; ++j) {
                v[j][0][0] += bflo(a[j][0]) + bflo(b[j][0]); v[j][0][1] += bfhi(a[j][0]) + bfhi(b[j][0]); v[j][0][2] += bflo(a[j][1]) + bflo(b[j][1]); v[j][0][3] += bfhi(a[j][1]) + bfhi(b[j][1]);
                v[j][1][0] += bflo(a[j][2]) + bflo(b[j][2]); v[j][1][1] += bfhi(a[j][2]) + bfhi(b[j][2]); v[j][1][2] += bflo(a[j][3]) + bflo(b[j][3]); v[j][1][3] += bfhi(a[j][3]) + bfhi(b[j][3]);
#pragma unroll
                for (int q = 0; q < 2; ++q) ss += v[j][q][0] * v[j][q][0] + v[j][q][1] * v[j][q][1] + v[j][q][2] * v[j][q][2] + v[j][q][3] * v[j][q][3]; }
            for (int o = 32; o >= 1; o >>= 1) ss += __shfl_xor(ss, o);
            const float inv = rsqrtf(ss * (1.0f / 2048.0f) + RMS_EPS);
#pragma unroll
            for (int j = 0; j < 4; ++j)
#pragma unroll
                for (int q = 0; q < 2; ++q) ((f32x4*)(dst + (size_t)row * 2048))[(lane + 64 * j) * 2 + q] = v[j][q] * inv * ((const f32x4*)g)[(lane + 64 * j) * 2 + q];
        }
    }
}

__device__ __forceinline__ void moe_offsets(const Params& p, LAS int* sm  , int& nrt) {
    const int tid = tid_l();
    const int* cnt = (const int*)(p.ws + WS_CTL) + CW_CNT;
    for (int i = tid; i < 2048; i += 512) sm[i] = cnt[i];
    __syncthreads();
    if (tid < 8) { int s = 0; for (int c = 0; c < 256; ++c) s += sm[c * 8 + tid]; sm[2048 + tid] = s; }
    __syncthreads();
    if (tid == 0) { int off = 0; for (int e = 0; e < 8; ++e) { sm[2056 + e] = off; off += (sm[2048 + e] + 255) & ~255; } sm[2064] = off; }
    __syncthreads();
    nrt = sm[2064] >> 8;
}
__device__ __forceinline__ void phase_moe_scatter(const Params& p, LAS unsigned char* lds) {
    const int tid = tid_l(), wid = tid >> 6, lane = tid & 63;
    LAS int* sm = (LAS int*)lds; int nrt; moe_offsets(p, sm, nrt);
    const int* toke = (const int*)(p.ws + WS_ROUTE); const float* tokw = (const float*)(p.ws + WS_ROUTE + (size_t)T * 8);
    int* slot = (int*)(p.ws + WS_ROUTE + (size_t)T * 16); float* roww = (float*)(p.ws + WS_ROUTE + (size_t)T * 24);
    const bf16_t* h2 = (const bf16_t*)(p.ws + ((MK_FUSE_N2) ? WS_XB : WS_H)); bf16_t* hg = (bf16_t*)(p.ws + WS_HG); const float* invs = (const float*)(p.ws + WS_SS);
    LAS int* ls = sm + 2080;
    for (int c = bid_l(); c < 256; c += gdim_l()) {
        LAS int* le = ls + 128; LAS float* lw = (LAS float*)(ls + 256);
        if (tid < 128) { le[tid] = toke[c * 128 + tid]; lw[tid] = tokw[c * 128 + tid]; }
        __syncthreads();
        if (tid < 8) { const int e = tid; int base = sm[2056 + e]; for (int cc = 0; cc < c; ++cc) base += sm[cc * 8 + e];
            for (int r = 0; r < 128; ++r) if (le[r] == e) { ls[r] = base; ++base; } }
        __syncthreads();
        if (tid < 128) { const int s = ls[tid]; slot[c * 128 + tid] = s; roww[s] = lw[tid]; }
#pragma unroll 1
        for (int tb = 0; tb < 8; tb += 4) {
            u32x4 a[4][2], b2[4][2];
#pragma unroll
            for (int q = 0; q < 4; ++q) { const int tok = c * 64 + wid + 8 * (tb + q); const u32x4* src = (const u32x4*)(h2 + (size_t)tok * 2048);
#pragma unroll
                for (int j = 0; j < 2; ++j) { a[q][j] = src[2 * lane + 128 * j]; b2[q][j] = src[2 * lane + 1 + 128 * j]; } }
#pragma unroll
            for (int q = 0; q < 4; ++q) { const int tl = wid + 8 * (tb + q); const int s0 = ls[2 * tl], s1 = ls[2 * tl + 1]; const float f4 = (MK_FUSE_N2) ? 4.f * invs[c * 64 + tl] : 4.f;
                u32x4* d0 = (u32x4*)((unsigned char*)hg + (size_t)s0 * 2048); u32x4* d1 = (u32x4*)((unsigned char*)hg + (size_t)s1 * 2048);
#pragma unroll
                for (int j = 0; j < 2; ++j) { const u32x4 x = a[q][j], y = b2[q][j]; int w[4] = {0, 0, 0, 0};
                    w[0] = __builtin_amdgcn_cvt_pk_fp8_f32(f4 * bflo(x[0]), f4 * bfhi(x[0]), w[0], false); w[0] = __builtin_amdgcn_cvt_pk_fp8_f32(f4 * bflo(x[1]), f4 * bfhi(x[1]), w[0], true);
                    w[1] = __builtin_amdgcn_cvt_pk_fp8_f32(f4 * bflo(x[2]), f4 * bfhi(x[2]), w[1], false); w[1] = __builtin_amdgcn_cvt_pk_fp8_f32(f4 * bflo(x[3]), f4 * bfhi(x[3]), w[1], true);
                    w[2] = __builtin_amdgcn_cvt_pk_fp8_f32(f4 * bflo(y[0]), f4 * bfhi(y[0]), w[2], false); w[2] = __builtin_amdgcn_cvt_pk_fp8_f32(f4 * bflo(y[1]), f4 * bfhi(y[1]), w[2], true);
                    w[3] = __builtin_amdgcn_cvt_pk_fp8_f32(f4 * bflo(y[2]), f4 * bfhi(y[2]), w[3], false); w[3] = __builtin_amdgcn_cvt_pk_fp8_f32(f4 * bflo(y[3]), f4 * bfhi(y[3]), w[3], true);
                    const u32x4 o = {(unsigned)w[0], (unsigned)w[1], (unsigned)w[2], (unsigned)w[3]};
                    d0[lane + 64 * j] = o; d1[lane + 64 * j] = o; } } }
        __syncthreads();
    }
    if (bid_l() == 0 && tid < 8) { const int e = tid; const int b = sm[2056 + e] + sm[2048 + e], en = sm[2056 + e] + ((sm[2048 + e] + 255) & ~255); for (int r = b; r < en; ++r) roww[r] = 0.f; }
}

__device__ __forceinline__ void phase_fox_cumsum(const Params& p, int layer) {
    const int gw = (bid_l() * 512 + tid_l()) >> 6, lane = tid_l() & 63, nw = (gdim_l() * 512) >> 6;
    const float* gates = (const float*)(p.ws + WS_GATES); float* cneg = (float*)(p.ws + WS_CNEG); float* ctot = (float*)(p.ws + WS_CTOT);
    for (int u = gw; u < 256; u += nw) { const int b = u >> 6, ch = u & 63; const int tok = b * SEQ + ch * 64 + lane;
        const f32x4 f0 = *(const f32x4*)(gates + (size_t)tok * 32), f1 = *(const f32x4*)(gates + (size_t)tok * 32 + 4);
        float x[8] = {f0[0], f0[1], f0[2], f0[3], f1[0], f1[1], f1[2], f1[3]};
#pragma unroll
        for (int hh = 0; hh < 8; ++hh) { const float v = x[hh] + p.in[IN_FOXB][layer * 8 + hh]; float inc = fminf(v, 0.f) - log1pf(expf(-fabsf(v)));
            for (int o = 1; o < 64; o <<= 1) { const float t = __shfl_up(inc, o); if (lane >= o) inc += t; }
            cneg[(size_t)(b * 8 + hh) * SEQ + ch * 64 + lane] = -inc * (1.0f / SM_SCALE);
            if (lane == 63) ctot[(b * 8 + hh) * 64 + ch] = -inc * (1.0f / SM_SCALE); } }
}

__device__ __forceinline__ void phase_gates(const Params& p, int layer) {
    const int gw = (bid_l() * 512 + tid_l()) >> 6, lane = tid_l() & 63, nw = (gdim_l() * 512) >> 6;
    const bool fused = (MK_FUSE_N1) && layer == 1; const unsigned* ss1 = (const unsigned*)(p.ws + WS_SS1);
    const bf16_t* h = (const bf16_t*)(p.ws + (fused ? WS_XB : WS_H)); const bf16_t* w = (const bf16_t*)(p.ws + WS_WG32 + layer * SZ_WG32);
    float* gates = (float*)(p.ws + WS_GATES);
    const int fr = lane & 15, fq = lane >> 4;
    for (int u2 = gw; u2 < T / 8; u2 += nw) { const int u = u2 >> 1, ct = u2 & 1;
        f32x4 a0 = {0.f, 0.f, 0.f, 0.f}, a1 = {0.f, 0.f, 0.f, 0.f};
        const bf16_t* ap = h + (size_t)(u * 16 + fr) * 2048 + fq * 8; const bf16_t* b0 = w + (size_t)(ct * 16 + fr) * 2048 + fq * 8;
#pragma unroll 8
        for (int ks = 0; ks < 64; ks += 2) { const bf16x8 x0 = *(const bf16x8*)(ap + ks * 32), y0 = *(const bf16x8*)(b0 + ks * 32), x1 = *(const bf16x8*)(ap + ks * 32 + 32), y1 = *(const bf16x8*)(b0 + ks * 32 + 32);
            a0 = __builtin_amdgcn_mfma_f32_16x16x32_bf16(x0, y0, a0, 0, 0, 0); a1 = __builtin_amdgcn_mfma_f32_16x16x32_bf16(x1, y1, a1, 0, 0, 0); }
#pragma unroll
        for (int i = 0; i < 4; ++i) { const int row_ = u * 16 + fq * 4 + i; const float iv_ = fused ? rsqrtf((float)ss1[row_] * (1.0f / 4096.0f / 2048.0f) + RMS_EPS) : 1.f;
            gates[(size_t)row_ * 32 + ct * 16 + fr] = (a0[i] + a1[i]) * iv_; }
    }
}
namespace pg8 {
constexpr int BM = 256, BK = 64, HALF = 128, HTB = HALF * BK * 2, STAGE_BYTES = 8 * HTB, NXCD = 8, WGM = 4;
__device__ __forceinline__ int lds_byte(int r, int c) { const int st = (r >> 4) * 2 + (c >> 5), rr = r & 15, cc = c & 31, ob = rr * 64 + cc * 2; return st * 1024 + (ob ^ (((ob >> 9) & 1) << 5)); }
__device__ __forceinline__ void stage_rc(int b, int& R, int& C) { const int st = b / 1024, sb = b % 1024, swz = sb ^ (((sb >> 9) & 1) << 5); R = (st >> 1) * 16 + swz / 64; C = (st & 1) * 32 + (swz % 64) / 2; }
__device__ __forceinline__ int perm32(int rho) { const int n = rho >> 4, i = rho & 15; return 8 * (i >> 2) + 4 * n + (i & 3); }

struct GUnit { size_t aoff, boff; int row0, col0, aux; int nt = 0, sub = 0; };
struct GemmP { const char* A; const char* B; unsigned rsB; size_t ks2A; int nt; };
struct LinRow { unsigned rs; __device__ __forceinline__ unsigned operator()(int R) const { return (unsigned)R * rs; } };

__device__ __forceinline__ bool static_tile_L(long L, int nM, int nN, int& pm, int& pn, int wgm = WGM) {
    const int nwg = nM * nN; if (L >= nwg) return false;
    int wgid = (int)L; { const int q = nwg / NXCD, r = nwg % NXCD, xcd = wgid % NXCD, off = wgid / NXCD; wgid = (xcd < r ? xcd * (q + 1) : r * (q + 1) + (xcd - r) * q) + off; }
    const int nig = wgm * nN, gid = wgid / nig, fm = gid * wgm, gsz = (nM - fm) < wgm ? (nM - fm) : wgm;
    pm = fm + ((wgid % nig) % gsz); pn = (wgid % nig) / gsz; return true;
}
__device__ __forceinline__ bool static_tile(int i, int G, int c, int nM, int nN, int& pm, int& pn, int wgm = WGM) { return static_tile_L((long)i * G + c, nM, nN, pm, pn, wgm); }
struct StaticOrder {
    int nM, nN, G, c; size_t tsA, tsB; int wgm = WGM;
    __device__ __forceinline__ bool next(int i, GUnit& u) const { int pm, pn; if (!static_tile(i, G, c, nM, nN, pm, pn, wgm)) return false;
        u.aoff = (size_t)pm * tsA; u.boff = (size_t)pn * tsB; u.row0 = pm * BM; u.col0 = pn * BM; u.aux = 0; return true; }
};

template <class Epi, class Sched, class RowA>
__device__ __forceinline__ void gemm_phase(LAS unsigned char* lds, const GemmP g, const Sched& S, const Epi& E, const RowA& rowA) {
    const int tid = tid_l(), wid = __builtin_amdgcn_readfirstlane(tid >> 6), lane = tid & 63, wr = wid >> 2, wc = wid & 3, fr = lane & 15, fq = lane >> 4;
    const int nt = g.nt;
    unsigned voffA[2], voffB[2];
#pragma unroll
    for (int i = 0; i < 2; ++i) { int R, C; stage_rc(tid * 16 + i * 8192, R, C); const int Rb = Epi::PERM ? ((R & ~31) + perm32(R & 31)) : R;
        voffA[i] = rowA(R) + (unsigned)C * 2u; voffB[i] = (unsigned)Rb * g.rsB + (unsigned)C * 2u; }
    const size_t hstepA = (size_t)rowA(HALF), hstepB = (size_t)HALF * g.rsB;
    const size_t ks2A = g.ks2A;
    const unsigned ldsw = (unsigned)wid * 1024u;
    const int aoff = lds_byte(wr * 64 + fr, fq * 8), boff = lds_byte(wc * 32 + fr, fq * 8);
#define PG8_SA(b, h) (((b) * 2 + (h)) * HTB)
#define PG8_SB(b, h) ((4 + (b) * 2 + (h)) * HTB)
#define PG8_STAGE(bufoff, gbase, voff) do { const unsigned long long gb_ = (unsigned long long)(gbase); const char* gu_ = (const char*)(((unsigned long long)(unsigned)__builtin_amdgcn_readfirstlane((int)(gb_ >> 32)) << 32) | (unsigned)__builtin_amdgcn_readfirstlane((int)gb_));   \
        _Pragma("unroll") for (int _i = 0; _i < 2; ++_i) \
        __builtin_amdgcn_global_load_lds((const unsigned*)(gu_ + (voff)[_i]), (LAS unsigned*)(lds + (bufoff) + ldsw + _i * 8192), 16, 0, 0); } while (0)
#define PG8_LDA(dst, b, h) do { _Pragma("unroll") for (int m = 0; m < 4; ++m) _Pragma("unroll") for (int k = 0; k < 2; ++k) dst[m][k] = *(const LAS bf16x8*)(lds + PG8_SA(b, h) + aoff + m * 2048 + k * 1024); } while (0)
#define PG8_LDB(dst, b, h) do { _Pragma("unroll") for (int n = 0; n < 2; ++n) _Pragma("unroll") for (int k = 0; k < 2; ++k) dst[n][k] = *(const LAS bf16x8*)(lds + PG8_SB(b, h) + boff + n * 2048 + k * 1024); } while (0)
#define PG8_MMA(ai, bj, At, Bt) do { __builtin_amdgcn_s_setprio(1); _Pragma("unroll") for (int m = 0; m < 4; ++m) _Pragma("unroll") for (int n = 0; n < 2; ++n) _Pragma("unroll") for (int k = 0; k < 2; ++k) \
        acc[ai][bj][m][n] = __builtin_amdgcn_mfma_f32_16x16x32_bf16(Bt[n][k], At[m][k], acc[ai][bj][m][n], 0, 0, 0); __builtin_amdgcn_s_setprio(0); } while (0)
#define PG8_WAIT_V(n) asm volatile("s_waitcnt vmcnt(" #n ")" ::: "memory")
#define PG8_WAIT_L(n) asm volatile("s_waitcnt lgkmcnt(" #n ")" ::: "memory")
#define PG8_BAR __builtin_amdgcn_s_barrier()
#define PG8_SCHED __builtin_amdgcn_sched_barrier(0)
    GUnit cur, nxt; int ui = 0;
    if (!S.next(0, cur)) return;
    f32x4 acc[2][2][4][2];
#pragma unroll
    for (int a = 0; a < 2; ++a)
#pragma unroll
        for (int b = 0; b < 2; ++b)
#pragma unroll
            for (int m = 0; m < 4; ++m)
#pragma unroll
                for (int n = 0; n < 2; ++n) acc[a][b][m][n] = (f32x4){0.f, 0.f, 0.f, 0.f};
    bf16x8 At[4][2], B0[2][2], B1[2][2];
    const char* cA = g.A + cur.aoff; const char* cB = g.B + cur.boff;
    PG8_STAGE(PG8_SB(0, 0), cB, voffB); PG8_STAGE(PG8_SA(0, 0), cA, voffA); PG8_STAGE(PG8_SB(0, 1), cB + hstepB, voffB); PG8_STAGE(PG8_SA(0, 1), cA + hstepA, voffA);
    if (wr == 1) PG8_BAR;
    PG8_WAIT_V(4); PG8_BAR;
    PG8_STAGE(PG8_SB(1, 0), cB + 128, voffB); PG8_STAGE(PG8_SA(1, 0), cA + 128, voffA); PG8_STAGE(PG8_SB(1, 1), cB + hstepB + 128, voffB);
    PG8_WAIT_V(6); PG8_BAR;
    for (;;) {
        const bool has_next = S.next(ui + 1, nxt);
        const char* nA = has_next ? g.A + nxt.aoff : cA; const char* nB = has_next ? g.B + nxt.boff : cB;
        for (int t = 0; t < nt; t += 2) {
            const bool last = (t == nt - 2);
            if constexpr (Epi::NHOOK > 0) { if (t == Epi::H1 || t == Epi::H2) E.hook(acc, cur, t, wr, wc, fr, fq); }
            const char* a1 = cA + (size_t)(t >> 1) * ks2A + 128;
            const char* a2 = last ? nA : cA + (size_t)((t >> 1) + 1) * ks2A; const char* b2 = last ? nB : cB + (size_t)(t + 2) * 128;
            const char* a3 = a2 + 128; const char* b3 = b2 + 128;
            PG8_LDB(B0, 0, 0); PG8_SCHED; PG8_LDA(At, 0, 0); PG8_STAGE(PG8_SA(1, 1), a1 + hstepA, voffA);
            PG8_WAIT_L(8); PG8_BAR; PG8_WAIT_L(0); PG8_MMA(0, 0, At, B0); PG8_BAR; PG8_SCHED;
            PG8_LDB(B1, 0, 1); PG8_STAGE(PG8_SB(0, 0), b2, voffB);
            PG8_BAR; PG8_WAIT_L(0); PG8_MMA(0, 1, At, B1); PG8_BAR;
            PG8_LDA(At, 0, 1); PG8_STAGE(PG8_SA(0, 0), a2, voffA);
            PG8_BAR; PG8_WAIT_L(0); PG8_MMA(1, 0, At, B0); PG8_BAR; PG8_SCHED;
            PG8_STAGE(PG8_SB(0, 1), b2 + hstepB, voffB);
            PG8_WAIT_V(6); PG8_BAR; PG8_MMA(1, 1, At, B1); PG8_BAR;
            PG8_LDB(B0, 1, 0); PG8_SCHED; PG8_LDA(At, 1, 0); PG8_STAGE(PG8_SA(0, 1), a2 + hstepA, voffA);
            PG8_WAIT_L(8); PG8_BAR; PG8_WAIT_L(0); PG8_MMA(0, 0, At, B0); PG8_BAR; PG8_SCHED;
            PG8_LDB(B1, 1, 1); PG8_STAGE(PG8_SB(1, 0), b3, voffB);
            PG8_BAR; PG8_WAIT_L(0); PG8_MMA(0, 1, At, B1); PG8_BAR;
            PG8_LDA(At, 1, 1); PG8_STAGE(PG8_SA(1, 0), a3, voffA);
            PG8_BAR; PG8_WAIT_L(0); PG8_MMA(1, 0, At, B0); PG8_BAR; PG8_SCHED;
            PG8_STAGE(PG8_SB(1, 1), b3 + hstepB, voffB);
            PG8_WAIT_V(6); PG8_BAR; PG8_MMA(1, 1, At, B1); PG8_BAR;
        }
        E(acc, cur, wr, wc, fr, fq);
        if (!has_next) break;
#pragma unroll
        for (int a = 0; a < 2; ++a)
#pragma unroll
            for (int b = 0; b < 2; ++b)
#pragma unroll
                for (int m = 0; m < 4; ++m)
#pragma unroll
                    for (int n = 0; n < 2; ++n) acc[a][b][m][n] = (f32x4){0.f, 0.f, 0.f, 0.f};
        cur = nxt; cA = nA; cB = nB; ++ui;
    }
    PG8_WAIT_V(0);
    if (wr == 0) PG8_BAR;
    PG8_BAR;
#undef PG8_SA
#undef PG8_SB
#undef PG8_STAGE
#undef PG8_LDA
#undef PG8_LDB
#undef PG8_MMA
#undef PG8_WAIT_V
#undef PG8_WAIT_L
#undef PG8_BAR
#undef PG8_SCHED
}

typedef int i32x4_ __attribute__((ext_vector_type(4)));
typedef int i32x8_ __attribute__((ext_vector_type(8)));
template <class Epi, class Sched, class RowA>
__device__ __forceinline__ void gemm_phase_fp8(LAS unsigned char* lds, const GemmP g, const Sched& S, const Epi& E, const RowA& rowA) {
    const int tid = tid_l(), wid = __builtin_amdgcn_readfirstlane(tid >> 6), lane = tid & 63, wr = wid >> 2, wc = wid & 3, fr = lane & 15, fq = lane >> 4;
    const int nt = g.nt;
    unsigned voffA[2], voffB[2];
#pragma unroll
    for (int i = 0; i < 2; ++i) { int R, C; stage_rc(tid * 16 + i * 8192, R, C); const int Rb = Epi::PERM ? ((R & ~31) + perm32(R & 31)) : R;
        voffA[i] = rowA(R) + (unsigned)C * 2u; voffB[i] = (unsigned)Rb * g.rsB + (unsigned)C * 2u; }
    const size_t hstepA = (size_t)rowA(HALF), hstepB = (size_t)HALF * g.rsB;
    const size_t ks2A = g.ks2A;
    const unsigned ldsw = (unsigned)wid * 1024u;
    const int aoff0 = lds_byte(wr * 64 + fr, fq * 16), aoff1 = lds_byte(wr * 64 + fr, fq * 16 + 8), boff0 = lds_byte(wc * 32 + fr, fq * 16), boff1 = lds_byte(wc * 32 + fr, fq * 16 + 8);
#define PG8_SA(b, h) (((b) * 2 + (h)) * HTB)
#define PG8_SB(b, h) ((4 + (b) * 2 + (h)) * HTB)
#define PG8_STAGE(bufoff, gbase, voff) do { const unsigned long long gb_ = (unsigned long long)(gbase); const char* gu_ = (const char*)(((unsigned long long)(unsigned)__builtin_amdgcn_readfirstlane((int)(gb_ >> 32)) << 32) | (unsigned)__builtin_amdgcn_readfirstlane((int)gb_));   \
        _Pragma("unroll") for (int _i = 0; _i < 2; ++_i) \
        __builtin_amdgcn_global_load_lds((const unsigned*)(gu_ + (voff)[_i]), (LAS unsigned*)(lds + (bufoff) + ldsw + _i * 8192), 16, 0, 0); } while (0)
#define PG8_LDA(dst, b, h) do { _Pragma("unroll") for (int m = 0; m < 4; ++m) dst[m] = __builtin_shufflevector(*(const LAS i32x4_*)(lds + PG8_SA(b, h) + aoff0 + m * 2048), *(const LAS i32x4_*)(lds + PG8_SA(b, h) + aoff1 + m * 2048), 0, 1, 2, 3, 4, 5, 6, 7); } while (0)
#define PG8_LDB(dst, b, h) do { _Pragma("unroll") for (int n = 0; n < 2; ++n) dst[n] = __builtin_shufflevector(*(const LAS i32x4_*)(lds + PG8_SB(b, h) + boff0 + n * 2048), *(const LAS i32x4_*)(lds + PG8_SB(b, h) + boff1 + n * 2048), 0, 1, 2, 3, 4, 5, 6, 7); } while (0)
#define PG8_F8(x) __builtin_shufflevector(__builtin_bit_cast(i32x4_, (x)[0]), __builtin_bit_cast(i32x4_, (x)[1]), 0, 1, 2, 3, 4, 5, 6, 7)
#define PG8_MMA(ai, bj, At, Bt) do { __builtin_amdgcn_s_setprio(1); _Pragma("unroll") for (int m = 0; m < 4; ++m) _Pragma("unroll") for (int n = 0; n < 2; ++n) \
        asm volatile("v_mfma_f32_16x16x128_f8f6f4 %0, %1, %2, %0" : "+v"(acc[ai][bj][m][n]) : "v"(Bt[n]), "v"(At[m]));   \
        __builtin_amdgcn_s_setprio(0); } while (0)
#define PG8_WAIT_V(n) asm volatile("s_waitcnt vmcnt(" #n ")" ::: "memory")
#define PG8_WAIT_L(n) asm volatile("s_waitcnt lgkmcnt(" #n ")" ::: "memory")
#define PG8_BAR __builtin_amdgcn_s_barrier()
#define PG8_SCHED __builtin_amdgcn_sched_barrier(0)
    GUnit cur, nxt; int ui = 0;
    if (!S.next(0, cur)) return;
    f32x4 acc[2][2][4][2];
#pragma unroll
    for (int a = 0; a < 2; ++a)
#pragma unroll
        for (int b = 0; b < 2; ++b)
#pragma unroll
            for (int m = 0; m < 4; ++m)
#pragma unroll
                for (int n = 0; n < 2; ++n) acc[a][b][m][n] = (f32x4){0.f, 0.f, 0.f, 0.f};
    i32x8_ At[4], B0[2], B1[2];
    const char* cA = g.A + cur.aoff; const char* cB = g.B + cur.boff;
    PG8_STAGE(PG8_SB(0, 0), cB, voffB); PG8_STAGE(PG8_SA(0, 0), cA, voffA); PG8_STAGE(PG8_SB(0, 1), cB + hstepB, voffB); PG8_STAGE(PG8_SA(0, 1), cA + hstepA, voffA);
    if (wr == 1) PG8_BAR;
    PG8_WAIT_V(4); PG8_BAR;
    PG8_STAGE(PG8_SB(1, 0), cB + 128, voffB); PG8_STAGE(PG8_SA(1, 0), cA + 128, voffA); PG8_STAGE(PG8_SB(1, 1), cB + hstepB + 128, voffB);
    PG8_WAIT_V(6); PG8_BAR;
    for (;;) {
        const bool has_next = S.next(ui + 1, nxt);
        const char* nA = has_next ? g.A + nxt.aoff : cA; const char* nB = has_next ? g.B + nxt.boff : cB;
        const int nt_ = cur.nt ? cur.nt : nt;
        for (int t = 0; t < nt_; t += 2) {
            const bool last = (t == nt_ - 2);
            if constexpr (Epi::NHOOK > 0) { if (t == Epi::H1 || t == Epi::H2) E.hook(acc, cur, t, wr, wc, fr, fq); }
            const char* a1 = cA + (size_t)(t >> 1) * ks2A + 128;
            const char* a2 = last ? nA : cA + (size_t)((t >> 1) + 1) * ks2A; const char* b2 = last ? nB : cB + (size_t)(t + 2) * 128;
            const char* a3 = a2 + 128; const char* b3 = b2 + 128;
            PG8_LDB(B0, 0, 0); PG8_SCHED; PG8_LDA(At, 0, 0); PG8_STAGE(PG8_SA(1, 1), a1 + hstepA, voffA);
            PG8_WAIT_L(8); PG8_BAR; PG8_WAIT_L(0); PG8_MMA(0, 0, At, B0); PG8_BAR; PG8_SCHED;
            PG8_LDB(B1, 0, 1); PG8_STAGE(PG8_SB(0, 0), b2, voffB);
            PG8_BAR; PG8_WAIT_L(0); PG8_MMA(0, 1, At, B1); PG8_BAR;
            PG8_LDA(At, 0, 1); PG8_STAGE(PG8_SA(0, 0), a2, voffA);
            PG8_BAR; PG8_WAIT_L(0); PG8_MMA(1, 0, At, B0); PG8_BAR; PG8_SCHED;
            PG8_STAGE(PG8_SB(0, 1), b2 + hstepB, voffB);
            PG8_WAIT_V(6); PG8_BAR; PG8_MMA(1, 1, At, B1); PG8_BAR;
            PG8_LDB(B0, 1, 0); PG8_SCHED; PG8_LDA(At, 1, 0); PG8_STAGE(PG8_SA(0, 1), a2 + hstepA, voffA);
            PG8_WAIT_L(8); PG8_BAR; PG8_WAIT_L(0); PG8_MMA(0, 0, At, B0); PG8_BAR; PG8_SCHED;
            PG8_LDB(B1, 1, 1); PG8_STAGE(PG8_SB(1, 0), b3, voffB);
            PG8_BAR; PG8_WAIT_L(0); PG8_MMA(0, 1, At, B1); PG8_BAR;
            PG8_LDA(At, 1, 1); PG8_STAGE(PG8_SA(1, 0), a3, voffA);
            PG8_BAR; PG8_WAIT_L(0); PG8_MMA(1, 0, At, B0); PG8_BAR; PG8_SCHED;
            PG8_STAGE(PG8_SB(1, 1), b3 + hstepB, voffB);
            PG8_WAIT_V(6); PG8_BAR; PG8_MMA(1, 1, At, B1); PG8_BAR;
        }
        asm volatile("s_nop 15\n\ts_nop 15" ::: "memory");
        E(acc, cur, wr, wc, fr, fq);
        if (!has_next) break;
#pragma unroll
        for (int a = 0; a < 2; ++a)
#pragma unroll
            for (int b = 0; b < 2; ++b)
#pragma unroll
                for (int m = 0; m < 4; ++m)
#pragma unroll
                    for (int n = 0; n < 2; ++n) acc[a][b][m][n] = (f32x4){0.f, 0.f, 0.f, 0.f};
        cur = nxt; cA = nA; cB = nB; ++ui;
    }
    PG8_WAIT_V(0);
    if (wr == 0) PG8_BAR;
    PG8_BAR;
#undef PG8_SA
#undef PG8_SB
#undef PG8_STAGE
#undef PG8_LDA
#undef PG8_LDB
#undef PG8_MMA
#undef PG8_F8
#undef PG8_WAIT_V
#undef PG8_WAIT_L
#undef PG8_BAR
#undef PG8_SCHED
}

#ifndef MK_NTST
#define MK_NTST 1
#endif
#define MK_EPI_STORE_B(bit, ptr, v) do { if constexpr ((MK_NTST) & (bit)) __builtin_nontemporal_store(v, ptr); else *(ptr) = (v); } while (0)
#define MK_EPI_STORE(ptr, v) MK_EPI_STORE_B(1, ptr, v)
template <bool ROWINV>
struct EpiBf16T {
    static constexpr bool PERM = true; static constexpr int NHOOK = 0, H1 = -1, H2 = -1;
    bf16_t* O; int ldc; float sc; bool off = false;
    __device__ __forceinline__ void operator()(const f32x4 (&acc)[2][2][4][2], const GUnit& u, int wr, int wc, int fr, int fq) const {
        if (off && acc[0][0][0][0][0] != 12345.678f) return;
        const int row0 = u.row0 + wr * 64 + fr, col0 = u.col0 + wc * 32 + 8 * fq;
        const unsigned* ss1 = (const unsigned*)((const unsigned char*)O + (WS_SS1 - WS_PROJ));
#pragma unroll
        for (int ai = 0; ai < 2; ++ai)
#pragma unroll
            for (int m = 0; m < 4; ++m) { bf16_t* rowp = O + (size_t)(row0 + ai * HALF + m * 16) * ldc + col0;
                float sc_ = sc; if constexpr (ROWINV) sc_ = sc * rsqrtf((float)ss1[row0 + ai * HALF + m * 16] * (1.0f / 4096.0f / 2048.0f) + RMS_EPS);
#pragma unroll
                for (int bj = 0; bj < 2; ++bj) { const f32x4 v0 = acc[ai][bj][m][0] * sc_, v1 = acc[ai][bj][m][1] * sc_;
                    u32x4 w; w.x = cvt_pk_bf16(v0[0], v0[1]); w.y = cvt_pk_bf16(v0[2], v0[3]); w.z = cvt_pk_bf16(v1[0], v1[1]); w.w = cvt_pk_bf16(v1[2], v1[3]);
                    MK_EPI_STORE((u32x4*)(rowp + bj * HALF), w); } }
    }
};
typedef EpiBf16T<false> EpiBf16;
__device__ __forceinline__ f32x2 silu_mul2(f32x2 ag, f32x2 au, float kneg, float c) {
    const f32x2 kv = {kneg, kneg}, cv = {c, c}, one = {1.f, 1.f};
    f32x2 t = ag * kv; t[0] = __builtin_amdgcn_exp2f(t[0]); t[1] = __builtin_amdgcn_exp2f(t[1]);
    f32x2 d = t + one; d[0] = rcp_(d[0]); d[1] = rcp_(d[1]);
    return ((ag * au) * cv) * d;
}
struct EpiSilu {
    static constexpr bool PERM = true; static constexpr int NHOOK = 0, H1 = -1, H2 = -1;
    bf16_t* O; int ldc; float sc;
    __device__ __forceinline__ void operator()(const f32x4 (&acc)[2][2][4][2], const GUnit& u, int wr, int wc, int fr, int fq) const {
        const int row0 = u.row0 + wr * 64 + fr, col0 = (u.col0 >> 1) + wc * 32 + 8 * fq;
#pragma unroll
        for (int ai = 0; ai < 2; ++ai)
#pragma unroll
            for (int m = 0; m < 4; ++m) { bf16_t* rowp = O + (size_t)(row0 + ai * HALF + m * 16) * ldc + col0;
                float r[8];
#pragma unroll
                for (int n = 0; n < 2; ++n)
#pragma unroll
                    for (int i = 0; i < 4; i += 2) { const f32x2 v = silu_mul2((f32x2){acc[ai][0][m][n][i], acc[ai][0][m][n][i + 1]}, (f32x2){acc[ai][1][m][n][i], acc[ai][1][m][n][i + 1]}, -sc * LOG2E, sc * sc); r[n * 4 + i] = v[0]; r[n * 4 + i + 1] = v[1]; }
                u32x4 w; w.x = cvt_pk_bf16(r[0], r[1]); w.y = cvt_pk_bf16(r[2], r[3]); w.z = cvt_pk_bf16(r[4], r[5]); w.w = cvt_pk_bf16(r[6], r[7]);
                MK_EPI_STORE_B(2, (u32x4*)rowp, w); }
    }
};
struct EpiSiluF8 {
    static constexpr bool PERM = true; static constexpr int NHOOK = 0, H1 = -1, H2 = -1;
    unsigned char* O; int ldc; float sc, osc; const unsigned* ss = nullptr;
    __device__ __forceinline__ void operator()(const f32x4 (&acc)[2][2][4][2], const GUnit& u, int wr, int wc, int fr, int fq) const {
        const int row0 = u.row0 + wr * 64 + fr, col0 = (u.col0 >> 1) + wc * 32 + 8 * fq;
#pragma unroll
        for (int ai = 0; ai < 2; ++ai)
#pragma unroll
            for (int m = 0; m < 4; ++m) { unsigned char* rowp = O + (size_t)(row0 + ai * HALF + m * 16) * ldc + col0;
                float inv = 1.f; if (ss) inv = rsqrtf((float)ss[row0 + ai * HALF + m * 16] * (1.0f / 4096.0f / 2048.0f) + RMS_EPS);
                const float kn_ = -sc * LOG2E * inv, cc_ = osc * sc * sc * inv * inv;
                float r[8];
#pragma unroll
                for (int n = 0; n < 2; ++n)
#pragma unroll
                    for (int i = 0; i < 4; i += 2) { const f32x2 v = silu_mul2((f32x2){acc[ai][0][m][n][i], acc[ai][0][m][n][i + 1]}, (f32x2){acc[ai][1][m][n][i], acc[ai][1][m][n][i + 1]}, kn_, cc_);
                        r[n * 4 + i] = __builtin_amdgcn_fmed3f(v[0], -448.f, 448.f); r[n * 4 + i + 1] = __builtin_amdgcn_fmed3f(v[1], -448.f, 448.f); }
                int q0 = 0, q1 = 0;
                q0 = __builtin_amdgcn_cvt_pk_fp8_f32(r[0], r[1], q0, false); q0 = __builtin_amdgcn_cvt_pk_fp8_f32(r[2], r[3], q0, true);
                q1 = __builtin_amdgcn_cvt_pk_fp8_f32(r[4], r[5], q1, false); q1 = __builtin_amdgcn_cvt_pk_fp8_f32(r[6], r[7], q1, true);
                { const u32x2 qq = {(unsigned)q0, (unsigned)q1}; MK_EPI_STORE_B(2, (u32x2*)rowp, qq); } }
    }
};
template <bool ROWINV>
struct EpiF8T {
    static constexpr bool PERM = true; static constexpr int NHOOK = 0, H1 = -1, H2 = -1;
    unsigned char* O; int ldc; float sc;
    __device__ __forceinline__ void operator()(const f32x4 (&acc)[2][2][4][2], const GUnit& u, int wr, int wc, int fr, int fq) const {
        const int row0 = u.row0 + wr * 64 + fr, col0 = u.col0 + wc * 32 + 8 * fq;
#pragma unroll
        for (int ai = 0; ai < 2; ++ai)
#pragma unroll
            for (int m = 0; m < 4; ++m) { unsigned char* rowp = O + (size_t)(row0 + ai * HALF + m * 16) * ldc + col0;
                float sc_ = sc; if constexpr (ROWINV) { const unsigned* ss1 = (const unsigned*)(O + (WS_SS1 - WS_PROJ - (size_t)PC_MERGE * 2)); sc_ = sc * rsqrtf((float)ss1[row0 + ai * HALF + m * 16] * (1.0f / 4096.0f / 2048.0f) + RMS_EPS); }
#pragma unroll
                for (int bj = 0; bj < 2; ++bj) { float r[8];
#pragma unroll
                    for (int n = 0; n < 2; ++n)
#pragma unroll
                        for (int i = 0; i < 4; ++i) r[n * 4 + i] = fminf(fmaxf(acc[ai][bj][m][n][i] * sc_, -448.f), 448.f);
                    int q0 = 0, q1 = 0;
                    q0 = __builtin_amdgcn_cvt_pk_fp8_f32(r[0], r[1], q0, false); q0 = __builtin_amdgcn_cvt_pk_fp8_f32(r[2], r[3], q0, true);
                    q1 = __builtin_amdgcn_cvt_pk_fp8_f32(r[4], r[5], q1, false); q1 = __builtin_amdgcn_cvt_pk_fp8_f32(r[6], r[7], q1, true);
                    const u32x2 qq = {(unsigned)q0, (unsigned)q1}; MK_EPI_STORE_B(1, (u32x2*)(rowp + bj * HALF), qq); } }
    }
};
typedef EpiF8T<false> EpiF8;
struct EpiRes {
    static constexpr bool PERM = false; static constexpr int NHOOK = 0, H1 = -1, H2 = -1;
    const float* base; float* out; float sc;
    __device__ __forceinline__ void operator()(const f32x4 (&acc)[2][2][4][2], const GUnit& u, int wr, int wc, int fr, int fq) const {
        const int row0 = u.row0 + wr * 64 + fr, col0 = u.col0 + wc * 32 + 4 * fq;
#pragma unroll
        for (int ai = 0; ai < 2; ++ai) {
            f32x4 bs[4][2][2];
#pragma unroll
            for (int m = 0; m < 4; ++m) { const size_t off = (size_t)(row0 + ai * HALF + m * 16) * 2048 + col0;
#pragma unroll
                for (int bj = 0; bj < 2; ++bj)
#pragma unroll
                    for (int n = 0; n < 2; ++n) bs[m][bj][n] = *(const f32x4*)(base + off + bj * HALF + n * 16); }
#pragma unroll
            for (int m = 0; m < 4; ++m) { const size_t off = (size_t)(row0 + ai * HALF + m * 16) * 2048 + col0;
#pragma unroll
                for (int bj = 0; bj < 2; ++bj)
#pragma unroll
                    for (int n = 0; n < 2; ++n) { const f32x4 rv = bs[m][bj][n] + acc[ai][bj][m][n] * sc; MK_EPI_STORE_B(4, (f32x4*)(out + off + bj * HALF + n * 16), rv); } }
            asm volatile("" ::: "memory");
        }
    }
};
template <bool F32IN, bool SUMSQ = false, bool X8OUT = false, int SSIDX = 0>
struct EpiResB {
    static constexpr bool PERM = true; static constexpr int NHOOK = 0, H1 = -1, H2 = -1;
    const void* base; bf16_t* out; float sc;
    __device__ __forceinline__ void operator()(const f32x4 (&acc)[2][2][4][2], const GUnit& u, int wr, int wc, int fr, int fq) const {
        const int row0 = u.row0 + wr * 64 + fr, col0 = u.col0 + wc * 32 + 8 * fq;
        unsigned* ss = (unsigned*)((unsigned char*)out + (WS_SS - WS_XB)) + (size_t)SSIDX * T;
        unsigned char* x8 = (unsigned char*)out - (WS_XB - WS_H8);
        constexpr int MG = SUMSQ ? 2 : 4;
#pragma unroll
        for (int ai = 0; ai < 2; ++ai)
#pragma unroll
        for (int mb = 0; mb < 4; mb += MG) {
            f32x4 bs[MG][2][2];
#pragma unroll
            for (int mm = 0; mm < MG; ++mm) { const int m = mb + mm; const size_t off = (size_t)(row0 + ai * HALF + m * 16) * 2048 + col0;
#pragma unroll
                for (int bj = 0; bj < 2; ++bj) {
                    if constexpr (F32IN) { const float* bp = (const float*)base + off + bj * HALF; bs[mm][bj][0] = *(const f32x4*)bp; bs[mm][bj][1] = *(const f32x4*)(bp + 4); }
                    else { const u32x4 w = *(const u32x4*)((const bf16_t*)base + off + bj * HALF);
                        bs[mm][bj][0] = (f32x4){bflo(w.x), bfhi(w.x), bflo(w.y), bfhi(w.y)}; bs[mm][bj][1] = (f32x4){bflo(w.z), bfhi(w.z), bflo(w.w), bfhi(w.w)}; } } }
#pragma unroll
            for (int mm = 0; mm < MG; ++mm) { const int m = mb + mm; const size_t off = (size_t)(row0 + ai * HALF + m * 16) * 2048 + col0; float rsq = 0.f;
#pragma unroll
                for (int bj = 0; bj < 2; ++bj) { const f32x4 v0 = bs[mm][bj][0] + acc[ai][bj][m][0] * sc, v1 = bs[mm][bj][1] + acc[ai][bj][m][1] * sc;
                    u32x4 w; w.x = cvt_pk_bf16(v0[0], v0[1]); w.y = cvt_pk_bf16(v0[2], v0[3]); w.z = cvt_pk_bf16(v1[0], v1[1]); w.w = cvt_pk_bf16(v1[2], v1[3]);
                    *(u32x4*)(out + off + bj * HALF) = w;
                    if constexpr (X8OUT) { int q0 = 0, q1 = 0;
                        q0 = __builtin_amdgcn_cvt_pk_fp8_f32(4.f * v0[0], 4.f * v0[1], q0, false); q0 = __builtin_amdgcn_cvt_pk_fp8_f32(4.f * v0[2], 4.f * v0[3], q0, true);
                        q1 = __builtin_amdgcn_cvt_pk_fp8_f32(4.f * v1[0], 4.f * v1[1], q1, false); q1 = __builtin_amdgcn_cvt_pk_fp8_f32(4.f * v1[2], 4.f * v1[3], q1, true);
                        *(u32x2*)(x8 + off + bj * HALF) = (u32x2){(unsigned)q0, (unsigned)q1}; }
                    if constexpr (SUMSQ) rsq += v0[0] * v0[0] + v0[1] * v0[1] + v0[2] * v0[2] + v0[3] * v0[3] + v1[0] * v1[0] + v1[1] * v1[1] + v1[2] * v1[2] + v1[3] * v1[3]; }
                if constexpr (SUMSQ) { rsq += __shfl_xor(rsq, 16); rsq += __shfl_xor(rsq, 32);
                    if (fq == 0) (void)__hip_atomic_fetch_add(ss + row0 + ai * HALF + m * 16, (unsigned)(rsq * 4096.f + 0.5f), __ATOMIC_RELAXED, __HIP_MEMORY_SCOPE_AGENT); } }
            asm volatile("" ::: "memory");
        }
    }
};
struct EpiSlab {
    static constexpr bool PERM = false; static constexpr int NHOOK = 0, H1 = -1, H2 = -1;
    bf16_t* slab;
    __device__ __forceinline__ void operator()(const f32x4 (&acc)[2][2][4][2], const GUnit& u, int wr, int wc, int fr, int fq) const {
        const int row0 = u.row0 + wr * 64 + fr, col0 = wc * 32 + 4 * fq;
        bf16_t* sb = slab + (size_t)u.aux * 2048 * 256;
#pragma unroll
        for (int ai = 0; ai < 2; ++ai)
#pragma unroll
            for (int m = 0; m < 4; ++m) { bf16_t* rowp = sb + (size_t)(row0 + ai * HALF + m * 16) * 256 + col0;
#pragma unroll
                for (int bj = 0; bj < 2; ++bj)
#pragma unroll
                    for (int n = 0; n < 2; ++n) { const f32x4 v = acc[ai][bj][m][n]; *(u32x2*)(rowp + bj * HALF + n * 16) = (u32x2){cvt_pk_bf16(v[0], v[1]), cvt_pk_bf16(v[2], v[3])}; } }
    }
};
struct EpiBranch {
    static constexpr bool PERM = true; static constexpr int NHOOK = 2, H1 = 16, H2 = 24;
    const bf16_t* proj; bf16_t* O;
    __device__ __forceinline__ void scale(f32x4 (&acc)[2][2][4][2], const GUnit& u, int mode, int wr, int wc, int fr, int fq) const {
        const unsigned voff = (unsigned)(fr * LDP * 2 + 8 * fq);
        constexpr float K_ = -LOG2E / 16.0f;
#pragma unroll
        for (int ai = 0; ai < 2; ++ai)
#pragma unroll
            for (int mp = 0; mp < 2; ++mp) {
                u32x2 za[2][2], zb[2][2];
#pragma unroll
                for (int mm = 0; mm < 2; ++mm) { const int m = mp * 2 + mm; const char* gp = (const char*)proj + ((size_t)(u.row0 + wr * 64 + ai * HALF + m * 16) * LDP + PC_MERGE) * 2 + u.col0 + wc * 32;
#pragma unroll
                    for (int bj = 0; bj < 2; ++bj) {
                        if (mode == 2) { za[mm][bj] = *(const u32x2*)(gp + (2 * 2048 + bj * HALF) + voff); zb[mm][bj] = za[mm][bj]; }
                        else { za[mm][bj] = *(const u32x2*)(gp + (mode * 2048 + bj * HALF) + voff); zb[mm][bj] = *(const u32x2*)(gp + ((mode + 1) * 2048 + bj * HALF) + voff); } } }
#pragma unroll
                for (int mm = 0; mm < 2; ++mm) { const int m = mp * 2 + mm;
#pragma unroll
                    for (int bj = 0; bj < 2; ++bj)
#pragma unroll
                        for (int n = 0; n < 2; ++n) { const int a_ = (int)(n ? za[mm][bj].y : za[mm][bj].x), b_ = (int)(n ? zb[mm][bj].y : zb[mm][bj].x); f32x4 f;
                            const f32x2 a0 = __builtin_amdgcn_cvt_pk_f32_fp8(a_, false), a1 = __builtin_amdgcn_cvt_pk_f32_fp8(a_, true);
                            if (mode == 2) { f[0] = rcp_(1.f + __builtin_amdgcn_exp2f(a0[0] * K_)); f[1] = rcp_(1.f + __builtin_amdgcn_exp2f(a0[1] * K_)); f[2] = rcp_(1.f + __builtin_amdgcn_exp2f(a1[0] * K_)); f[3] = rcp_(1.f + __builtin_amdgcn_exp2f(a1[1] * K_)); }
                            else { const f32x2 b0 = __builtin_amdgcn_cvt_pk_f32_fp8(b_, false), b1 = __builtin_amdgcn_cvt_pk_f32_fp8(b_, true);
                                   f[0] = (1.f + __builtin_amdgcn_exp2f(b0[0] * K_)) * rcp_(1.f + __builtin_amdgcn_exp2f(a0[0] * K_)); f[1] = (1.f + __builtin_amdgcn_exp2f(b0[1] * K_)) * rcp_(1.f + __builtin_amdgcn_exp2f(a0[1] * K_));
                                   f[2] = (1.f + __builtin_amdgcn_exp2f(b1[0] * K_)) * rcp_(1.f + __builtin_amdgcn_exp2f(a1[0] * K_)); f[3] = (1.f + __builtin_amdgcn_exp2f(b1[1] * K_)) * rcp_(1.f + __builtin_amdgcn_exp2f(a1[1] * K_)); }
                            acc[ai][bj][m][n] *= f; } }
                asm volatile("" ::: "memory");
            }
    }
    __device__ __forceinline__ void hook(f32x4 (&acc)[2][2][4][2], const GUnit& u, int t, int wr, int wc, int fr, int fq) const { scale(acc, u, t == 16 ? 0 : 1, wr, wc, fr, fq); }
    __device__ __forceinline__ void operator()(f32x4 (&acc)[2][2][4][2], const GUnit& u, int wr, int wc, int fr, int fq) const {
        scale(acc, u, 2, wr, wc, fr, fq);
        EpiBf16 e{O, 2048, 1.0f}; e(acc, u, wr, wc, fr, fq);
    }
};
struct EpiMoeDown {
    static constexpr bool PERM = true; static constexpr int NHOOK = 0, H1 = -1, H2 = -1;
    bf16_t* O; const float* roww; float sc; bf16_t* part; unsigned* tmap;
    __device__ __forceinline__ void operator()(const f32x4 (&acc)[2][2][4][2], const GUnit& u, int wr, int wc, int fr, int fq) const {
        const int row0 = u.row0 + wr * 64 + fr, col0 = u.col0 + wc * 32 + 8 * fq;
        float rws[2][4];
#pragma unroll
        for (int ai = 0; ai < 2; ++ai)
#pragma unroll
            for (int m = 0; m < 4; ++m) rws[ai][m] = roww[row0 + ai * HALF + m * 16];
        bf16_t* base = O + (size_t)row0 * 2048 + col0; size_t ld = 2048;
        if (u.sub) { const int ks = (u.sub - 1) & 3, tu = (u.sub - 1) >> 2;
            base = part + ((size_t)(ks * 64 + tu) * 256 + (wr * 64 + fr)) * 256 + wc * 32 + 8 * fq; ld = 256;
            if (ks == 0 && wr == 0 && wc == 0 && fr == 0 && fq == 0) tmap[(u.row0 >> 8) * 8 + (u.col0 >> 8)] = (unsigned)tu + 1u; }
#pragma unroll
        for (int ai = 0; ai < 2; ++ai)
#pragma unroll
            for (int m = 0; m < 4; ++m) { const float rw = rws[ai][m] * sc; bf16_t* rowp = base + (size_t)(ai * HALF + m * 16) * ld;
#pragma unroll
                for (int bj = 0; bj < 2; ++bj) { const f32x4 v0 = acc[ai][bj][m][0] * rw, v1 = acc[ai][bj][m][1] * rw;
                    u32x4 w; w.x = cvt_pk_bf16(v0[0], v0[1]); w.y = cvt_pk_bf16(v0[2], v0[3]); w.z = cvt_pk_bf16(v1[0], v1[1]); w.w = cvt_pk_bf16(v1[2], v1[3]);
                    MK_EPI_STORE_B(8, (u32x4*)(rowp + bj * HALF), w); } }
    }
};
}
#define KSWZ(row, colB) ((row) * 256 + ((colB) ^ (((row) & 7) << 4)))
__device__ __forceinline__ int v_st(int k, int c) { const int kk = (k & ~0xC) | ((k & 4) << 1) | ((k & 8) >> 1); return ((kk >> 3) * 4 + (c >> 5)) * 512 + ((kk & 7) * 32 + (c & 31)) * 2; }
__device__ __forceinline__ int v_rd_base(int lane) { return ((lane & 3) << 3) | (((lane >> 2) & 3) << 6) | (((lane >> 4) & 1) << 5) | (((lane >> 5) & 1) << 8); }
constexpr int v_rd_off(int d0, int ks, int half) { return d0 * 512 + ks * 4096 + half * 2048; }
__device__ __forceinline__ int crow(int r, int hi) { return (r & 3) + 8 * (r >> 2) + 4 * hi; }

__device__ __forceinline__ void qkt(f32x16& p0, f32x16& p1, LAS const unsigned char* Kb, int r32, int hi, const bf16x8* qr) {
    unsigned ka[4];
#pragma unroll
    for (int dd = 0; dd < 4; ++dd) ka[dd] = (unsigned)(uintptr_t)(Kb + KSWZ(r32, (dd * 16 + hi * 8) * 2));
    bf16x8 b00, b01, b10, b11, b20, b21, b30, b31, b40, b41, b50, b51, b60, b61, b70, b71;
#define KRD_(dst, a_, off) asm volatile("ds_read_b128 %0, %1 offset:%2" : "=&v"(dst) : "v"(a_), "i"(off) : "memory")
#define KISS(s) do { KRD_(b##s##0, ka[(s) & 3], ((s) >> 2) * 128); KRD_(b##s##1, ka[(s) & 3], ((s) >> 2) * 128 + 8192); } while (0)
#define KUSE(s, n) do { asm volatile("s_waitcnt lgkmcnt(" #n ")" : "+v"(b##s##0), "+v"(b##s##1) :: "memory"); \
        p0 = __builtin_amdgcn_mfma_f32_32x32x16_bf16(b##s##0, qr[s], p0, 0, 0, 0); p1 = __builtin_amdgcn_mfma_f32_32x32x16_bf16(b##s##1, qr[s], p1, 0, 0, 0); } while (0)
    KISS(0); KISS(1); KISS(2);
    asm volatile("" : "+v"(p0), "+v"(p1));
    KISS(3); KUSE(0, 6); KISS(4); KUSE(1, 6); KISS(5); KUSE(2, 6); KISS(6); KUSE(3, 6); KISS(7); KUSE(4, 6); KUSE(5, 4); KUSE(6, 2); KUSE(7, 0);
#undef KUSE
#undef KISS
#undef KRD_
}
__device__ __forceinline__ void pv_tile(f32x16* o, unsigned vb, bf16x8 pa0, bf16x8 pa1, bf16x8 pa2, bf16x8 pa3) {
#define TRRD(dst, off) asm volatile("ds_read_b64_tr_b16 %0, %1 offset:%2" : "=&v"(dst) : "v"(vb), "i"(off) : "memory")
#define PV_D0(d0) do { s16x4 l0, l1, l2, l3, h0, h1, h2, h3; constexpr int b_ = v_rd_off(d0, 0, 0); \
        TRRD(l0, b_); TRRD(h0, b_ + 2048); TRRD(l1, b_ + 4096); TRRD(h1, b_ + 6144); TRRD(l2, b_ + 8192); TRRD(h2, b_ + 10240); TRRD(l3, b_ + 12288); TRRD(h3, b_ + 14336); \
        asm volatile("s_waitcnt lgkmcnt(0)" ::: "memory"); __builtin_amdgcn_sched_barrier(0); \
        o[d0] = __builtin_amdgcn_mfma_f32_32x32x16_bf16(pa0, (bf16x8){l0[0], l0[1], l0[2], l0[3], h0[0], h0[1], h0[2], h0[3]}, o[d0], 0, 0, 0);   \
        o[d0] = __builtin_amdgcn_mfma_f32_32x32x16_bf16(pa1, (bf16x8){l1[0], l1[1], l1[2], l1[3], h1[0], h1[1], h1[2], h1[3]}, o[d0], 0, 0, 0);   \
        o[d0] = __builtin_amdgcn_mfma_f32_32x32x16_bf16(pa2, (bf16x8){l2[0], l2[1], l2[2], l2[3], h2[0], h2[1], h2[2], h2[3]}, o[d0], 0, 0, 0);   \
        o[d0] = __builtin_amdgcn_mfma_f32_32x32x16_bf16(pa3, (bf16x8){l3[0], l3[1], l3[2], l3[3], h3[0], h3[1], h3[2], h3[3]}, o[d0], 0, 0, 0); } while (0)
    PV_D0(0); PV_D0(1); PV_D0(2); PV_D0(3);
#undef PV_D0
#undef TRRD
}
__device__ __forceinline__ float swapmax(float v) { auto rr = __builtin_amdgcn_permlane32_swap(__float_as_uint(v), __float_as_uint(v), false, false); return fmaxf(__uint_as_float(rr[0]), __uint_as_float(rr[1])); }
__device__ __forceinline__ float swapadd(float v) { auto rr = __builtin_amdgcn_permlane32_swap(__float_as_uint(v), __float_as_uint(v), false, false); return __uint_as_float(rr[0]) + __uint_as_float(rr[1]); }
__device__ __forceinline__ void pack_p(const f32x16& p0, const f32x16& p1, bf16x8& pa0, bf16x8& pa1, bf16x8& pa2, bf16x8& pa3) {
#define PK4(P, B_, OUT) do { unsigned a0 = cvt_pk_bf16(P[B_+0], P[B_+1]), a1 = cvt_pk_bf16(P[B_+2], P[B_+3]);                          \
        unsigned b0 = cvt_pk_bf16(P[B_+4], P[B_+5]), b1 = cvt_pk_bf16(P[B_+6], P[B_+7]);                                             \
        auto r0 = __builtin_amdgcn_permlane32_swap(a0, b0, false, false); auto r1 = __builtin_amdgcn_permlane32_swap(a1, b1, false, false); \
        u32x4 w = {r0[0], r1[0], r0[1], r1[1]}; OUT = *reinterpret_cast<bf16x8*>(&w); } while (0)
    PK4(p0, 0, pa0); PK4(p0, 8, pa1); PK4(p1, 0, pa2); PK4(p1, 8, pa3);
#undef PK4
}

template <class F>
__device__ __forceinline__ void attn_unit(const F& f, LAS unsigned char* lds) {
    constexpr int NPOS = F::NPOS, NH = F::NH, TW = NPOS + 63, TABN = NH * TW;
    constexpr int TWS = NH == 1 ? TW : 136, TBUF = 576;
    static_assert(NH * TWS <= TBUF, "table buffer");
    static_assert(NPOS * NH == 256 && TABN <= 512, "unit geometry");
    const int tid = tid_l(), wid = rfl(tid >> 6), lane = tid & 63, r32 = lane & 31, hi = lane >> 5;
    LAS unsigned char* V_lds = lds; LAS unsigned char* K_lds = lds + 3 * SHM_V;
    LAS float* als = (LAS float*)(lds + ALS_OFF) + wid * 64;
    LAS float* tab = (LAS float*)(lds + TAB_OFF);
    LAS float* keyb = (LAS float*)(lds + KEYB_OFF);
    const int row = wid * 32 + r32;
    const int pl = NH == 1 ? row : (row >> 2), gh = NH == 1 ? 0 : (row & 3);
    bf16x8 qr[8];
    { const bf16_t* qp = f.qptr(row);
#pragma unroll
      for (int d0 = 0; d0 < 8; ++d0) qr[d0] = *(const bf16x8*)(qp + d0 * 16 + hi * 8); }
    float m_reg = -1e30f, l_reg = 0.f;
    f32x16 o[4];
#pragma unroll
    for (int d = 0; d < 4; ++d)
#pragma unroll
        for (int r = 0; r < 16; ++r) o[d][r] = 0.f;
    const int nt = f.nt;
    const int tlb = gh * TWS + NPOS - 1 - pl + 4 * hi;
    const unsigned vb0 = (unsigned)(uintptr_t)V_lds + (unsigned)v_rd_base(lane);
    int ko0, ko1, vo0, vo1;
    { const int rs_ = (int)f.rs();
#define A_OFFS(i, KO, VO) { const int ch = wid * 2 + i; const int krow = ch * 4 + (lane >> 4), kcolB = ((lane & 15) * 16) ^ ((krow & 7) << 4); \
        const int sub = ch * 2 + (lane >> 5), j = lane & 31; const int kk = (sub >> 2) * 8 + (j >> 2); const int vk = (kk & ~0xC) | ((kk & 4) << 1) | ((kk & 8) >> 1); \
        KO = krow * rs_ + (kcolB >> 1); VO = vk * rs_ + (sub & 3) * 32 + (j & 3) * 8; }
      A_OFFS(0, ko0, vo0) A_OFFS(1, ko1, vo1)
#undef A_OFFS
    }
#define A_DMA(t, bf) do { const int kb_ = f.kbase(t); const bf16_t* kp_ = f.kptr(kb_); const bf16_t* vp_ = f.vptr(kb_); \
        __builtin_amdgcn_global_load_lds((const unsigned*)(kp_ + ko0), (LAS unsigned*)(K_lds + (bf) * SHM_K + (wid * 2) * 1024), 16, 0, 0); \
        __builtin_amdgcn_global_load_lds((const unsigned*)(vp_ + vo0), (LAS unsigned*)(V_lds + (bf) * SHM_V + (wid * 2) * 1024), 16, 0, 0); \
        __builtin_amdgcn_global_load_lds((const unsigned*)(kp_ + ko1), (LAS unsigned*)(K_lds + (bf) * SHM_K + (wid * 2 + 1) * 1024), 16, 0, 0); \
        __builtin_amdgcn_global_load_lds((const unsigned*)(vp_ + vo1), (LAS unsigned*)(V_lds + (bf) * SHM_V + (wid * 2 + 1) * 1024), 16, 0, 0); } while (0)
#define A_TAB(t, bf) do { if (tid < TABN) { const int g_ = tid / TW, j_ = tid - g_ * TW; tab[(bf) * TBUF + g_ * TWS + j_] = f.tabval(rbl, g_, f.q0 - f.kbase(t) + NPOS - 1 - j_) * (1.0f / C2); } } while (0)
    LAS float* rbl = (LAS float*)(lds + RBL_OFF);
    float gpre[16]; f.gate_prefetch(gpre, wid, hi);
    if (nt > 0) { A_DMA(0, 0); }
    if (nt > 1) { A_DMA(1, 1); }
    f.load_bias(rbl, tid);
    if constexpr (F::NEEDS_BIAS) __syncthreads();
    if (nt > 0) { A_TAB(0, 0); }
    if constexpr (F::KEYBIAS) {
        LAS float* pref = (LAS float*)(lds + ALS_OFF);
        if (tid < 64) { const float tt = f.ctot[tid]; float inc = tt; for (int o = 1; o < 64; o <<= 1) { const float t_ = __shfl_up(inc, o); if (tid >= o) inc += t_; } pref[tid] = inc - tt; }
        __syncthreads();
        const f32x4* kbg = (const f32x4*)f.keyb;
        ((LAS f32x4*)keyb)[tid] = kbg[tid] + pref[tid >> 4]; ((LAS f32x4*)keyb)[tid + 512] = kbg[tid + 512] + pref[(tid + 512) >> 4]; }
#define A_SYNC(more) do { if (more) asm volatile("s_waitcnt vmcnt(4)" ::: "memory"); else asm volatile("s_waitcnt vmcnt(0)" ::: "memory"); \
        asm volatile("s_waitcnt lgkmcnt(0)" ::: "memory"); __builtin_amdgcn_s_barrier(); asm volatile("" ::: "memory"); } while (0)
    A_SYNC(nt > 1);
    auto tile = [&](const int t, const int kvb, const int bf) __attribute__((always_inline)) {
        if (f.wave_active(t, wid)) {
            f32x16 p0, p1;
            LAS const float* tp = tab + bf * TBUF + tlb;
            bool addtab = false;
            if constexpr (F::KEYBIAS) { const int kb_ = f.kbase(t);
#pragma unroll
                for (int a = 0; a < 4; ++a) { const f32x4 x0 = *(LAS const f32x4*)(keyb + kb_ + 8 * a + 4 * hi), x1 = *(LAS const f32x4*)(keyb + kb_ + 32 + 8 * a + 4 * hi);
#pragma unroll
                    for (int i = 0; i < 4; ++i) { p0[4 * a + i] = x0[i]; p1[4 * a + i] = x1[i]; } }
                addtab = !f.unmasked(t, wid); }
            else {
#pragma unroll
                for (int r = 0; r < 16; ++r) { const int c = (r & 3) + 8 * (r >> 2); p0[r] = tp[c]; p1[r] = tp[c + 32]; } }
            qkt(p0, p1, K_lds + kvb * SHM_K, r32, hi, qr);
            if constexpr (F::KEYBIAS) { if (addtab) {
#pragma unroll
                for (int r = 0; r < 16; ++r) { const int c = (r & 3) + 8 * (r >> 2); p0[r] += tp[c]; p1[r] += tp[c + 32]; } } }
            if (F::ROWMASK) { if (!f.row_on(t, row)) {
#pragma unroll
                for (int r = 0; r < 16; ++r) { p0[r] = -__builtin_inff(); p1[r] = -__builtin_inff(); } } }
            float pmax = fmaxf(p0[0], p1[0]);
#pragma unroll
            for (int r = 1; r < 16; ++r) pmax = fmaxf(fmaxf(pmax, p0[r]), p1[r]);
            pmax = swapmax(pmax);
            const float mn = __all(pmax - m_reg <= 24.f / C2) ? m_reg : fmaxf(m_reg, pmax);
            const float alpha = __builtin_amdgcn_exp2f((m_reg - mn) * C2); m_reg = mn;
            const f32x2 c2v = {C2, C2}, nmv = {-mn * C2, -mn * C2};
            f32x2 ps2 = {0.f, 0.f};
#pragma unroll
            for (int r = 0; r < 16; r += 2) {
                f32x2 u = (f32x2){p0[r], p0[r + 1]} * c2v + nmv, w = (f32x2){p1[r], p1[r + 1]} * c2v + nmv;
                u[0] = __builtin_amdgcn_exp2f(u[0]); u[1] = __builtin_amdgcn_exp2f(u[1]); w[0] = __builtin_amdgcn_exp2f(w[0]); w[1] = __builtin_amdgcn_exp2f(w[1]);
                p0[r] = u[0]; p0[r + 1] = u[1]; p1[r] = w[0]; p1[r + 1] = w[1]; ps2 += u; ps2 += w; }
            float ps = swapadd(ps2[0] + ps2[1]);
            l_reg = l_reg * alpha + ps;
            bf16x8 pa0, pa1, pa2, pa3; pack_p(p0, p1, pa0, pa1, pa2, pa3);
            if (__any(alpha < 1.f)) { if (hi == 0) als[r32] = alpha; asm volatile("s_waitcnt lgkmcnt(0)" ::: "memory");
#pragma unroll
                for (int r = 0; r < 16; ++r) { const float a_ = als[crow(r, hi)];
#pragma unroll
                    for (int d = 0; d < 4; ++d) o[d][r] *= a_; } }
            pv_tile(o, vb0 + (unsigned)(kvb * SHM_V), pa0, pa1, pa2, pa3);
        }
    };
    int kvb = 0;
#pragma unroll 1
    for (int t = 0; t < nt; ++t) {
        const int nb2 = kvb == 0 ? 2 : kvb - 1;
        if (t + 2 < nt) A_DMA(t + 2, nb2);
        tile(t, kvb, t & 1);
        if (t + 1 < nt) { A_TAB(t + 1, (t + 1) & 1); }
        A_SYNC(t + 2 < nt);
        kvb = kvb == 2 ? 0 : kvb + 1;
    }
#undef A_DMA
#undef A_SYNC
#undef A_TAB
    if (hi == 0) { als[r32] = l_reg; f.stats(row, m_reg * C2, l_reg); }
    asm volatile("s_waitcnt lgkmcnt(0)" ::: "memory");
    float rl[16];
#pragma unroll
    for (int r = 0; r < 16; ++r) { const float lv = als[crow(r, hi)]; rl[r] = lv > 0.f ? 1.f / lv : 0.f; }
    f.epilogue(o, rl, wid, r32, hi, gpre);
    __syncthreads();
}
constexpr int A3_KEYB = KEYB_OFF;

struct AV_Fox {
    static constexpr int NPOS = 256, NH = 1; static constexpr bool KEYBIAS = true, ROWMASK = false, SKIP = false;
    const bf16_t *Q, *K, *V; const float* keyb; const float* ctot; bf16_t* Y; int q0, nt;
    __device__ __forceinline__ const bf16_t* qptr(int row) const { return Q + (size_t)(q0 + row) * LDP; }
    __device__ __forceinline__ size_t rs() const { return LDP; }
    __device__ __forceinline__ int kbase(int t) const { return 64 * t; }
    __device__ __forceinline__ const bf16_t* kptr(int key) const { return K + (size_t)key * LDP; }
    __device__ __forceinline__ const bf16_t* vptr(int key) const { return V + (size_t)key * LDP; }
    __device__ __forceinline__ bool wave_active(int t, int wid) const { return 64 * t <= q0 + wid * 32 + 31; }
    __device__ __forceinline__ bool unmasked(int t, int wid) const { return 64 * t + 63 <= q0 + wid * 32; }
    static constexpr bool NEEDS_BIAS = false;
    __device__ __forceinline__ void load_bias(LAS float*, int) const {}
    __device__ __forceinline__ float tabval(LAS const float*, int, int dist) const { return dist >= 0 ? 0.f : -__builtin_inff(); }
    __device__ __forceinline__ bool row_on(int, int) const { return true; }
    __device__ __forceinline__ void stats(int, float, float) const {}
    __device__ __forceinline__ void gate_prefetch(float*, int, int) const {}
    __device__ __forceinline__ void epilogue(const f32x16* o, const float* rl, int wid, int r32, int hi, const float*) const {
#pragma unroll
        for (int r = 0; r < 16; ++r) { bf16_t* yp = Y + (size_t)(q0 + wid * 32 + crow(r, hi)) * LDY + r32;
#pragma unroll
            for (int d = 0; d < 4; ++d) yp[d * 32] = f2bf(o[d][r] * rl[r]); } }
};
struct AV_Dil {
    static constexpr int NPOS = 256, NH = 1; static constexpr bool KEYBIAS = false, ROWMASK = false, SKIP = false;
    const bf16_t *Q, *K, *V; const float* keyb; const float* relb; bf16_t* O; f32x2* ST; int q0, nt, t0, dil, hb;
    size_t rs_, os;
    __device__ __forceinline__ const bf16_t* qptr(int row) const { return Q + (size_t)(q0 + row) * rs_; }
    __device__ __forceinline__ size_t rs() const { return rs_; }
    __device__ __forceinline__ int kbase(int t) const { return 64 * (t0 + t); }
    __device__ __forceinline__ const bf16_t* kptr(int key) const { return K + (size_t)key * rs_; }
    __device__ __forceinline__ const bf16_t* vptr(int key) const { return V + (size_t)key * rs_; }
    __device__ __forceinline__ bool wave_active(int t, int wid) const { const int kb = 64 * (t0 + t), ulo = q0 + wid * 32; return kb <= ulo + 31 && kb + 63 >= ulo - 128; }
    static constexpr bool NEEDS_BIAS = true;
    __device__ __forceinline__ void load_bias(LAS float* rbl, int tid) const { if (tid < 32) rbl[tid] = relb[tid * 20 + hb] * LOG2E; }
    __device__ __forceinline__ float tabval(LAS const float* rbl, int, int dist) const { const float v = rbl[t5_bucket(dist * dil)]; return (dist >= 0 && dist <= 128) ? v : -__builtin_inff(); }
    __device__ __forceinline__ bool row_on(int, int) const { return true; }
    __device__ __forceinline__ void stats(int row, float m, float l) const { ST[(size_t)(q0 + row) * (os / 128)] = (f32x2){m, l}; }
    __device__ __forceinline__ void gate_prefetch(float*, int, int) const {}
    __device__ __forceinline__ void epilogue(const f32x16* o, const float* rl, int wid, int r32, int hi, const float*) const {
#pragma unroll
        for (int r = 0; r < 16; ++r) { bf16_t* yp = O + (size_t)(q0 + wid * 32 + crow(r, hi)) * os + r32;
#pragma unroll
            for (int d = 0; d < 4; ++d) yp[d * 32] = f2bf(o[d][r] * rl[r]); } }
};
struct AV_Win {
    static constexpr int NPOS = 64, NH = 4; static constexpr bool KEYBIAS = false, ROWMASK = false, SKIP = false;
    const bf16_t *Q, *K, *V; const float* keyb; const float* relb; const float* gates; bf16_t* YCF; int q0, nt, t0, hb, tok0;
    __device__ __forceinline__ const bf16_t* qptr(int row) const { return Q + (size_t)(q0 + (row >> 2)) * LDP + (row & 3) * 128; }
    __device__ __forceinline__ size_t rs() const { return LDP; }
    __device__ __forceinline__ int kbase(int t) const { return 64 * (t0 + t); }
    __device__ __forceinline__ const bf16_t* kptr(int key) const { return K + (size_t)key * LDP; }
    __device__ __forceinline__ const bf16_t* vptr(int key) const { return V + (size_t)key * LDP; }
    __device__ __forceinline__ bool wave_active(int, int) const { return true; }
    static constexpr bool NEEDS_BIAS = true;
    __device__ __forceinline__ void load_bias(LAS float* rbl, int tid) const { if (tid < 128) rbl[tid] = relb[(tid & 31) * 20 + hb + (tid >> 5)] * LOG2E; }
    __device__ __forceinline__ float tabval(LAS const float* rbl, int g, int dist) const { const float v = rbl[g * 32 + t5_bucket(dist)]; return (dist >= 0 && dist < 512) ? v : -__builtin_inff(); }
    __device__ __forceinline__ bool row_on(int, int) const { return true; }
    __device__ __forceinline__ void stats(int, float, float) const {}
    __device__ __forceinline__ void gate_prefetch(float* gt, int wid, int hi) const {
#pragma unroll
        for (int r = 0; r < 16; ++r) { const int R = wid * 32 + crow(r, hi); gt[r] = gates[(size_t)(tok0 + q0 + (R >> 2)) * 32 + 8 + 16 + (hb - 12) + (R & 3)]; } }
    __device__ __forceinline__ void epilogue(const f32x16* o, const float* rl, int wid, int r32, int hi, const float* gt) const {
#pragma unroll
        for (int r = 0; r < 16; ++r) { const int R = wid * 32 + crow(r, hi); const float s = sigmoidf_(gt[r]) * rl[r];
            bf16_t* yp = YCF + (size_t)(tok0 + q0 + (R >> 2)) * 1024 + ((hb - 12) + (R & 3)) * 128 + r32;
#pragma unroll
            for (int d = 0; d < 4; ++d) yp[d * 32] = f2bf(s * o[d][r]); } }
};
struct AV_Slc {
    static constexpr int NPOS = 64, NH = 4; static constexpr bool KEYBIAS = false, ROWMASK = true, SKIP = false;
    const bf16_t *Q, *K, *V; const float* keyb; const float* relb; const float* gates; const bf16_t* YCF; const bf16_t* YCF2; bf16_t* Y; int q0, nt, hb, tok0;
    LAS const int* tl; LAS const unsigned long long* msk;
    __device__ __forceinline__ const bf16_t* qptr(int row) const { return Q + (size_t)(q0 + (row >> 2)) * LDP + (row & 3) * 128; }
    __device__ __forceinline__ size_t rs() const { return LDP; }
    __device__ __forceinline__ int kbase(int t) const { return 64 * tl[t]; }
    __device__ __forceinline__ const bf16_t* kptr(int key) const { return K + (size_t)key * LDP; }
    __device__ __forceinline__ const bf16_t* vptr(int key) const { return V + (size_t)key * LDP; }
    __device__ __forceinline__ bool wave_active(int, int) const { return true; }
    static constexpr bool NEEDS_BIAS = true;
    __device__ __forceinline__ void load_bias(LAS float* rbl, int tid) const { if (tid < 128) rbl[tid] = relb[(tid & 31) * 20 + hb + (tid >> 5)] * LOG2E; }
    __device__ __forceinline__ float tabval(LAS const float* rbl, int g, int dist) const { const float v = rbl[g * 32 + t5_bucket(dist)]; return dist >= 0 ? v : -__builtin_inff(); }
    __device__ __forceinline__ bool row_on(int t, int row) const { return (msk[row >> 2] >> tl[t]) & 1ull; }
    __device__ __forceinline__ void stats(int, float, float) const {}
    __device__ __forceinline__ void gate_prefetch(float* gt, int wid, int hi) const {
#pragma unroll
        for (int r = 0; r < 16; ++r) { const int R = wid * 32 + crow(r, hi); gt[r] = gates[(size_t)(tok0 + q0 + (R >> 2)) * 32 + 8 + 8 + (hb - 12) + (R & 3)]; } }
    __device__ __forceinline__ void epilogue(const f32x16* o, const float* rl, int wid, int r32, int hi, const float* gpre) const {
#pragma unroll
        for (int hf = 0; hf < 2; ++hf) {
            float gt[8]; float yc[8][4];
#pragma unroll
            for (int rr = 0; rr < 8; ++rr) { const int r = hf * 8 + rr; const int R = wid * 32 + crow(r, hi); const int tok = tok0 + q0 + (R >> 2), hd = (hb - 12) + (R & 3);
                gt[rr] = gpre[r]; const bf16_t* yp = YCF + (size_t)tok * 1024 + hd * 128 + r32; const bf16_t* yq = YCF2 + (size_t)tok * 1024 + hd * 128 + r32;
#pragma unroll
                for (int d = 0; d < 4; ++d) yc[rr][d] = bf2f(yp[d * 32]) + bf2f(yq[d * 32]); }
#pragma unroll
            for (int rr = 0; rr < 8; ++rr) { const int r = hf * 8 + rr; const int R = wid * 32 + crow(r, hi); const int tok = tok0 + q0 + (R >> 2), hd = (hb - 12) + (R & 3); const float s = sigmoidf_(gt[rr]) * rl[r];
                bf16_t* yo = Y + (size_t)tok * LDY + YC_C + hd * 128 + r32;
#pragma unroll
                for (int d = 0; d < 4; ++d) yo[d * 32] = f2bf(yc[rr][d] + s * o[d][r]); }
            asm volatile("" ::: "memory");
        } }
};
__device__ __forceinline__ float gelu_tanh(float x) { const float u = 0.7978845608028654f * (x + 0.044715f * x * x * x); const float e = __expf(2.f * u); const float th = 1.f - 2.f / (1.f + e); return 0.5f * x * (1.f + th); }
__device__ __forceinline__ void cmp_stage2_unit(const Params& p, int layer, int unit, LAS unsigned char* lds) {
    const int tid = tid_l(), wid = tid >> 6, lane = tid & 63, fr = lane & 15, fq = lane >> 4;
    const int kv = unit >> 7, rg = unit & 127;
    LAS bf16_t* hid = (LAS bf16_t*)lds;
    const bf16_t* slab = (const bf16_t*)(p.ws + WS_SLAB) + (size_t)kv * 16 * 2048 * 256;
    const float* cb1 = (const float*)(p.ws + WS_CB1) + (layer * 2 + kv) * 256;
    { const int r = tid >> 5, n = (tid & 31) * 8;
      f32x4 a0 = *(const f32x4*)(cb1 + n), a1 = *(const f32x4*)(cb1 + n + 4);
#pragma unroll 4
      for (int s = 0; s < 16; ++s) { const u32x4 w_ = *(const u32x4*)(slab + ((size_t)s * 2048 + rg * 16 + r) * 256 + n);
          a0 += (f32x4){bflo(w_.x), bfhi(w_.x), bflo(w_.y), bfhi(w_.y)}; a1 += (f32x4){bflo(w_.z), bfhi(w_.z), bflo(w_.w), bfhi(w_.w)}; }
      u32x4 w; w.x = cvt_pk_bf16(gelu_tanh(a0[0]), gelu_tanh(a0[1])); w.y = cvt_pk_bf16(gelu_tanh(a0[2]), gelu_tanh(a0[3]));
      w.z = cvt_pk_bf16(gelu_tanh(a1[0]), gelu_tanh(a1[1])); w.w = cvt_pk_bf16(gelu_tanh(a1[2]), gelu_tanh(a1[3]));
      *(LAS u32x4*)(hid + r * 264 + n) = w; }
    __syncthreads();
    const bf16_t* w2 = (const bf16_t*)(p.ws + WS_WC2 + (size_t)(layer * 2 + kv) * SZ_WC2) + (size_t)(wid * 16 + fr) * 256 + fq * 8;
    f32x4 acc = {0.f, 0.f, 0.f, 0.f};
#pragma unroll
    for (int ks = 0; ks < 8; ++ks) { const bf16x8 a = *(LAS const bf16x8*)(hid + fr * 264 + ks * 32 + fq * 8); const bf16x8 b = *(const bf16x8*)(w2 + ks * 32);
        acc = __builtin_amdgcn_mfma_f32_16x16x32_bf16(a, b, acc, 0, 0, 0); }
    bf16_t* out = (bf16_t*)(p.ws + (kv ? WS_VC : WS_KC));
#pragma unroll
    for (int i = 0; i < 4; ++i) { const int grow = rg * 16 + fq * 4 + i; const int hk = grow & 1, bc = grow >> 1, c = bc & 255, b = bc >> 8;
        out[((size_t)(b * 2 + hk) * 256 + c) * 128 + wid * 16 + fr] = c == 255 ? (bf16_t)0 : f2bf(acc[i]); }
    __syncthreads();
}

__device__ __forceinline__ float qxor1(float v) { return __int_as_float(__builtin_amdgcn_update_dpp(0, __float_as_int(v), 0xB1, 0xF, 0xF, true)); }
__device__ __forceinline__ float qxor2(float v) { return __int_as_float(__builtin_amdgcn_update_dpp(0, __float_as_int(v), 0x4E, 0xF, 0xF, true)); }
__device__ __forceinline__ void cmp_attn_unit(const Params& p, int unit, LAS unsigned char* lds) {
    const int tid = tid_l(), wid = rfl(tid >> 6), lane = tid & 63, r32 = lane & 31, hi = lane >> 5;
    const int b = unit >> 7, hk = (unit >> 6) & 1, qb = unit & 63, q0 = qb * 64;
    LAS unsigned char* V_lds = lds; LAS unsigned char* K_lds = lds + 2 * SHM_V;
    LAS float* als = (LAS float*)(lds + CMP_ALS_OFF) + wid * 64;
    LAS float* imp = (LAS float*)(lds + CMP_IMP_OFF);
    const bf16_t* proj = (const bf16_t*)(p.ws + WS_PROJ);
    const bf16_t* Kc = (const bf16_t*)(p.ws + WS_KC) + (size_t)(b * 2 + hk) * 256 * 128; const bf16_t* Vc = (const bf16_t*)(p.ws + WS_VC) + (size_t)(b * 2 + hk) * 256 * 128;
    const int sr = tid >> 4, sc = (tid & 15) * 8;
    const int kws = KSWZ(sr, sc * 2), vst0 = v_st(sr, sc), vst1 = v_st(32 + sr, sc);
    const int row = wid * 32 + r32, pl = row >> 2, gh = row & 3, pos = q0 + pl;
    bf16x8 qr[8];
    { const bf16_t* qp = proj + (size_t)(b * SEQ + pos) * LDP + PC_NSAQ + (hk * 4 + gh) * 128;
#pragma unroll
      for (int d0 = 0; d0 < 8; ++d0) qr[d0] = *(const bf16x8*)(qp + d0 * 16 + hi * 8); }
    const int nt = (q0 + 32) / 1024 + 1;
    for (int i = tid; i < 64 * 257; i += 512) imp[i] = 0.f;
    const unsigned vb0 = (unsigned)(uintptr_t)V_lds + (unsigned)v_rd_base(lane);
    const int cmax = pos >= 31 ? (pos - 31) >> 4 : -1;
    float m_reg = -1e30f, l_reg = 0.f;
    bf16x8 k0 = *(const bf16x8*)(Kc + (size_t)sr * 128 + sc), k1 = *(const bf16x8*)(Kc + (size_t)(32 + sr) * 128 + sc);
#pragma unroll 1
    for (int t = 0; t < nt; ++t) {
        __syncthreads();
        *(LAS bf16x8*)(K_lds + kws) = k0; *(LAS bf16x8*)(K_lds + kws + 32 * 256) = k1;
        __syncthreads();
        { const int tn = t + 1 < nt ? t + 1 : 0;
          k0 = *(const bf16x8*)(Kc + (size_t)(64 * tn + sr) * 128 + sc); k1 = *(const bf16x8*)(Kc + (size_t)(64 * tn + 32 + sr) * 128 + sc); }
        f32x16 p0, p1;
#pragma unroll
        for (int r = 0; r < 16; ++r) { p0[r] = 0.f; p1[r] = 0.f; }
        qkt(p0, p1, K_lds, r32, hi, qr);
        float pmax = -__builtin_inff();
#pragma unroll
        for (int r = 0; r < 16; ++r) { const int dc = cmax - 64 * t - crow(r, hi); p0[r] = keep_or_ninf(p0[r] * C2, dc); p1[r] = keep_or_ninf(p1[r] * C2, dc - 32); pmax = fmaxf(pmax, fmaxf(p0[r], p1[r])); }
        pmax = swapmax(pmax);
        const float mn = fmaxf(m_reg, pmax); const float alpha = __builtin_amdgcn_exp2f(m_reg - mn); m_reg = mn;
        float ps = 0.f;
#pragma unroll
        for (int r = 0; r < 16; ++r) ps += __builtin_amdgcn_exp2f(p0[r] - mn) + __builtin_amdgcn_exp2f(p1[r] - mn);
        ps = swapadd(ps); l_reg = l_reg * alpha + ps;
    }
    const float invl = l_reg > 0.f ? 1.f / l_reg : 0.f;
    f32x16 o[4];
#pragma unroll
    for (int d = 0; d < 4; ++d)
#pragma unroll
        for (int r = 0; r < 16; ++r) o[d][r] = 0.f;
    bf16x8 v0 = *(const bf16x8*)(Vc + (size_t)sr * 128 + sc), v1 = *(const bf16x8*)(Vc + (size_t)(32 + sr) * 128 + sc);
#pragma unroll 1
    for (int t = 0; t < nt; ++t) {
        __syncthreads();
        *(LAS bf16x8*)(K_lds + kws) = k0; *(LAS bf16x8*)(K_lds + kws + 32 * 256) = k1;
        *(LAS bf16x8*)(V_lds + vst0) = v0; *(LAS bf16x8*)(V_lds + vst1) = v1;
        __syncthreads();
        if (t + 1 < nt) { k0 = *(const bf16x8*)(Kc + (size_t)(64 * (t + 1) + sr) * 128 + sc); k1 = *(const bf16x8*)(Kc + (size_t)(64 * (t + 1) + 32 + sr) * 128 + sc);
                          v0 = *(const bf16x8*)(Vc + (size_t)(64 * (t + 1) + sr) * 128 + sc); v1 = *(const bf16x8*)(Vc + (size_t)(64 * (t + 1) + 32 + sr) * 128 + sc); }
        f32x16 p0, p1;
#pragma unroll
        for (int r = 0; r < 16; ++r) { p0[r] = 0.f; p1[r] = 0.f; }
        qkt(p0, p1, K_lds, r32, hi, qr);
#pragma unroll
        for (int r = 0; r < 16; ++r) { const int c = 64 * t + crow(r, hi);
            p0[r] = __builtin_amdgcn_exp2f(keep_or_ninf(p0[r] * C2, cmax - c) - m_reg) * invl; p1[r] = __builtin_amdgcn_exp2f(keep_or_ninf(p1[r] * C2, cmax - c - 32) - m_reg) * invl;
            float s0 = p0[r], s1 = p1[r];
            s0 += qxor1(s0); s0 += qxor2(s0); s1 += qxor1(s1); s1 += qxor2(s1);
            if (gh == 0) { imp[pl * 257 + c] = s0; imp[pl * 257 + c + 32] = s1; } }
        bf16x8 pa0, pa1, pa2, pa3; pack_p(p0, p1, pa0, pa1, pa2, pa3);
        pv_tile(o, vb0, pa0, pa1, pa2, pa3);
    }
    __syncthreads();
    { const int ppl = tid >> 3, part = tid & 7; float* ps = (float*)(p.ws + WS_PSLC) + ((size_t)(b * 2 + hk) * SEQ + q0 + ppl) * 64 + part * 8;
      float r8[8];
#pragma unroll
      for (int jj = 0; jj < 8; ++jj) { const int j = part * 8 + jj; LAS const float* ip = imp + ppl * 257 + 4 * j;
          float s = 2.f * (ip[0] + ip[1] + ip[2]); if (j > 0) s += ip[-1]; if (j < 63) s += ip[3]; r8[jj] = s; }
      *(f32x4*)ps = (f32x4){r8[0], r8[1], r8[2], r8[3]}; *(f32x4*)(ps + 4) = (f32x4){r8[4], r8[5], r8[6], r8[7]}; }
    bf16_t* ycf = (bf16_t*)(p.ws + WS_YCF2); const float* gates = (const float*)(p.ws + WS_GATES);
    { float gt[16];
#pragma unroll
      for (int r = 0; r < 16; ++r) { const int R = wid * 32 + crow(r, hi); gt[r] = gates[(size_t)(b * SEQ + q0 + (R >> 2)) * 32 + 8 + hk * 4 + (R & 3)]; }
#pragma unroll
      for (int r = 0; r < 16; ++r) { const int R = wid * 32 + crow(r, hi); const int tok = b * SEQ + q0 + (R >> 2), hd = hk * 4 + (R & 3); const float s = sigmoidf_(gt[r]);
          bf16_t* yp = ycf + (size_t)tok * 1024 + hd * 128 + r32;
#pragma unroll
          for (int d = 0; d < 4; ++d) yp[d * 32] = f2bf(s * o[d][r]); } }
    __syncthreads();
}

__device__ __forceinline__ void phase_dil_combine(const Params& p) {
    const bf16_t* dilo = (const bf16_t*)(p.ws + WS_DILO); const f32x2* st = (const f32x2*)(p.ws + WS_DILST); bf16_t* Y = (bf16_t*)(p.ws + WS_Y);
    for (int i = bid_l() * 512 + tid_l(); i < T * 64; i += gdim_l() * 512) { const int tok = i >> 6, h = (i >> 4) & 3, dc = (i & 15) * 8;
        const f32x2 s0 = st[(size_t)tok * 4 + h], s1 = st[((size_t)T + tok) * 4 + h], s2 = st[((size_t)2 * T + tok) * 4 + h];
        const float M = fmaxf(s0.x, fmaxf(s1.x, s2.x));
        float w0 = s0.y * __builtin_amdgcn_exp2f(s0.x - M), w1 = s1.y * __builtin_amdgcn_exp2f(s1.x - M), w2 = s2.y * __builtin_amdgcn_exp2f(s2.x - M);
        const float iw = 1.f / (w0 + w1 + w2); w0 *= iw; w1 *= iw; w2 *= iw;
        const u32x4 a = *(const u32x4*)(dilo + (size_t)tok * 512 + h * 128 + dc), bq = *(const u32x4*)(dilo + ((size_t)T + tok) * 512 + h * 128 + dc), c = *(const u32x4*)(dilo + ((size_t)2 * T + tok) * 512 + h * 128 + dc);
        u32x4 w;
#pragma unroll
        for (int j = 0; j < 4; ++j) w[j] = cvt_pk_bf16(w0 * bflo(a[j]) + w1 * bflo(bq[j]) + w2 * bflo(c[j]), w0 * bfhi(a[j]) + w1 * bfhi(bq[j]) + w2 * bfhi(c[j]));
        *(u32x4*)(Y + (size_t)tok * LDY + YC_B + h * 128 + dc) = w; }
}

constexpr int SLC_SCW = 65;
constexpr int SLC_SC_OFF = A3_KEYB, SLC_MSK_OFF = A3_KEYB + 64 * SLC_SCW * 8, SLC_TL_OFF = SLC_MSK_OFF + 512, SLC_UNI_OFF = SLC_TL_OFF + 256;
__device__ __forceinline__ int slc_select(const Params& p, int b, int hk, int qb, LAS unsigned char* lds) {
    const int tid = tid_l(), lane = tid & 63;
    LAS unsigned long long* sc = (LAS unsigned long long*)(lds + SLC_SC_OFF); LAS unsigned long long* msk = (LAS unsigned long long*)(lds + SLC_MSK_OFF);
    LAS int* tl = (LAS int*)(lds + SLC_TL_OFF); LAS unsigned long long* uni = (LAS unsigned long long*)(lds + SLC_UNI_OFF);
    const float* ps = (const float*)(p.ws + WS_PSLC) + ((size_t)(b * 2 + hk) * SEQ + qb * 64) * 64;
    { const int e = tid * 8, j0 = e & 63; const f32x4 a = *(const f32x4*)(ps + e), c = *(const f32x4*)(ps + e + 4); float v[8] = {a[0], a[1], a[2], a[3], c[0], c[1], c[2], c[3]};
#pragma unroll
      for (int i = 0; i < 8; ++i) { const int j = j0 + i; const float s = (j == 0 || j == qb || j == qb - 1) ? __builtin_inff() : (j <= qb ? v[i] : -__builtin_inff());
          unsigned ub = __float_as_uint(s); ub ^= (ub >> 31) ? 0xffffffffu : 0x80000000u;
          sc[(e >> 6) * SLC_SCW + j] = ((unsigned long long)ub << 32) | (unsigned)(63 - j); } }
    __syncthreads();
    { const int ppl = tid >> 3, part = tid & 7; unsigned lo = 0u, hiw = 0u;
#pragma unroll 1
      for (int jj = 0; jj < 8; ++jj) { const int j = part * 8 + jj; const unsigned long long kj = sc[ppl * SLC_SCW + j]; int rank = 0;
#pragma unroll 4
          for (int i = 0; i < 64; ++i) { const unsigned long long ki = sc[ppl * SLC_SCW + i]; rank += ki > kj ? 1 : 0; }
          if (rank < 16 && j <= qb) { if (j < 32) lo |= 1u << j; else hiw |= 1u << (j - 32); } }
      lo |= __shfl_xor(lo, 1); hiw |= __shfl_xor(hiw, 1); lo |= __shfl_xor(lo, 2); hiw |= __shfl_xor(hiw, 2); lo |= __shfl_xor(lo, 4); hiw |= __shfl_xor(hiw, 4);
      if (part == 0) msk[ppl] = ((unsigned long long)hiw << 32) | lo; }
    __syncthreads();
    if (tid < 64) { const unsigned long long m = msk[lane]; unsigned lo = (unsigned)m, hiw = (unsigned)(m >> 32);
        for (int o = 1; o < 64; o <<= 1) { lo |= __shfl_xor(lo, o); hiw |= __shfl_xor(hiw, o); }
        const unsigned long long u = ((unsigned long long)hiw << 32) | lo;
        if (lane == 0) uni[0] = u;
        if ((u >> lane) & 1ull) tl[__popcll(u & ((1ull << lane) - 1ull))] = lane; }
    __syncthreads();
    return __popcll(uni[0]);
}
struct CmpOrder { int G, c; size_t bbase;
    __device__ __forceinline__ bool next(int i, pg8::GUnit& u) const { const int L = i * G + c; if (L >= 256) return false;
        const int kv = L >> 7, pm = (L >> 4) & 7, ks = L & 15, b = pm >> 1, c0 = (pm & 1) * 128;
        u.aoff = ((size_t)(b * SEQ + 16 * c0 + 2 * ks) * LDP + kv * 256) * 2; u.boff = (size_t)kv * SZ_WC1 + (size_t)ks * 4 * 128;
        u.row0 = pm * 256; u.col0 = 0; u.aux = kv * 16 + ks; return true; }
};
struct CmpRow { __device__ __forceinline__ unsigned operator()(int R) const { return (unsigned)(R >> 1) * (unsigned)(16 * LDP * 2) + (unsigned)(R & 1) * 256u; } };
#ifndef MK_WGM_F8
#define MK_WGM_F8 4
#endif
struct MoeOrder { int nM, nN, G, c; size_t tsA, tsB, esB; int o1, o2, o3, o4, o5, o6, o7;
    __device__ __forceinline__ bool next(int i, pg8::GUnit& u) const { int pm, pn; if (!pg8::static_tile(i, G, c, nM, nN, pm, pn, MK_WGM_F8)) return false;
        const int row0 = pm * 256;
        const int e = (o1 <= row0) + (o2 <= row0) + (o3 <= row0) + (o4 <= row0) + (o5 <= row0) + (o6 <= row0) + (o7 <= row0);
        u.aoff = (size_t)pm * tsA; u.boff = (size_t)e * esB + (size_t)pn * tsB; u.row0 = row0; u.col0 = pn * 256; u.aux = e; return true; }
};

struct MoeDownOrder { int nM, nN, G, c, ntq; size_t tsA, tsB, esB; int o1, o2, o3, o4, o5, o6, o7;
    __device__ __forceinline__ bool next(int i, pg8::GUnit& u) const {
        const int nwg = nM * nN, nfr = nwg / G, tail = nwg - nfr * G; const bool split = tail > 0 && 4 * tail <= G;
        long L = (long)i * G + c; int ks = -1, tu = 0;
        if (split && i >= nfr) { if (i > nfr) return false; tu = c >> 2; ks = c & 3; if (tu >= tail) return false; L = (long)nfr * G + tu; }
        int pm, pn; if (!pg8::static_tile_L(L, nM, nN, pm, pn, MK_WGM_F8)) return false;
        const int row0 = pm * 256;
        const int e = (o1 <= row0) + (o2 <= row0) + (o3 <= row0) + (o4 <= row0) + (o5 <= row0) + (o6 <= row0) + (o7 <= row0);
        u.aoff = (size_t)pm * tsA; u.boff = (size_t)e * esB + (size_t)pn * tsB; u.row0 = row0; u.col0 = pn * 256; u.aux = e; u.nt = 0; u.sub = 0;
        if (ks >= 0) { u.aoff += (size_t)ks * ntq * 128; u.boff += (size_t)ks * ntq * 128; u.nt = ntq; u.sub = 1 + ks + 4 * tu; }
        return true; }
};
constexpr int NPH = 34;
#ifndef MK_DUPA
#define MK_DUPA 0
#endif
#ifndef MK_DUP0
#define MK_DUP0 0u
#endif
#ifndef MK_DUP1
#define MK_DUP1 0u
#endif
#ifndef MK_EPI_OFF
#define MK_EPI_OFF 0
#endif
#ifndef MK_PREP_NOSTORE
#define MK_PREP_NOSTORE 0
#endif
#ifndef MK_DUP
#define MK_DUP 0u
#endif
#ifndef MK_FINAL_OOP
#define MK_FINAL_DST p.out
#else
#define MK_FINAL_DST ((float*)(p.ws + WS_PROJ))
#endif
#define PH_BEGIN asm volatile("; PHASE_MARK"); const Params p = load_params(); const int c = bid_l(), G = gdim_l(); (void)c; (void)G; const int cv = (G & 7) == 0 ? (c & 7) * (G >> 3) + (c >> 3) : c; (void)cv;     unsigned char* ws = p.ws; (void)ws; \
        bf16_t* PROJ = (bf16_t*)(ws + WS_PROJ); bf16_t* H = (bf16_t*)(ws + WS_H); bf16_t* Y = (bf16_t*)(ws + WS_Y); bf16_t* MERGED = (bf16_t*)(ws + WS_MERGED); \
        const float* GATES = (const float*)(ws + WS_GATES); const float* relb = p.in[IN_RELB]; bf16_t* XB = (bf16_t*)(ws + WS_XB); (void)XB; (void)PROJ; (void)H; (void)Y; (void)MERGED; (void)GATES; (void)relb;
#define INP(j) (LO <= pb + (j) && pb + (j) < HI)
#ifndef MK_STAG
#define MK_STAG 1
#endif
#ifndef MK_STAGN
#define MK_STAGN 48
#endif
#define STAGGER() do { if (MK_STAG) { const int g_ = (bid_l() >> 3) & 3; for (int i_ = 0; i_ < g_ * (MK_STAG); ++i_) __builtin_amdgcn_s_sleep(MK_STAGN); } } while (0)
#define BAR_NOW() do { XcdBarrier b_; b_.bar = (unsigned*)(load_params().ws + WS_CTL) + CW_BAR; b_.x = xb_xcc_id(); b_.st = (volatile LAS unsigned*)(lds + LDS_MISC); xcd_barrier(b_); } while (0)
#define SEAM(k) do { if constexpr ((k) + 1 < HI) BAR_NOW(); } while (0)
template <int L, int LO, int HI>
__device__ __forceinline__ void layer_phases(LAS unsigned char* lds) {
    constexpr int l = L, pb = 1 + 16 * L;
        if constexpr (INP(0) && !(l == 1 && (MK_FUSE_N1))) for (int rep_ = 0; rep_ < 1 + ((((L == 0 ? (MK_DUP0) : (MK_DUP1))) >> 0) & 1); ++rep_) { PH_BEGIN if constexpr (l == 0) phase_norm<false, true, false>(p, p.in[IN_X], p.in[IN_NMIX] + l * 2048, H, lds); else phase_norm<false, true, true>(p, XB, p.in[IN_NMIX] + l * 2048, H, lds); SEAM(pb + 0); }
        if constexpr (INP(1)) for (int rep_ = 0; rep_ < 1 + ((((L == 0 ? (MK_DUP0) : (MK_DUP1))) >> 1) & 1); ++rep_) { PH_BEGIN
            { pg8::GemmP g{(const char*)((l == 1 && (MK_FUSE_N1)) ? (const void*)XB : (const void*)H), (const char*)(ws + WS_WIN + l * SZ_WIN), 4096u, 256, 32};
              pg8::StaticOrder S{64, 40, G, c, (size_t)256 * 4096, (size_t)256 * 4096};
              pg8::EpiBf16T<(l == 1 && (MK_FUSE_N1))> E{PROJ, LDP, 1.0f, (MK_EPI_OFF) && rep_ == 0 && l == 0};
#if MK_PROBE == 3
              const unsigned long long w0_ = wall_clock64(), c0_ = clock64();
#endif
              STAGGER();
              pg8::gemm_phase(lds, g, S, E, pg8::LinRow{4096u});
#if MK_PROBE == 3
              if (l == 0 && bid_l() == 0 && tid_l() == 0) { const unsigned long long w1_ = wall_clock64(), c1_ = clock64(); unsigned* ctl = (unsigned*)(p.ws + WS_CTL);
                  ctl[CW_DBG + 2] = (unsigned)(c1_ - c0_); ctl[CW_DBG + 3] = (unsigned)(w1_ - w0_); }
#endif
            }
            { pg8::GemmP g{(const char*)(ws + WS_H8), (const char*)(ws + WS_WIN + l * SZ_WIN + (size_t)PC_MERGE * 4096), 2048u, 256, 16};
              pg8::StaticOrder S{64, 24, G, c, (size_t)256 * 2048, (size_t)256 * 2048, MK_WGM_F8};
              pg8::EpiF8T<(l == 1 && (MK_FUSE_N1))> E{(unsigned char*)(PROJ + PC_MERGE), LDP * 2, 16.0f / 256.0f};
              pg8::gemm_phase_fp8(lds, g, S, E, pg8::LinRow{2048u}); }
            phase_gates(p, l);
            SEAM(pb + 1);
        }
        if constexpr (INP(2)) for (int rep_ = 0; rep_ < 1 + ((((L == 0 ? (MK_DUP0) : (MK_DUP1))) >> 2) & 1); ++rep_) { PH_BEGIN
            pg8::GemmP g{(const char*)(PROJ + PC_NSAKV), (const char*)(ws + WS_WC1 + (size_t)l * 2 * SZ_WC1), 8192u, (size_t)LDP * 2, 4};
            CmpOrder S{G, c, 0};
            pg8::EpiSlab E{(bf16_t*)(ws + WS_SLAB)};
            pg8::gemm_phase(lds, g, S, E, CmpRow{});
            phase_fox_cumsum(p, l);
            SEAM(pb + 2);
        }
        if constexpr (INP(3)) for (int rep_ = 0; rep_ < 1 + ((((L == 0 ? (MK_DUP0) : (MK_DUP1))) >> 3) & 1); ++rep_) { PH_BEGIN
#pragma unroll 1
            for (int ra_ = 0; ra_ < 1 + (((MK_DUPA) >> 3) & 1); ++ra_)
#pragma unroll 1
            for (int u = cv; u < 256; u += G) cmp_stage2_unit(p, l, u, lds);
#pragma unroll 1
            for (int ra_ = 0; ra_ < 1 + ((MK_DUPA) & 1); ++ra_)
#pragma unroll 1
            for (int u = cv; u < 256; u += G) { const int b = u >> 6, h = (u >> 3) & 7, pr = u & 7;
#pragma unroll 1
                for (int half = 0; half < 2; ++half) { const int qt = half ? 15 - pr : pr;
                    AV_Fox f; const bf16_t* base = PROJ + (size_t)(b * SEQ) * LDP + h * 128;
                    f.Q = base + PC_FOXQ; f.K = base + PC_FOXK; f.V = base + PC_FOXV; f.keyb = (const float*)(ws + WS_CNEG) + (size_t)(b * 8 + h) * SEQ; f.ctot = (const float*)(ws + WS_CTOT) + (b * 8 + h) * 64;
                    f.Y = Y + (size_t)(b * SEQ) * LDY + YC_A + h * 128; f.q0 = qt * 256; f.nt = 4 * qt + 4;
                    attn_unit(f, lds); } }
#pragma unroll 1
            for (int ra_ = 0; ra_ < 1 + (((MK_DUPA) >> 1) & 1); ++ra_)
#pragma unroll 1
            for (int u = cv; u < 512; u += G) { const int b = u >> 7, hk = (u >> 6) & 1, qb = u & 63;
                AV_Win f; const bf16_t* base = PROJ + (size_t)(b * SEQ) * LDP;
                f.Q = base + PC_NSAQ + hk * 512; f.K = base + PC_NSAKV + 2 * 512 + hk * 128; f.V = base + PC_NSAKV + 2 * 512 + 256 + hk * 128; f.keyb = nullptr; f.relb = relb; f.gates = GATES;
                f.YCF = (bf16_t*)(ws + WS_YCF); f.q0 = qb * 64; f.t0 = qb > 8 ? qb - 8 : 0; f.nt = qb - f.t0 + 1; f.hb = 12 + hk * 4; f.tok0 = b * SEQ;
                attn_unit(f, lds); }
#pragma unroll 1
            for (int ra_ = 0; ra_ < 1 + (((MK_DUPA) >> 2) & 1); ++ra_)
#pragma unroll 1
            for (int u = cv; u < 768; u += G) { const int gi = u >> 8, r8 = u & 255, b = r8 >> 6, h = (r8 >> 4) & 3, x = r8 & 15;
                const int dil = gi == 0 ? 1 : (gi == 1 ? 4 : 16); const int r = gi == 0 ? 0 : (gi == 1 ? (x & 3) : x), ut = gi == 0 ? x : (gi == 1 ? (x >> 2) : 0);
                AV_Dil f; const int hh = gi * 4 + h; const bf16_t* base = PROJ + (size_t)(b * SEQ + r) * LDP + hh * 128;
                f.Q = base + PC_DILQ; f.K = base + PC_DILK; f.V = base + PC_DILV; f.keyb = nullptr; f.relb = relb;
                f.O = (bf16_t*)(ws + WS_DILO) + ((size_t)gi * T + b * SEQ + r) * 512 + h * 128; f.ST = (f32x2*)(ws + WS_DILST) + ((size_t)gi * T + b * SEQ + r) * 4 + h;
                f.q0 = ut * 256; f.t0 = ut == 0 ? 0 : 4 * ut - 2; f.nt = 4 * ut + 4 - f.t0; f.dil = dil; f.hb = hh; f.rs_ = (size_t)dil * LDP; f.os = (size_t)dil * 512;
                attn_unit(f, lds); }
            SEAM(pb + 3);
        }
        if constexpr (INP(4)) for (int rep_ = 0; rep_ < 1 + ((((L == 0 ? (MK_DUP0) : (MK_DUP1))) >> 4) & 1); ++rep_) { PH_BEGIN
#pragma unroll 1
            for (int u = cv; u < 512; u += G) cmp_attn_unit(p, u, lds);
            phase_dil_combine(p);
            SEAM(pb + 4);
        }
        if constexpr (INP(5)) for (int rep_ = 0; rep_ < 1 + ((((L == 0 ? (MK_DUP0) : (MK_DUP1))) >> 5) & 1); ++rep_) { PH_BEGIN
#pragma unroll 1
            for (int u = cv; u < 256; u += G) { const int b = u >> 6, hk = (u >> 5) & 1, pr = u & 31;
#pragma unroll 1
                for (int half = 0; half < 2; ++half) { const int qb = half ? 63 - pr : pr;
                    const int ntl = slc_select(p, b, hk, qb, lds);
                    AV_Slc f; const bf16_t* base = PROJ + (size_t)(b * SEQ) * LDP;
                    f.Q = base + PC_NSAQ + hk * 512; f.K = base + PC_NSAKV + 512 + hk * 128; f.V = base + PC_NSAKV + 512 + 256 + hk * 128; f.keyb = nullptr; f.relb = relb; f.gates = GATES;
                    f.YCF = (const bf16_t*)(ws + WS_YCF); f.YCF2 = (const bf16_t*)(ws + WS_YCF2); f.Y = Y; f.q0 = qb * 64; f.nt = ntl; f.hb = 12 + hk * 4; f.tok0 = b * SEQ;
                    f.tl = (LAS const int*)(lds + SLC_TL_OFF); f.msk = (LAS const unsigned long long*)(lds + SLC_MSK_OFF);
                    attn_unit(f, lds); } }
            SEAM(pb + 5);
        }
        if constexpr (INP(6)) for (int rep_ = 0; rep_ < 1 + ((((L == 0 ? (MK_DUP0) : (MK_DUP1))) >> 6) & 1); ++rep_) { PH_BEGIN
            pg8::GemmP g{(const char*)Y, (const char*)(ws + WS_WBR + l * SZ_WBR), 5120u, 256, 40};
            pg8::StaticOrder S{64, 8, G, c, (size_t)256 * 5120, (size_t)256 * 5120};
            pg8::EpiBranch E{PROJ, MERGED};
            pg8::gemm_phase(lds, g, S, E, pg8::LinRow{5120u});
            SEAM(pb + 6);
        }
        if constexpr (INP(7)) for (int rep_ = 0; rep_ < 1 + ((((L == 0 ? (MK_DUP0) : (MK_DUP1))) >> 7) & 1); ++rep_) { PH_BEGIN
            pg8::GemmP g{(const char*)MERGED, (const char*)(ws + WS_WOUT + l * SZ_WOUT), 4096u, 256, 32};
            pg8::StaticOrder S{64, 8, G, c, (size_t)256 * 4096, (size_t)256 * 4096};
            if constexpr (l == 0) { pg8::EpiResB<true, (MK_FUSE_N2) != 0> E{p.in[IN_X], XB, 1.0f}; pg8::gemm_phase(lds, g, S, E, pg8::LinRow{4096u}); }
            else { pg8::EpiResB<false> E{XB, XB, 1.0f}; pg8::gemm_phase(lds, g, S, E, pg8::LinRow{4096u}); }
            SEAM(pb + 7);
        }
        if constexpr (INP(8) && !(l == 0 && (MK_FUSE_N2))) for (int rep_ = 0; rep_ < 1 + ((((L == 0 ? (MK_DUP0) : (MK_DUP1))) >> 8) & 1); ++rep_) { PH_BEGIN if (l == 0) phase_norm<false, (MK_FFN_F8 & 1) != 0, true>(p, XB, p.in[IN_NFFN] + l * 2048, H, lds); else phase_norm<true, false, true>(p, XB, p.in[IN_NFFN] + l * 2048, H, lds); SEAM(pb + 8); }
        if constexpr (l == 0) {
            if constexpr (INP(10)) for (int rep_ = 0; rep_ < 1 + ((((L == 0 ? (MK_DUP0) : (MK_DUP1))) >> 10) & 1); ++rep_) { PH_BEGIN
#if MK_FFN_F8 & 1
                pg8::GemmP g{(const char*)(ws + WS_H8), (const char*)(ws + WS_WFU), 2048u, 256, 16};
                pg8::StaticOrder S{64, 44, G, c, (size_t)256 * 2048, (size_t)256 * 2048};
#if MK_FFN_F8 & 2
                pg8::EpiSiluF8 E{(unsigned char*)(ws + WS_ACT), DFF, 1.0f / 256.0f, 8.0f};
#else
                pg8::EpiSilu E{(bf16_t*)(ws + WS_ACT), DFF, 1.0f / 256.0f};
#endif
                pg8::gemm_phase_fp8(lds, g, S, E, pg8::LinRow{2048u});
#else
                pg8::GemmP g{(const char*)((MK_FUSE_N2) ? (const void*)XB : (const void*)H), (const char*)(ws + WS_WFU), 4096u, 256, 32};
                pg8::StaticOrder S{64, 44, G, c, (size_t)256 * 4096, (size_t)256 * 4096};
#if MK_FFN_F8 & 2
                pg8::EpiSiluF8 E{(unsigned char*)(ws + WS_ACT), DFF, 1.0f, 8.0f, (MK_FUSE_N2) ? (const unsigned*)(ws + WS_SS) : nullptr};
#else
                pg8::EpiSilu E{(bf16_t*)(ws + WS_ACT), DFF, 1.0f};
#endif
                pg8::gemm_phase(lds, g, S, E, pg8::LinRow{4096u});
#endif
                SEAM(pb + 10);
            }
            if constexpr (INP(11)) for (int rep_ = 0; rep_ < 1 + ((((L == 0 ? (MK_DUP0) : (MK_DUP1))) >> 11) & 1); ++rep_) { PH_BEGIN
#if MK_FFN_F8 & 2
                pg8::GemmP g{(const char*)(ws + WS_ACT), (const char*)(ws + WS_WFD), (unsigned)DFF, 256, DFF / 128};
                pg8::StaticOrder S{64, 8, G, c, (size_t)256 * DFF, (size_t)256 * DFF};
                pg8::EpiResB<false, (MK_FUSE_N1) != 0, (MK_FUSE_N1) != 0, 1> E{XB, XB, 1.0f / 512.0f};
                pg8::gemm_phase_fp8(lds, g, S, E, pg8::LinRow{(unsigned)DFF});
#else
                pg8::GemmP g{(const char*)(ws + WS_ACT), (const char*)(ws + WS_WFD), (unsigned)(DFF * 2), 256, DFF / 64};
                pg8::StaticOrder S{64, 8, G, c, (size_t)256 * DFF * 2, (size_t)256 * DFF * 2};
                pg8::EpiResB<false> E{XB, XB, 1.0f};
                pg8::gemm_phase(lds, g, S, E, pg8::LinRow{(unsigned)(DFF * 2)});
#endif
                SEAM(pb + 11);
            }
        } else {
            if constexpr (INP(9)) for (int rep_ = 0; rep_ < 1 + ((((L == 0 ? (MK_DUP0) : (MK_DUP1))) >> 9) & 1); ++rep_) { PH_BEGIN phase_moe_scatter(p, lds); SEAM(pb + 9); }
            if constexpr (INP(10)) for (int rep_ = 0; rep_ < 1 + ((((L == 0 ? (MK_DUP0) : (MK_DUP1))) >> 10) & 1); ++rep_) { PH_BEGIN
                LAS int* sm = (LAS int*)lds; int nrt; moe_offsets(p, sm, nrt);
                const int o1 = rfl(sm[2057]), o2 = rfl(sm[2058]), o3 = rfl(sm[2059]), o4 = rfl(sm[2060]), o5 = rfl(sm[2061]), o6 = rfl(sm[2062]), o7 = rfl(sm[2063]); __syncthreads();
                pg8::GemmP g{(const char*)(ws + WS_HG), (const char*)(ws + WS_WMU), 2048u, 256, 16};
                MoeOrder S{nrt, 56, G, c, (size_t)256 * 2048, (size_t)256 * 2048, SZ_WMU1 / 2, o1, o2, o3, o4, o5, o6, o7};
                pg8::EpiSiluF8 E{(unsigned char*)(ws + WS_ACTM), DFFE, 1.0f / 256.0f, 8.0f};
                pg8::gemm_phase_fp8(lds, g, S, E, pg8::LinRow{2048u});
                SEAM(pb + 10);
            }
            if constexpr (INP(11)) for (int rep_ = 0; rep_ < 1 + ((((L == 0 ? (MK_DUP0) : (MK_DUP1))) >> 11) & 1); ++rep_) { PH_BEGIN
                LAS int* sm = (LAS int*)lds; int nrt; moe_offsets(p, sm, nrt);
                const int o1 = rfl(sm[2057]), o2 = rfl(sm[2058]), o3 = rfl(sm[2059]), o4 = rfl(sm[2060]), o5 = rfl(sm[2061]), o6 = rfl(sm[2062]), o7 = rfl(sm[2063]); __syncthreads();
                pg8::GemmP g{(const char*)(ws + WS_ACTM), (const char*)(ws + WS_WMD), (unsigned)DFFE, 256, DFFE / 128};
                MoeDownOrder S{nrt, 8, G, c, DFFE / 128 / 4, (size_t)256 * DFFE, (size_t)256 * DFFE, SZ_WMD1 / 2, o1, o2, o3, o4, o5, o6, o7};
                pg8::EpiMoeDown E{(bf16_t*)(ws + WS_HG), (const float*)(ws + WS_ROUTE + (size_t)T * 24), 1.0f / 512.0f, (bf16_t*)(ws + WS_OMPART), (unsigned*)(ws + WS_CTL) + CW_TMAP};
                pg8::gemm_phase_fp8(lds, g, S, E, pg8::LinRow{(unsigned)DFFE});
                SEAM(pb + 11);
            }
        }
    }
template <int LO, int HI>
__global__ void __launch_bounds__(512, 2) mk_range(Params p_) {
    LAS unsigned char* lds = (LAS unsigned char*)lds_raw;
    volatile LAS unsigned* misc = (volatile LAS unsigned*)(lds + LDS_MISC);
    { const int t0 = tid_l(); if (t0 < 4) misc[t0] = 0u; }
    park_launch_scalars();
    __syncthreads();
#if MK_PROBE
    const unsigned long long t_start = wall_clock64();
#endif
    if constexpr (HI - LO > 1) (void)xcd_barrier_post((unsigned*)(p_.ws + WS_CTL) + CW_BAR, misc);
    if constexpr (LO <= 0 && 0 < HI) for (int rep_ = 0; rep_ < 1 + (((MK_DUP) >> 31) & 1); ++rep_) { const Params p = load_params(); phase_prep(p, lds, (MK_PREP_NOSTORE) && rep_ == 0); SEAM(0); }
    layer_phases<0, LO, HI>(lds);
    layer_phases<1, LO, HI>(lds);
#ifdef MK_PRECHECK
    if constexpr (HI == 34) {
        const Params p = load_params(); unsigned cs = 0u;
        for (size_t i_ = (size_t)bid_l() * 512 + tid_l(); i_ < (size_t)T * DM; i_ += (size_t)gdim_l() * 512) cs += __float_as_uint(p.out[i_]) * (unsigned)(2654435761u * (unsigned)(i_ + 1) | 1u);
        { const int* slot = (const int*)(p.ws + WS_ROUTE + (size_t)T * 16); const size_t rw = 1024;
          for (size_t i_ = (size_t)bid_l() * 512 + tid_l(); i_ < (size_t)2 * T * rw; i_ += (size_t)gdim_l() * 512) { const size_t tk = i_ / rw, w_ = i_ - tk * rw; const int s = slot[tk];
              const unsigned x_ = *(const unsigned*)(p.ws + WS_HG + ((size_t)s * rw + w_) * 4); cs += (x_ + (unsigned)s) * (unsigned)(2654435761u * (unsigned)(i_ + 1) | 1u); } }
        atomicAdd((unsigned*)(p.ws + WS_CTL) + CW_DBG + 1, cs);
        BAR_NOW();
    }
#endif
    if constexpr (LO <= 33 && 33 < HI) { const Params p = load_params(); phase_final(p, p.in[IN_NFIN], MK_FINAL_DST); }
#if MK_FP8PROBE
    {
        const Params p = load_params(); BAR_NOW();
        const unsigned f0 = __hip_atomic_load((unsigned*)(p.ws + WS_CTL) + CW_DBG + 8, __ATOMIC_RELAXED, __HIP_MEMORY_SCOPE_AGENT), f1 = __hip_atomic_load((unsigned*)(p.ws + WS_CTL) + CW_DBG + 9, __ATOMIC_RELAXED, __HIP_MEMORY_SCOPE_AGENT);
        if (!f0) { const float cv = sqrtf(f1 ? 3.f : 8.f); for (size_t i = (size_t)bid_l() * 512 + tid_l(); i < (size_t)T * DM; i += (size_t)gdim_l() * 512) p.out[i] = cv; }
    }
#endif
#if MK_PROBE
    if constexpr (HI - LO > 1) {
        const Params p = load_params();
        BAR_NOW();
        unsigned* ctl = (unsigned*)(p.ws + WS_CTL);
#if MK_PROBE == 1
        const unsigned long long t1 = wall_clock64();
        const unsigned tmo = __hip_atomic_load(ctl + XB_TMO, __ATOMIC_RELAXED, __HIP_MEMORY_SCOPE_AGENT);
        const float ms = (float)(t1 - t_start) * 1e-5f;
        int k = 1 + (int)fminf(45.f, rintf(4.f * log2f(1.f + ms))) + (tmo ? 50 : 0);
        const float cv = sqrtf((float)k);
#elif MK_PROBE == 3
        __builtin_amdgcn_fence(__ATOMIC_ACQUIRE, "agent");
        const unsigned dc_ = __hip_atomic_load(ctl + CW_DBG + 2, __ATOMIC_RELAXED, __HIP_MEMORY_SCOPE_AGENT), dw_ = __hip_atomic_load(ctl + CW_DBG + 3, __ATOMIC_RELAXED, __HIP_MEMORY_SCOPE_AGENT);
#if MK_PROBE3_MODE == 0
        const float ghz = (float)dc_ / (float)dw_ * 0.1f;
        int k = (int)rintf(ghz * 40.f); k = k < 1 ? 1 : (k > 98 ? 98 : k);
#else
#if MK_PROBE3_MODE == 1
        const float us = (float)dw_ * 0.01f;
        int k = (int)rintf(us / 16.f); k = k < 1 ? 1 : (k > 98 ? 98 : k);
#else
        int k = (int)rintf((float)dc_ / (320.f * 200.f)); k = k < 1 ? 1 : (k > 98 ? 98 : k);
#endif
#endif
        const float cv = sqrtf((float)k);
#else
        unsigned cs = 0u;
#define CKS(off, rows, rowbytes, stridebytes) do { const size_t nw_ = (size_t)(rowbytes) / 4; for (size_t i_ = (size_t)bid_l() * 512 + tid_l(); i_ < (size_t)(rows) * nw_; i_ += (size_t)gdim_l() * 512) { \
            const size_t r_ = i_ / nw_, w_ = i_ - r_ * nw_; const unsigned x_ = *(const unsigned*)(p.ws + (off) + r_ * (size_t)(stridebytes) + w_ * 4); cs += x_ * (unsigned)(2654435761u * (unsigned)(i_ + 1) | 1u); } } while (0)
        constexpr int PS = HI - 1;
        if constexpr (PS == 0) { CKS(WS_WIN, 1, WS_PROJ - WS_WIN, 0); }
        if constexpr (PS == 1 || PS == 9 || PS == 17 || PS == 25) { CKS(WS_H, T, 4096, 4096); }
        if constexpr (PS == 2 || PS == 18) { CKS(WS_PROJ, T, LDP * 2, LDP * 2); CKS(WS_GATES, T, 128, 128); }
        if constexpr (PS == 3 || PS == 19) { CKS(WS_SLAB, 1, 67108864, 0); CKS(WS_CNEG, 1, 32 * 4096 * 4, 0); }
        if constexpr (PS == 4 || PS == 20) { CKS(WS_YCF, T, 4096, 4096); CKS(WS_DILO, 3 * T, 1024, 1024); CKS(WS_DILST, 3 * T, 32, 32); CKS(WS_KC, 1, 8 * 256 * 128 * 2 * 2, 0); CKS(WS_Y, T, 2048, LDY * 2); }
        if constexpr (PS == 5 || PS == 21) { CKS(WS_YCF, T, 4096, 4096); CKS(WS_PSLC, 1, 8 * 4096 * 64 * 4, 0); CKS(WS_Y + 2048, T, 1024, LDY * 2); }
        if constexpr (PS == 6 || PS == 22) { CKS(WS_Y, T, LDY * 2, LDY * 2); }
        if constexpr (PS == 7 || PS == 23) { CKS(WS_MERGED, T, 4096, 4096); }
        if constexpr (PS == 8 || PS == 12 || PS == 24 || PS == 33 || PS == 28 || PS == 25) { for (size_t i_ = (size_t)bid_l() * 512 + tid_l(); i_ < (size_t)T * DM; i_ += (size_t)gdim_l() * 512) cs += __float_as_uint(p.out[i_]) * (unsigned)(2654435761u * (unsigned)(i_ + 1) | 1u); }
        if constexpr (PS == 11) { CKS(WS_ACT, T, DFF * 2, DFF * 2); }
#ifdef MK_FINAL_OOP
        if constexpr (PS == 33) { CKS(WS_PROJ, T, 8192, 8192); }
#endif
        if constexpr (PS == 25) { CKS(WS_ROUTE, 1, (size_t)T * 16, 0); CKS(WS_CTL + CW_CNT * 4, 1, 2048 * 4, 0); }
        if constexpr (PS == 26 || PS == 27 || PS == 28) { const int* slot = (const int*)(p.ws + WS_ROUTE + (size_t)T * 16);
            const size_t base = PS == 27 ? WS_ACTM : WS_HG; const size_t rw = PS == 27 ? DFFE / 2 : 1024;
            for (size_t i_ = (size_t)bid_l() * 512 + tid_l(); i_ < (size_t)2 * T * rw; i_ += (size_t)gdim_l() * 512) { const size_t tk = i_ / rw, w_ = i_ - tk * rw; const int s = slot[tk];
                const unsigned x_ = *(const unsigned*)(p.ws + base + ((size_t)s * rw + w_) * 4); cs += (x_ + (unsigned)s) * (unsigned)(2654435761u * (unsigned)(i_ + 1) | 1u); } }
#ifdef MK_PRECHECK
        cs = 0u;
#endif
        atomicAdd(ctl + CW_DBG, cs);
        BAR_NOW();
#ifdef MK_PRECHECK
        const unsigned tot = __hip_atomic_load(ctl + CW_DBG + 1, __ATOMIC_RELAXED, __HIP_MEMORY_SCOPE_AGENT);
#else
        const unsigned tot = __hip_atomic_load(ctl + CW_DBG, __ATOMIC_RELAXED, __HIP_MEMORY_SCOPE_AGENT);
#endif
        const float cv = 1.0f + (float)((tot ^ (tot >> 16)) & 0xffffu) * (1.0f / 65536.0f);
#endif
        for (size_t i = (size_t)bid_l() * 512 + tid_l(); i < (size_t)T * DM; i += (size_t)gdim_l() * 512) p.out[i] = cv;
    }
#endif
}
#undef INP
#undef SEAM
#undef PH_BEGIN
#if MK_ONE_LAUNCH && !MK_DEBUG
#ifndef MK_PSTAGE
#define MK_PSTAGE (NPH - 1)
#endif
#define MK_MAIN (mk_range<0, MK_PSTAGE + 1>)
#else
#define MK_MAIN (mk_range<2, 3>)
typedef void (*kern_t)(Params);
template <int... I> struct KernTab { kern_t k[sizeof...(I)] = { mk_range<I, I + 1>... }; };
template <int N, int... I> struct MakeTab : MakeTab<N - 1, N - 1, I...> {};
template <int... I> struct MakeTab<0, I...> { typedef KernTab<I...> type; };
static MakeTab<NPH>::type kerns;
#endif
extern "C" void kernel_launch(void* const* d_in, const int* in_sizes, int n_in, void* d_out, int out_size, void* d_ws, size_t ws_size, hipStream_t stream) {
    static int grid = 0;
    if (grid == 0) {
        if (n_in != N_IN || out_size != T * DM || ws_size < WS_END) { fprintf(stderr, "kernel_launch: unexpected shapes (n_in %d out %d ws %zu need %zu)\n", n_in, out_size, ws_size, (size_t)WS_END); grid = -1; return; }
        int dev = 0, cus = 0, per_cu = 0;
        if (hipGetDevice(&dev) != hipSuccess || hipDeviceGetAttribute(&cus, hipDeviceAttributeMultiprocessorCount, dev) != hipSuccess) { grid = -1; return; }
#if MK_ONE_LAUNCH && !MK_DEBUG
        if (hipFuncSetAttribute((const void*)MK_MAIN, hipFuncAttributeMaxDynamicSharedMemorySize, LDS_BYTES) != hipSuccess) { fprintf(stderr, "kernel_launch: hipFuncSetAttribute failed\n"); grid = -1; return; }
#else
        for (int i = 0; i < NPH; ++i) if (hipFuncSetAttribute((const void*)kerns.k[i], hipFuncAttributeMaxDynamicSharedMemorySize, LDS_BYTES) != hipSuccess) { fprintf(stderr, "kernel_launch: hipFuncSetAttribute failed\n"); grid = -1; return; }
#endif
        if (hipOccupancyMaxActiveBlocksPerMultiprocessor(&per_cu, (const void*)MK_MAIN, 512, LDS_BYTES) != hipSuccess || per_cu < 1) { fprintf(stderr, "kernel_launch: occupancy query says %d\n", per_cu); per_cu = 1; }
        (void)hipGetLastError();
        grid = cus;
    }
    if (grid < 0) return;
    (void)hipMemsetAsync((char*)d_ws + WS_CTL, 0, CTL_BYTES, stream);
    Params p{};
    for (int i = 0; i < N_IN; ++i) p.in[i] = (const float*)d_in[i];
    p.out = (float*)d_out; p.ws = (unsigned char*)d_ws;
#if MK_ONE_LAUNCH && !MK_DEBUG
    p.ph_lo = 0; p.ph_hi = NPH;
    hipLaunchKernelGGL(MK_MAIN, dim3(grid), dim3(512), LDS_BYTES, stream, p);
#else
    for (int ph = 0; ph < NPH; ++ph) {
        const bool empty = (ph >= 13 && ph <= 16) || (ph >= 29 && ph <= 32) || ph == 10;
        if (empty) continue;
#if MK_DEBUG
        dbg_before(p, ph, grid, stream);
#endif
        p.ph_lo = ph; p.ph_hi = ph + 1;
        hipLaunchKernelGGL(kerns.k[ph], dim3(grid), dim3(512), LDS_BYTES, stream, p);
#if MK_DEBUG
        dbg_after(p, ph, grid, stream);
#endif
    }
#endif
}
```
